# Optimizing an MI355X kernel written in HIP

```python
import jax, jax.numpy as jnp
from jax import lax
import numpy as np

D_MODEL = 1024
BATCH = 4
SEQ = 8192
DEPTH = 1

ATTN_HEADS = 8
ATTN_HD = 64
ATTN_WIDTH = ATTN_HEADS * ATTN_HD
DILATED_PATTERNS = ((128, 1), (512, 4), (2048, 16))
ATTN_BLOCK = 128
DN_HEADS = 4
DN_KD = 128
DN_VD = 128
DN_QK_WIDTH = DN_HEADS * DN_KD
DN_V_WIDTH = DN_HEADS * DN_VD
DN_CONV_DIM = 2 * DN_QK_WIDTH + DN_V_WIDTH
CONV_K = 4
DN_CHUNK = 64
D_MIX = ATTN_WIDTH + DN_V_WIDTH
IN_SPLITS = (ATTN_WIDTH, 2 * ATTN_WIDTH, 3 * ATTN_WIDTH,
             3 * ATTN_WIDTH + DN_CONV_DIM,
             3 * ATTN_WIDTH + DN_CONV_DIM + DN_V_WIDTH,
             3 * ATTN_WIDTH + DN_CONV_DIM + DN_V_WIDTH + DN_HEADS)
IN_COLS = 3 * ATTN_WIDTH + DN_CONV_DIM + DN_V_WIDTH + 2 * DN_HEADS
N_EXPERTS = 32
TOP_K = 4
D_EXPERT = 1024
SWIGLU_LIMIT = 7.0
SWIGLU_ALPHA = 1.702
MOE_BLOCK = 128
NORM_EPS = 1e-6

kernel_name = 'hybrid_dilated_attn_gdn_moe_adaln'


def rms_norm(x, w):
    xf = x.astype(jnp.float32)
    y = xf * lax.rsqrt(jnp.mean(xf * xf, axis=-1, keepdims=True) + NORM_EPS)
    return (y * w.astype(jnp.float32)).astype(x.dtype)


def l2_norm(x):
    return x * lax.rsqrt(jnp.sum(x * x, axis=-1, keepdims=True) + NORM_EPS)


def modulate(x, w, shift, scale):
    return rms_norm(x, w) * (1 + scale[:, None, :]) + shift[:, None, :]


def dilated_branch(q, k, v, window, dilation):
    B, S, H, Dh = q.shape
    L = S // dilation
    span = window // dilation
    nb = -(-L // ATTN_BLOCK)
    Lp = nb * ATTN_BLOCK

    def to_sub(t):
        t = t.astype(jnp.float32).reshape(B, L, dilation, H, Dh).transpose(0, 2, 3, 1, 4)
        return jnp.pad(t, ((0, 0), (0, 0), (0, 0), (0, Lp - L), (0, 0)))

    def window_blocks(t):
        t = jnp.pad(t, ((0, 0), (0, 0), (0, 0), (ATTN_BLOCK, 0), (0, 0)))
        t = t.reshape(B, dilation, H, nb + 1, ATTN_BLOCK, Dh)
        return jnp.concatenate([t[:, :, :, :-1], t[:, :, :, 1:]], axis=-2)

    qb = to_sub(q).reshape(B, dilation, H, nb, ATTN_BLOCK, Dh)
    kw = window_blocks(to_sub(k))
    vw = window_blocks(to_sub(v))
    s = jnp.einsum('bdhnqe,bdhnke->bdhnqk', qb, kw) * (ATTN_HD ** -0.5)
    dist = (jnp.arange(ATTN_BLOCK)[:, None] + ATTN_BLOCK) - jnp.arange(2 * ATTN_BLOCK)[None, :]
    band = (dist >= 0) & (dist <= span)
    kpos = jnp.arange(nb)[:, None] * ATTN_BLOCK - ATTN_BLOCK + jnp.arange(2 * ATTN_BLOCK)[None, :]
    mask = band[None, :, :] & (kpos >= 0)[:, None, :]
    s = jnp.where(mask, s, -jnp.inf)
    m = jnp.max(s, axis=-1, keepdims=True)
    p = jnp.exp(s - m)
    den = jnp.sum(p, axis=-1)
    o = jnp.einsum('bdhnqk,bdhnke->bdhnqe', p, vw) / den[..., None]
    lse = m[..., 0] + jnp.log(den)
    o = o.reshape(B, dilation, H, Lp, Dh)[:, :, :, :L].transpose(0, 3, 1, 2, 4).reshape(B, S, H, Dh)
    lse = lse.reshape(B, dilation, H, Lp)[:, :, :, :L].transpose(0, 3, 1, 2).reshape(B, S, H)
    return o, lse


def dilated_attention(q, k, v):
    outs, lses = [], []
    for window, dilation in DILATED_PATTERNS:
        o, lse = dilated_branch(q, k, v, window, dilation)
        outs.append(o)
        lses.append(lse)
    wts = jax.nn.softmax(jnp.stack(lses, axis=0), axis=0)
    return jnp.einsum('gbsh,gbshe->bshe', wts, jnp.stack(outs, axis=0))


def causal_short_conv(x, w):
    S = x.shape[1]
    xp = jnp.pad(x, ((0, 0), (CONV_K - 1, 0), (0, 0)))
    y = w[CONV_K - 1] * x
    for j in range(CONV_K - 1):
        y = y + w[j] * xp[:, j:j + S]
    return y


def gated_delta_rule(q, k, v, g, beta):
    B, S, H, Dk = q.shape
    Dv = v.shape[-1]
    C = DN_CHUNK
    N = S // C
    q = l2_norm(q) * (Dk ** -0.5)
    k = l2_norm(k)

    def chunk(t):
        return jnp.swapaxes(t.reshape((B, N, C, H) + t.shape[3:]), 2, 3)

    qc, kc, vc, gc, bc = chunk(q), chunk(k), chunk(v), chunk(g), chunk(beta)
    gc = jnp.cumsum(gc, axis=-1)
    tril = jnp.tril(jnp.ones((C, C), dtype=bool))
    strict = jnp.tril(jnp.ones((C, C), dtype=bool), -1)
    decay = jnp.exp(jnp.where(tril, gc[..., :, None] - gc[..., None, :], -jnp.inf))
    kb = kc * bc[..., None]
    vb = vc * bc[..., None]
    a_low = jnp.where(strict, jnp.einsum('bnhie,bnhje->bnhij', kb, kc) * decay, 0.0)
    lhs = a_low + jnp.eye(C, dtype=jnp.float32)
    u = lax.linalg.triangular_solve(lhs, vb, left_side=True, lower=True)
    w = lax.linalg.triangular_solve(lhs, kb * jnp.exp(gc)[..., None], left_side=True, lower=True)
    intra = jnp.einsum('bnhie,bnhje->bnhij', qc, kc) * decay
    q_dec = qc * jnp.exp(gc)[..., None]
    k_dec = kc * jnp.exp(gc[..., -1:] - gc)[..., None]
    g_last = jnp.exp(gc[..., -1])

    def step(state, xs):
        qd, kd, u_i, w_i, intra_i, gl = xs
        v_new = u_i - jnp.einsum('bhce,bhef->bhcf', w_i, state)
        o = jnp.einsum('bhce,bhef->bhcf', qd, state) + jnp.einsum('bhij,bhjf->bhif', intra_i, v_new)
        state = state * gl[..., None, None] + jnp.einsum('bhce,bhcf->bhef', kd, v_new)
        return state, o

    xs = tuple(jnp.moveaxis(t, 1, 0) for t in (q_dec, k_dec, u, w, intra, g_last))
    state0 = jnp.zeros((B, H, Dk, Dv), jnp.float32)
    _, o = lax.scan(step, state0, xs)
    return o.transpose(1, 0, 3, 2, 4).reshape(B, S, H, Dv)


def hybrid_mixer(h, w_in, conv_w, A_log, dt_bias, dn_norm_w, w_out):
    B, S, _ = h.shape
    proj = h @ w_in
    aq, ak, av, dqkv, dz, db, da = jnp.split(proj, IN_SPLITS, axis=-1)
    shp_a = (B, S, ATTN_HEADS, ATTN_HD)
    attn_out = dilated_attention(aq.reshape(shp_a), ak.reshape(shp_a), av.reshape(shp_a))
    attn_out = attn_out.reshape(B, S, ATTN_WIDTH).astype(h.dtype)
    dqkv = jax.nn.silu(causal_short_conv(dqkv, conv_w)).astype(jnp.float32)
    dq, dk, dv = jnp.split(dqkv, (DN_QK_WIDTH, 2 * DN_QK_WIDTH), axis=-1)
    g = -jnp.exp(A_log.astype(jnp.float32)) * jax.nn.softplus(da.astype(jnp.float32) + dt_bias.astype(jnp.float32))
    beta = jax.nn.sigmoid(db.astype(jnp.float32))
    o = gated_delta_rule(dq.reshape(B, S, DN_HEADS, DN_KD), dk.reshape(B, S, DN_HEADS, DN_KD),
                         dv.reshape(B, S, DN_HEADS, DN_VD), g, beta)
    o = rms_norm(o, dn_norm_w) * jax.nn.silu(dz.astype(jnp.float32).reshape(B, S, DN_HEADS, DN_VD))
    dn_out = o.reshape(B, S, DN_V_WIDTH).astype(h.dtype)
    return jnp.concatenate([attn_out, dn_out], axis=-1) @ w_out


def clamped_swiglu(hgu):
    gate, up = jnp.split(hgu, 2, axis=-1)
    gate = jnp.minimum(gate, SWIGLU_LIMIT)
    up = jnp.clip(up, -SWIGLU_LIMIT, SWIGLU_LIMIT)
    return gate * jax.nn.sigmoid(SWIGLU_ALPHA * gate) * (up + 1)


def routed_moe(h, w_router, b_router, w1, b1, w2, b2):
    B, S, D = h.shape
    T = B * S
    xt = h.reshape(T, D)
    logits = (xt @ w_router + b_router).astype(jnp.float32)
    top_v, top_e = lax.top_k(logits, TOP_K)
    gates = jax.nn.softmax(top_v, axis=-1)
    A = T * TOP_K
    e_flat = top_e.reshape(A)
    tok_flat = jnp.repeat(jnp.arange(T, dtype=jnp.int32), TOP_K)
    g_flat = gates.reshape(A)
    order = jnp.argsort(e_flat)
    se, stok, sg = e_flat[order], tok_flat[order], g_flat[order]
    counts = jnp.zeros((N_EXPERTS,), jnp.int32).at[e_flat].add(1)
    padded = (counts + MOE_BLOCK - 1) // MOE_BLOCK * MOE_BLOCK
    pend = jnp.cumsum(padded)
    pstart = pend - padded
    cstart = jnp.cumsum(counts) - counts
    dest = pstart[se] + (jnp.arange(A, dtype=jnp.int32) - cstart[se])
    P = A + N_EXPERTS * MOE_BLOCK
    NB = P // MOE_BLOCK
    row_tok = jnp.zeros((P,), jnp.int32).at[dest].set(stok)
    row_gate = jnp.zeros((P,), jnp.float32).at[dest].set(sg)
    block_exp = jnp.minimum(jnp.searchsorted(pend, jnp.arange(NB) * MOE_BLOCK, side='right'),
                            N_EXPERTS - 1).astype(jnp.int32)
    xs = xt[row_tok].reshape(NB, MOE_BLOCK, D)

    def expert_block(args):
        xb, e = args
        return clamped_swiglu(xb @ w1[e] + b1[e]) @ w2[e] + b2[e]

    yb = lax.map(expert_block, (xs, block_exp)).reshape(P, D)
    y = jnp.zeros((T, D), h.dtype).at[row_tok].add(yb * row_gate[:, None].astype(yb.dtype))
    return y.reshape(B, S, D)


def setup_inputs(seed: int = 0) -> dict:
    key = jax.random.key(seed)
    ks = jax.random.split(key, 20)
    D, L, E, F = D_MODEL, DEPTH, N_EXPERTS, D_EXPERT
    nrm = jax.random.normal
    return {
        'x': nrm(ks[0], (BATCH, SEQ, D), jnp.float32),
        'c': nrm(ks[1], (BATCH, D), jnp.float32),
        'w_ada': nrm(ks[2], (L, D, 6 * D), jnp.float32) * (0.5 * D ** -0.5),
        'b_ada': nrm(ks[3], (L, 6 * D), jnp.float32) * 0.02,
        'norm1_w': 1.0 + 0.05 * nrm(ks[4], (L, D), jnp.float32),
        'w_in': nrm(ks[5], (L, D, IN_COLS), jnp.float32) * (D ** -0.5),
        'conv_w': nrm(ks[6], (L, CONV_K, DN_CONV_DIM), jnp.float32) * 0.5,
        'A_log': jnp.log(jax.random.uniform(ks[7], (L, DN_HEADS), jnp.float32, 1.0, 16.0)),
        'dt_bias': jax.random.uniform(ks[8], (L, DN_HEADS), jnp.float32, -4.5, -2.5),
        'dn_norm_w': 1.0 + 0.05 * nrm(ks[9], (L, DN_VD), jnp.float32),
        'w_out': nrm(ks[10], (L, D_MIX, D), jnp.float32) * (D_MIX ** -0.5),
        'norm2_w': 1.0 + 0.05 * nrm(ks[11], (L, D), jnp.float32),
        'w_router': nrm(ks[12], (L, D, E), jnp.float32) * (D ** -0.5),
        'b_router': nrm(ks[13], (L, E), jnp.float32) * 0.01,
        'w1': nrm(ks[14], (L, E, D, 2 * F), jnp.float32) * (D ** -0.5),
        'b1': nrm(ks[15], (L, E, 2 * F), jnp.float32) * 0.01,
        'w2': nrm(ks[16], (L, E, F, D), jnp.float32) * (F ** -0.5),
        'b2': nrm(ks[17], (L, E, D), jnp.float32) * 0.01,
        'final_norm_w': 1.0 + 0.05 * nrm(ks[18], (D,), jnp.float32),
    }


def reference(x, c, w_ada, b_ada, norm1_w, w_in, conv_w, A_log, dt_bias, dn_norm_w, w_out,
              norm2_w, w_router, b_router, w1, b1, w2, b2, final_norm_w):
    cond = jax.nn.silu(c)
    for l in range(DEPTH):
        mod = cond @ w_ada[l] + b_ada[l]
        shift1, scale1, gate1, shift2, scale2, gate2 = jnp.split(mod, 6, axis=-1)
        h = modulate(x, norm1_w[l], shift1, scale1)
        x = x + gate1[:, None, :] * hybrid_mixer(h, w_in[l], conv_w[l], A_log[l], dt_bias[l],
                                                 dn_norm_w[l], w_out[l])
        h = modulate(x, norm2_w[l], shift2, scale2)
        x = x + gate2[:, None, :] * routed_moe(h, w_router[l], b_router[l], w1[l], b1[l], w2[l], b2[l])
    return rms_norm(x, final_norm_w)
```

```cpp
#include <hip/hip_runtime.h>
#include <hip/hip_cooperative_groups.h>
#include <cstdio>
#include <cstdint>
namespace cg = cooperative_groups;

typedef _Float16 h16;
typedef _Float16 h16x2 __attribute__((ext_vector_type(2)));
typedef _Float16 h16x4 __attribute__((ext_vector_type(4)));
typedef _Float16 h16x8 __attribute__((ext_vector_type(8)));
typedef float f32x4 __attribute__((ext_vector_type(4)));
typedef float f32x2 __attribute__((ext_vector_type(2)));

constexpr int D = 1024, NB = 4, SEQ = 8192, T = NB * SEQ;
constexpr int AH = 8, AHD = 64, AW = 512;
constexpr int DH = 4, DKD = 128, DW = 512, DCONV = 1536;
constexpr int INC = 3592, INC_MAIN = 3584;
constexpr int NE = 32, TOPK = 4, FE = 1024;
constexpr int NASG = T * TOPK;
constexpr float EPS = 1e-6f;
constexpr int NTHREADS = 512, NWAVES = 8;

constexpr size_t MiB = (size_t)1 << 20;
constexpr size_t WS_CTL = 0;
constexpr size_t WS_MOD = 1 * MiB;
constexpr size_t WS_BA = 2 * MiB;
constexpr size_t WS_G = 3 * MiB;
constexpr size_t WS_ASG_E = 4 * MiB;
constexpr size_t WS_ASG_P = 4 * MiB + 512 * 1024;
constexpr size_t WS_ASG_G = 5 * MiB;
constexpr size_t WS_TOK = 6 * MiB;
constexpr size_t WS_W16 = 16 * MiB;
constexpr size_t WS_H16 = 224 * MiB;
constexpr size_t WS_X1 = 288 * MiB;
constexpr size_t WS_R = 416 * MiB;
constexpr size_t WS_Q16 = WS_R;
constexpr size_t WS_K16 = WS_R + 32 * MiB;
constexpr size_t WS_V16 = WS_R + 64 * MiB;
constexpr size_t WS_DQKV = WS_R + 96 * MiB;
constexpr size_t WS_Z16 = WS_R + 192 * MiB;
constexpr size_t WS_QN = WS_R + 224 * MiB;
constexpr size_t WS_KN = WS_R + 256 * MiB;
constexpr size_t WS_VV = WS_R + 288 * MiB;
constexpr size_t WS_O32 = WS_R + 320 * MiB;
constexpr size_t WS_MIX = WS_R + 384 * MiB;
constexpr size_t WS_ACT = WS_R;
constexpr size_t WS_Y16 = WS_R + 272 * MiB;
constexpr size_t WS_END = WS_R + 544 * MiB;

struct Params { const float* in[19]; float* out; unsigned char* ws; };

__device__ __forceinline__ float wave_sum(float v) {
#pragma unroll
    for (int o = 1; o < 64; o <<= 1) v += __shfl_xor(v, o);
    return v;
}
__device__ __forceinline__ float wave_max(float v) {
#pragma unroll
    for (int o = 1; o < 64; o <<= 1) v = fmaxf(v, __shfl_xor(v, o));
    return v;
}
__device__ __forceinline__ int otid() { int t = threadIdx.x; asm volatile("" : "+v"(t)); return t; }
__device__ __forceinline__ float silu_f(float v) { return v / (1.f + __expf(-v)); }
__device__ __forceinline__ float sigmoid_f(float v) { return 1.f / (1.f + __expf(-v)); }

template <class RowPtr, class ColMap, class Epi>
__device__ __forceinline__ void gemm_tile(float* lds, int K, const float* __restrict__ B, int ldb, RowPtr rowptr, ColMap colmap, Epi epi) {
    float* As = lds;
    float* Bs = lds + 16 * 132;
    const int tid = otid(), ty = tid >> 4, tx = tid & 15;
    const int ar = tid >> 2, ak = (tid & 3) * 4;
    const h16* arow = rowptr(ar);
    const int bk = tid >> 5, bc = (tid & 31) * 4;
    const int bcol = colmap(bc);
    float acc[4][8];
#pragma unroll
    for (int i = 0; i < 4; ++i)
#pragma unroll
        for (int j = 0; j < 8; ++j) acc[i][j] = 0.f;
    for (int k0 = 0; k0 < K; k0 += 16) {
        h16x4 av = (h16x4){(h16)0, (h16)0, (h16)0, (h16)0};
        if (arow) av = *(const h16x4*)(arow + k0 + ak);
        const f32x4 bv = *(const f32x4*)(B + (size_t)(k0 + bk) * ldb + bcol);
        __syncthreads();
        As[(ak + 0) * 132 + ar] = (float)av[0];
        As[(ak + 1) * 132 + ar] = (float)av[1];
        As[(ak + 2) * 132 + ar] = (float)av[2];
        As[(ak + 3) * 132 + ar] = (float)av[3];
        *(f32x4*)(Bs + bk * 128 + bc) = bv;
        __syncthreads();
#pragma unroll
        for (int k = 0; k < 16; ++k) {
            const f32x4 a = *(const f32x4*)(As + k * 132 + ty * 4);
            const f32x4 b0 = *(const f32x4*)(Bs + k * 128 + tx * 4);
            const f32x4 b1 = *(const f32x4*)(Bs + k * 128 + 64 + tx * 4);
#pragma unroll
            for (int i = 0; i < 4; ++i)
#pragma unroll
                for (int j = 0; j < 4; ++j) { acc[i][j] += a[i] * b0[j]; acc[i][4 + j] += a[i] * b1[j]; }
        }
    }
#pragma unroll
    for (int i = 0; i < 4; ++i) epi(ty * 4 + i, tx * 4, acc[i]);
}

__device__ __forceinline__ void phase_mod(const Params& p, float* lds) {
    const float* c = p.in[1]; const float* w = p.in[2]; const float* bias = p.in[3];
    float* mod = (float*)(p.ws + WS_MOD);
    const int tid = otid();
    for (int i = tid; i < 4096; i += NTHREADS) lds[i] = silu_f(c[i]);
    __syncthreads();
    float* red = lds + 4096;
    for (int cb = blockIdx.x; cb < 192; cb += gridDim.x) {
        const int cc = tid & 31, col = cb * 32 + cc, ks = tid >> 5;
        float a0 = 0.f, a1 = 0.f, a2 = 0.f, a3 = 0.f;
        for (int k = ks * 64; k < ks * 64 + 64; ++k) {
            const float wv = w[(size_t)k * 6144 + col];
            a0 += lds[k] * wv; a1 += lds[1024 + k] * wv; a2 += lds[2048 + k] * wv; a3 += lds[3072 + k] * wv;
        }
        red[(ks * 4 + 0) * 32 + cc] = a0; red[(ks * 4 + 1) * 32 + cc] = a1; red[(ks * 4 + 2) * 32 + cc] = a2; red[(ks * 4 + 3) * 32 + cc] = a3;
        __syncthreads();
        if (tid < 128) {
            const int b = tid >> 5; float s = 0.f;
            for (int q = 0; q < 16; ++q) s += red[(q * 4 + b) * 32 + cc];
            mod[b * 6144 + col] = s + bias[col];
        }
        __syncthreads();
    }
    if (blockIdx.x == 0 && tid < 64) ((int*)(p.ws + WS_CTL))[tid] = 0;
}

__device__ __forceinline__ void phase_mod1(const Params& p) {
    const float* x = p.in[0]; const float* nw = p.in[4]; const float* w_in = p.in[5];
    const float* mod = (const float*)(p.ws + WS_MOD);
    h16* hout = (h16*)(p.ws + WS_H16); float* ba = (float*)(p.ws + WS_BA);
    const int tid_ = otid(); const int lane = tid_ & 63, wave = tid_ >> 6;
    const int gw = blockIdx.x * NWAVES + wave, NGW = gridDim.x * NWAVES;
    for (int row = gw; row < T; row += NGW) {
        const int b = row / SEQ;
        const float* shift = mod + b * 6144; const float* scale = shift + 1024;
        const f32x4* xr = (const f32x4*)(x + (size_t)row * D) + lane;
        f32x4 v[4]; float ss = 0.f;
#pragma unroll
        for (int j = 0; j < 4; ++j) { v[j] = xr[64 * j]; ss += v[j][0] * v[j][0] + v[j][1] * v[j][1] + v[j][2] * v[j][2] + v[j][3] * v[j][3]; }
        const float rstd = rsqrtf(wave_sum(ss) * (1.f / D) + EPS);
        float pb[8];
#pragma unroll
        for (int e = 0; e < 8; ++e) pb[e] = 0.f;
#pragma unroll
        for (int j = 0; j < 4; ++j) {
            const int col = 256 * j + 4 * lane;
            const f32x4 w4 = *(const f32x4*)(nw + col), sc = *(const f32x4*)(scale + col), sh = *(const f32x4*)(shift + col);
            f32x4 hv;
#pragma unroll
            for (int i = 0; i < 4; ++i) hv[i] = v[j][i] * rstd * w4[i] * (1.f + sc[i]) + sh[i];
            h16x4 o; o[0] = (h16)hv[0]; o[1] = (h16)hv[1]; o[2] = (h16)hv[2]; o[3] = (h16)hv[3];
            *(h16x4*)(hout + (size_t)row * D + col) = o;
#pragma unroll
            for (int i = 0; i < 4; ++i) {
                const f32x4 wa = *(const f32x4*)(w_in + (size_t)(col + i) * INC + INC_MAIN);
                const f32x4 wb = *(const f32x4*)(w_in + (size_t)(col + i) * INC + INC_MAIN + 4);
#pragma unroll
                for (int e = 0; e < 4; ++e) { pb[e] += hv[i] * wa[e]; pb[4 + e] += hv[i] * wb[e]; }
            }
        }
#pragma unroll
        for (int e = 0; e < 8; ++e) pb[e] = wave_sum(pb[e]);
        if (lane == 0) {
            *(f32x4*)(ba + (size_t)row * 8) = (f32x4){pb[0], pb[1], pb[2], pb[3]};
            *(f32x4*)(ba + (size_t)row * 8 + 4) = (f32x4){pb[4], pb[5], pb[6], pb[7]};
        }
    }
}

struct RowPlain { const h16* base; int row0; __device__ __forceinline__ const h16* operator()(int r) const { return base + (size_t)(row0 + r) * D; } };
struct ColPlain { int n0; __device__ __forceinline__ int operator()(int n) const { return n0 + n; } };
struct EpiInProj {
    unsigned char* ws; int row0, n0;
    __device__ __forceinline__ void st(int row, int c, const float* a) const {
        h16* dst; int ld, cc;
        if (c < 512) { dst = (h16*)(ws + WS_Q16); ld = 512; cc = c; }
        else if (c < 1024) { dst = (h16*)(ws + WS_K16); ld = 512; cc = c - 512; }
        else if (c < 1536) { dst = (h16*)(ws + WS_V16); ld = 512; cc = c - 1024; }
        else if (c < 3072) { dst = (h16*)(ws + WS_DQKV); ld = 1536; cc = c - 1536; }
        else { dst = (h16*)(ws + WS_Z16); ld = 512; cc = c - 3072; }
        h16x4 o; o[0] = (h16)a[0]; o[1] = (h16)a[1]; o[2] = (h16)a[2]; o[3] = (h16)a[3];
        *(h16x4*)(dst + (size_t)row * ld + cc) = o;
    }
    __device__ __forceinline__ void operator()(int r, int n, const float* a) const { st(row0 + r, n0 + n, a); st(row0 + r, n0 + 64 + n, a + 4); }
};
__device__ __forceinline__ void phase_inproj(const Params& p, float* lds) {
    const h16* h = (const h16*)(p.ws + WS_H16);
    constexpr int NT = INC_MAIN / 128, MT = T / 128;
    for (int u = blockIdx.x; u < NT * MT; u += gridDim.x) {
        const int mt = u / NT, nt = u % NT;
        gemm_tile(lds, D, p.in[5], INC, RowPlain{h, mt * 128}, ColPlain{nt * 128}, EpiInProj{p.ws, mt * 128, nt * 128});
    }
}

__device__ __forceinline__ void phase_dnprep(const Params& p) {
    const h16* dqkv = (const h16*)(p.ws + WS_DQKV);
    const float* cw = p.in[6]; const float* A_log = p.in[7]; const float* dt_bias = p.in[8];
    const float* ba = (const float*)(p.ws + WS_BA);
    h16* qn = (h16*)(p.ws + WS_QN); h16* kn = (h16*)(p.ws + WS_KN); h16* vv = (h16*)(p.ws + WS_VV);
    float* g = (float*)(p.ws + WS_G); float* beta = g + (size_t)T * 4;
    const int tid_ = otid(); const int lane = tid_ & 63, wave = tid_ >> 6;
    const int gw = blockIdx.x * NWAVES + wave, NGW = gridDim.x * NWAVES;
    for (int it = gw; it < T * DH; it += NGW) {
        const int row = it >> 2, hd = it & 3, tpos = row % SEQ;
        float y[3][2];
#pragma unroll
        for (int part = 0; part < 3; ++part) {
            const int ch = part * 512 + hd * 128 + 2 * lane;
            float a0 = 0.f, a1 = 0.f;
#pragma unroll
            for (int j = 0; j < 4; ++j) {
                const int tt = tpos - 3 + j;
                if (tt >= 0) {
                    const h16x2 xv = *(const h16x2*)(dqkv + (size_t)(row - 3 + j) * DCONV + ch);
                    const f32x2 wv = *(const f32x2*)(cw + j * DCONV + ch);
                    a0 += (float)xv[0] * wv[0]; a1 += (float)xv[1] * wv[1];
                }
            }
            y[part][0] = silu_f(a0); y[part][1] = silu_f(a1);
        }
        const float sq = wave_sum(y[0][0] * y[0][0] + y[0][1] * y[0][1]);
        const float sk = wave_sum(y[1][0] * y[1][0] + y[1][1] * y[1][1]);
        const float rq = rsqrtf(sq + EPS) * 0.08838834764831845f, rk = rsqrtf(sk + EPS);
        const size_t o = (size_t)row * DW + hd * 128 + 2 * lane;
        h16x2 t2;
        t2[0] = (h16)(y[0][0] * rq); t2[1] = (h16)(y[0][1] * rq); *(h16x2*)(qn + o) = t2;
        t2[0] = (h16)(y[1][0] * rk); t2[1] = (h16)(y[1][1] * rk); *(h16x2*)(kn + o) = t2;
        t2[0] = (h16)y[2][0]; t2[1] = (h16)y[2][1]; *(h16x2*)(vv + o) = t2;
        if (lane == 0) {
            const float dbv = ba[(size_t)row * 8 + hd], dav = ba[(size_t)row * 8 + 4 + hd];
            const float xsp = dav + dt_bias[hd];
            const float sp = (xsp > 20.f) ? xsp : log1pf(__expf(xsp));
            g[(size_t)row * 4 + hd] = -__expf(A_log[hd]) * sp;
            beta[(size_t)row * 4 + hd] = sigmoid_f(dbv);
        }
    }
}

__device__ __forceinline__ void phase_scan_naive(const Params& p, float* ldsf, int bh) {
    const h16* qn = (const h16*)(p.ws + WS_QN); const h16* kn = (const h16*)(p.ws + WS_KN); const h16* vv = (const h16*)(p.ws + WS_VV);
    const float* g = (const float*)(p.ws + WS_G); const float* beta = g + (size_t)T * 4;
    float* o32 = (float*)(p.ws + WS_O32);
    h16* qs = (h16*)ldsf; h16* ks = qs + 64 * 128; h16* vs = ks + 64 * 128; float* gs = (float*)(vs + 64 * 128); float* bs = gs + 64;
    const int tid = otid(), b = bh >> 2, hd = bh & 3;
    float S[64];
#pragma unroll
    for (int i = 0; i < 64; ++i) S[i] = 0.f;
    const int col = tid >> 1, hf = tid & 1;
    for (int chunk = 0; chunk < SEQ / 64; ++chunk) {
        const size_t t0 = (size_t)b * SEQ + chunk * 64;
        for (int i = tid; i < 1024; i += NTHREADS) {
            const int r = i >> 4, c = (i & 15) * 8; const size_t go = (t0 + r) * DW + hd * 128 + c;
            *(h16x8*)(qs + r * 128 + c) = *(const h16x8*)(qn + go);
            *(h16x8*)(ks + r * 128 + c) = *(const h16x8*)(kn + go);
            *(h16x8*)(vs + r * 128 + c) = *(const h16x8*)(vv + go);
        }
        if (tid < 64) { gs[tid] = g[(t0 + tid) * 4 + hd]; bs[tid] = beta[(t0 + tid) * 4 + hd]; }
        __syncthreads();
        if (tid < 256) {
            for (int s = 0; s < 64; ++s) {
                const float eg = __expf(gs[s]), bt = bs[s];
                float dot = 0.f;
#pragma unroll
                for (int i = 0; i < 64; i += 8) {
                    const h16x8 kk = *(const h16x8*)(ks + s * 128 + hf * 64 + i);
#pragma unroll
                    for (int j = 0; j < 8; ++j) dot += (float)kk[j] * S[i + j];
                }
                dot += __shfl_xor(dot, 1);
                const float vn = bt * ((float)vs[s * 128 + col] - eg * dot);
                float o = 0.f;
#pragma unroll
                for (int i = 0; i < 64; i += 8) {
                    const h16x8 kk = *(const h16x8*)(ks + s * 128 + hf * 64 + i);
                    const h16x8 qq = *(const h16x8*)(qs + s * 128 + hf * 64 + i);
#pragma unroll
                    for (int j = 0; j < 8; ++j) { S[i + j] = eg * S[i + j] + (float)kk[j] * vn; o += (float)qq[j] * S[i + j]; }
                }
                o += __shfl_xor(o, 1);
                if (hf == 0) o32[(t0 + s) * DW + hd * 128 + col] = o;
            }
        }
        __syncthreads();
    }
}

__device__ __forceinline__ void phase_attn_naive(const Params& p, int vblock, int nvblocks) {
    const h16* q16 = (const h16*)(p.ws + WS_Q16); const h16* k16 = (const h16*)(p.ws + WS_K16); const h16* v16 = (const h16*)(p.ws + WS_V16);
    h16* mix = (h16*)(p.ws + WS_MIX);
    const int tid_ = otid(); const int lane = tid_ & 63, wave = tid_ >> 6;
    const int gw = vblock * NWAVES + wave, NGW = nvblocks * NWAVES;
    for (int it = gw; it < T * AH; it += NGW) {
        const int row = it >> 3, hd = it & 7, tpos = row % SEQ;
        float q[64];
        {
            const h16x8* qp = (const h16x8*)(q16 + (size_t)row * AW + hd * 64);
#pragma unroll
            for (int i = 0; i < 8; ++i) { const h16x8 t8 = qp[i];
#pragma unroll
                for (int j = 0; j < 8; ++j) q[i * 8 + j] = (float)t8[j]; }
        }
        float s[7]; int tk[7];
        float m = -INFINITY;
#pragma unroll
        for (int e = 0; e < 7; ++e) {
            const int idx = e * 64 + lane;
            const int br = idx / 129, j = idx - br * 129;
            const int dil = (br == 0) ? 1 : ((br == 1) ? 4 : 16);
            const int tkk = tpos - j * dil;
            const bool valid = (idx < 387) && (tkk >= 0);
            tk[e] = valid ? (row - j * dil) : -1;
            float sc = -INFINITY;
            if (valid) {
                const h16x8* kp = (const h16x8*)(k16 + (size_t)(row - j * dil) * AW + hd * 64);
                float acc = 0.f;
#pragma unroll
                for (int i = 0; i < 8; ++i) { const h16x8 t8 = kp[i];
#pragma unroll
                    for (int jj = 0; jj < 8; ++jj) acc += q[i * 8 + jj] * (float)t8[jj]; }
                sc = acc * 0.125f;
            }
            s[e] = sc; m = fmaxf(m, sc);
        }
        m = wave_max(m);
        float l = 0.f;
#pragma unroll
        for (int e = 0; e < 7; ++e) { s[e] = (tk[e] >= 0) ? __expf(s[e] - m) : 0.f; l += s[e]; }
        l = wave_sum(l);
        float o = 0.f;
#pragma unroll
        for (int e = 0; e < 7; ++e) {
            const int nsrc = (e < 6) ? 64 : 3;
            for (int src = 0; src < nsrc; ++src) {
                const float pp = __shfl(s[e], src); const int tr = __shfl(tk[e], src);
                if (tr >= 0) o += pp * (float)v16[(size_t)tr * AW + hd * 64 + lane];
            }
        }
        mix[(size_t)row * D + hd * 64 + lane] = (h16)(o / l);
    }
}

__device__ __forceinline__ void phase_dnout(const Params& p) {
    const float* o32 = (const float*)(p.ws + WS_O32); const h16* z16 = (const h16*)(p.ws + WS_Z16); const float* nw = p.in[9];
    h16* mix = (h16*)(p.ws + WS_MIX);
    const int tid_ = otid(); const int lane = tid_ & 63, wave = tid_ >> 6;
    const int gw = blockIdx.x * NWAVES + wave, NGW = gridDim.x * NWAVES;
    for (int it = gw; it < T * DH; it += NGW) {
        const int row = it >> 2, hd = it & 3;
        const f32x2 ov = *(const f32x2*)(o32 + (size_t)row * DW + hd * 128 + 2 * lane);
        const float rstd = rsqrtf(wave_sum(ov[0] * ov[0] + ov[1] * ov[1]) * (1.f / 128.f) + EPS);
        const h16x2 zv = *(const h16x2*)(z16 + (size_t)row * DW + hd * 128 + 2 * lane);
        const f32x2 w2 = *(const f32x2*)(nw + 2 * lane);
        h16x2 r; r[0] = (h16)(ov[0] * rstd * w2[0] * silu_f((float)zv[0])); r[1] = (h16)(ov[1] * rstd * w2[1] * silu_f((float)zv[1]));
        *(h16x2*)(mix + (size_t)row * D + 512 + hd * 128 + 2 * lane) = r;
    }
}

struct EpiOutProj {
    const float* x; const float* mod; float* x1; int row0, n0;
    __device__ __forceinline__ void st(int row, int c, const float* a) const {
        const int b = row / SEQ; const f32x4 gt = *(const f32x4*)(mod + b * 6144 + 2048 + c); const f32x4 xv = *(const f32x4*)(x + (size_t)row * D + c);
        f32x4 o; o[0] = xv[0] + gt[0] * a[0]; o[1] = xv[1] + gt[1] * a[1]; o[2] = xv[2] + gt[2] * a[2]; o[3] = xv[3] + gt[3] * a[3];
        *(f32x4*)(x1 + (size_t)row * D + c) = o;
    }
    __device__ __forceinline__ void operator()(int r, int n, const float* a) const { st(row0 + r, n0 + n, a); st(row0 + r, n0 + 64 + n, a + 4); }
};
__device__ __forceinline__ void phase_outproj(const Params& p, float* lds) {
    const h16* mix = (const h16*)(p.ws + WS_MIX);
    constexpr int NT = D / 128, MT = T / 128;
    for (int u = blockIdx.x; u < NT * MT; u += gridDim.x) {
        const int mt = u / NT, nt = u % NT;
        gemm_tile(lds, D, p.in[10], D, RowPlain{mix, mt * 128}, ColPlain{nt * 128},
                  EpiOutProj{p.in[0], (const float*)(p.ws + WS_MOD), (float*)(p.ws + WS_X1), mt * 128, nt * 128});
    }
}

__device__ __forceinline__ void phase_router(const Params& p) {
    const float* x1 = (const float*)(p.ws + WS_X1); const float* nw = p.in[11]; const float* wr = p.in[12]; const float* br = p.in[13];
    const float* mod = (const float*)(p.ws + WS_MOD);
    h16* hout = (h16*)(p.ws + WS_H16);
    int* cnt = (int*)(p.ws + WS_CTL); int* tok = (int*)(p.ws + WS_TOK);
    int* asg_e = (int*)(p.ws + WS_ASG_E); int* asg_p = (int*)(p.ws + WS_ASG_P); float* asg_g = (float*)(p.ws + WS_ASG_G);
    const int tid_ = otid(); const int lane = tid_ & 63, wave = tid_ >> 6;
    const int gw = blockIdx.x * NWAVES + wave, NGW = gridDim.x * NWAVES;
    for (int row = gw; row < T; row += NGW) {
        const int b = row / SEQ;
        const float* shift = mod + b * 6144 + 3072; const float* scale = shift + 1024;
        const f32x4* xr = (const f32x4*)(x1 + (size_t)row * D) + lane;
        float ss = 0.f;
#pragma unroll
        for (int j = 0; j < 4; ++j) { const f32x4 t4 = xr[64 * j]; ss += t4[0] * t4[0] + t4[1] * t4[1] + t4[2] * t4[2] + t4[3] * t4[3]; }
        const float rstd = rsqrtf(wave_sum(ss) * (1.f / D) + EPS);
        float lg[32];
#pragma unroll
        for (int e = 0; e < 32; ++e) lg[e] = 0.f;
#pragma unroll 1
        for (int j = 0; j < 4; ++j) {
            const int col = 256 * j + 4 * lane;
            const f32x4 vj = xr[64 * j];
            const f32x4 w4 = *(const f32x4*)(nw + col), sc = *(const f32x4*)(scale + col), sh = *(const f32x4*)(shift + col);
            f32x4 hv;
#pragma unroll
            for (int i = 0; i < 4; ++i) hv[i] = vj[i] * rstd * w4[i] * (1.f + sc[i]) + sh[i];
            h16x4 o; o[0] = (h16)hv[0]; o[1] = (h16)hv[1]; o[2] = (h16)hv[2]; o[3] = (h16)hv[3];
            *(h16x4*)(hout + (size_t)row * D + col) = o;
#pragma unroll
            for (int i = 0; i < 4; ++i) {
                const f32x4* wp = (const f32x4*)(wr + (size_t)(col + i) * NE);
#pragma unroll
                for (int e4 = 0; e4 < 8; ++e4) { const f32x4 wv = wp[e4];
#pragma unroll
                    for (int e = 0; e < 4; ++e) lg[e4 * 4 + e] += hv[i] * wv[e]; }
            }
        }
#pragma unroll
        for (int e = 0; e < 32; ++e) lg[e] = wave_sum(lg[e]) + br[e];
        unsigned used = 0u; float tv[4]; int te[4];
#pragma unroll
        for (int k = 0; k < 4; ++k) {
            float best = -INFINITY; int bi = 0;
#pragma unroll
            for (int e = 0; e < 32; ++e) { const bool ok = !((used >> e) & 1u) && (lg[e] > best); best = ok ? lg[e] : best; bi = ok ? e : bi; }
            used |= 1u << bi; tv[k] = best; te[k] = bi;
        }
        float ex[4]; float sum = 0.f;
#pragma unroll
        for (int k = 0; k < 4; ++k) { ex[k] = __expf(tv[k] - tv[0]); sum += ex[k]; }
        if (lane < 4) {
            const int e = (lane == 0) ? te[0] : (lane == 1) ? te[1] : (lane == 2) ? te[2] : te[3];
            const float gt = ((lane == 0) ? ex[0] : (lane == 1) ? ex[1] : (lane == 2) ? ex[2] : ex[3]) / sum;
            const int pos = atomicAdd(cnt + e, 1);
            tok[(size_t)e * T + pos] = row;
            asg_e[row * 4 + lane] = e; asg_p[row * 4 + lane] = pos; asg_g[row * 4 + lane] = gt;
        }
    }
}

struct RowGather { const h16* base; const int* list; int nvalid; __device__ __forceinline__ const h16* operator()(int r) const { return (r < nvalid) ? base + (size_t)list[r] * D : nullptr; } };
struct RowAct { const h16* base; int nvalid; __device__ __forceinline__ const h16* operator()(int r) const { return (r < nvalid) ? base + (size_t)r * FE : nullptr; } };
struct ColGateUp { int j0; __device__ __forceinline__ int operator()(int n) const { return (n < 64) ? (j0 + n) : (1024 + j0 + (n - 64)); } };
struct EpiSwiglu {
    h16* act; const float* b1; int nvalid, j0;
    __device__ __forceinline__ void operator()(int r, int n, const float* a) const {
        if (r >= nvalid) return;
        const f32x4 bg = *(const f32x4*)(b1 + j0 + n), bu = *(const f32x4*)(b1 + 1024 + j0 + n);
        h16x4 o;
#pragma unroll
        for (int i = 0; i < 4; ++i) {
            float gt = fminf(a[i] + bg[i], 7.f); float up = fminf(fmaxf(a[4 + i] + bu[i], -7.f), 7.f);
            o[i] = (h16)(gt * sigmoid_f(1.702f * gt) * (up + 1.f));
        }
        *(h16x4*)(act + (size_t)r * FE + j0 + n) = o;
    }
};
struct EpiDown {
    h16* y; const float* b2; int nvalid, n0;
    __device__ __forceinline__ void st(int r, int c, const float* a) const {
        const f32x4 bv = *(const f32x4*)(b2 + c);
        h16x4 o; o[0] = (h16)(a[0] + bv[0]); o[1] = (h16)(a[1] + bv[1]); o[2] = (h16)(a[2] + bv[2]); o[3] = (h16)(a[3] + bv[3]);
        *(h16x4*)(y + (size_t)r * D + c) = o;
    }
    __device__ __forceinline__ void operator()(int r, int n, const float* a) const { if (r >= nvalid) return; st(r, n0 + n, a); st(r, n0 + 64 + n, a + 4); }
};
__device__ __forceinline__ void moe_prefix(const Params& p, int* li) {
    const int* cnt = (const int*)(p.ws + WS_CTL);
    if (threadIdx.x == 0) {
        int b = 0, t = 0;
        for (int e = 0; e < NE; ++e) { li[e] = b; li[40 + e] = t; const int c = cnt[e]; b += c; t += (c + 127) / 128; }
        li[NE] = b; li[40 + NE] = t;
    }
    __syncthreads();
}
__device__ __forceinline__ void phase_moe1(const Params& p, float* lds) {
    int* li = (int*)(lds + 16 * 132 + 16 * 128);
    moe_prefix(p, li);
    const int* cnt = (const int*)(p.ws + WS_CTL); const int* tok = (const int*)(p.ws + WS_TOK);
    const h16* h = (const h16*)(p.ws + WS_H16); h16* act = (h16*)(p.ws + WS_ACT);
    const int ntile = li[40 + NE]; constexpr int NT = FE / 64;
    for (int u = blockIdx.x; u < ntile * NT; u += gridDim.x) {
        const int tl = u / NT, nt = u % NT;
        int e = 0;
        for (int q = 1; q < NE; ++q) if (li[40 + q] <= tl) e = q;
        const int rt = tl - li[40 + e], nvalid = min(128, cnt[e] - rt * 128);
        gemm_tile(lds, D, p.in[14] + (size_t)e * D * 2 * FE, 2 * FE, RowGather{h, tok + (size_t)e * T + rt * 128, nvalid}, ColGateUp{nt * 64},
                  EpiSwiglu{act + (size_t)(li[e] + rt * 128) * FE, p.in[15] + (size_t)e * 2 * FE, nvalid, nt * 64});
    }
}
__device__ __forceinline__ void phase_moe2(const Params& p, float* lds) {
    int* li = (int*)(lds + 16 * 132 + 16 * 128);
    moe_prefix(p, li);
    const int* cnt = (const int*)(p.ws + WS_CTL);
    const h16* act = (const h16*)(p.ws + WS_ACT); h16* y = (h16*)(p.ws + WS_Y16);
    const int ntile = li[40 + NE]; constexpr int NT = D / 128;
    for (int u = blockIdx.x; u < ntile * NT; u += gridDim.x) {
        const int tl = u / NT, nt = u % NT;
        int e = 0;
        for (int q = 1; q < NE; ++q) if (li[40 + q] <= tl) e = q;
        const int rt = tl - li[40 + e], nvalid = min(128, cnt[e] - rt * 128);
        const size_t slot0 = (size_t)(li[e] + rt * 128);
        gemm_tile(lds, FE, p.in[16] + (size_t)e * FE * D, D, RowAct{act + slot0 * FE, nvalid}, ColPlain{nt * 128},
                  EpiDown{y + slot0 * D, p.in[17] + (size_t)e * D, nvalid, nt * 128});
    }
}

__device__ __forceinline__ void phase_final(const Params& p, float* lds) {
    int* li = (int*)lds;
    moe_prefix(p, li);
    const float* x1 = (const float*)(p.ws + WS_X1); const float* mod = (const float*)(p.ws + WS_MOD); const float* fw = p.in[18];
    const h16* y = (const h16*)(p.ws + WS_Y16);
    const int* asg_e = (const int*)(p.ws + WS_ASG_E); const int* asg_p = (const int*)(p.ws + WS_ASG_P); const float* asg_g = (const float*)(p.ws + WS_ASG_G);
    const int tid_ = otid(); const int lane = tid_ & 63, wave = tid_ >> 6;
    const int gw = blockIdx.x * NWAVES + wave, NGW = gridDim.x * NWAVES;
    for (int row = gw; row < T; row += NGW) {
        const int b = row / SEQ; const float* gate2 = mod + b * 6144 + 5120;
        size_t slot[4]; float gk[4];
#pragma unroll
        for (int k = 0; k < 4; ++k) { slot[k] = (size_t)(li[asg_e[row * 4 + k]] + asg_p[row * 4 + k]); gk[k] = asg_g[row * 4 + k]; }
        f32x4 v[4]; float ss = 0.f;
#pragma unroll
        for (int j = 0; j < 4; ++j) {
            const int col = 256 * j + 4 * lane;
            f32x4 acc = (f32x4){0.f, 0.f, 0.f, 0.f};
#pragma unroll
            for (int k = 0; k < 4; ++k) { const h16x4 yv = *(const h16x4*)(y + slot[k] * D + col);
#pragma unroll
                for (int i = 0; i < 4; ++i) acc[i] += gk[k] * (float)yv[i]; }
            const f32x4 xv = *(const f32x4*)(x1 + (size_t)row * D + col), g2 = *(const f32x4*)(gate2 + col);
#pragma unroll
            for (int i = 0; i < 4; ++i) { v[j][i] = xv[i] + g2[i] * acc[i]; ss += v[j][i] * v[j][i]; }
        }
        const float rstd = rsqrtf(wave_sum(ss) * (1.f / D) + EPS);
#pragma unroll
        for (int j = 0; j < 4; ++j) {
            const int col = 256 * j + 4 * lane; const f32x4 w4 = *(const f32x4*)(fw + col);
            f32x4 o; o[0] = v[j][0] * rstd * w4[0]; o[1] = v[j][1] * rstd * w4[1]; o[2] = v[j][2] * rstd * w4[2]; o[3] = v[j][3] * rstd * w4[3];
            *(f32x4*)(p.out + (size_t)row * D + col) = o;
        }
    }
}

constexpr int LDS_BYTES = 65536;
__global__ void __launch_bounds__(NTHREADS) fwd_megakernel(Params p) {
    extern __shared__ __attribute__((aligned(16))) unsigned char lds_raw[];
    float* lds = (float*)lds_raw;
    cg::grid_group grid = cg::this_grid();
    phase_mod(p, lds);
    grid.sync();
    phase_mod1(p);
    grid.sync();
    phase_inproj(p, lds);
    grid.sync();
    phase_dnprep(p);
    grid.sync();
    {
        const int nscan = NB * DH;
        if (gridDim.x >= 2 * nscan) {
            if (blockIdx.x < nscan) phase_scan_naive(p, lds, blockIdx.x);
            else phase_attn_naive(p, blockIdx.x - nscan, gridDim.x - nscan);
        } else {
            for (int bh = blockIdx.x; bh < nscan; bh += gridDim.x) phase_scan_naive(p, lds, bh);
            phase_attn_naive(p, blockIdx.x, gridDim.x);
        }
    }
    grid.sync();
    phase_dnout(p);
    grid.sync();
    phase_outproj(p, lds);
    grid.sync();
    phase_router(p);
    grid.sync();
    phase_moe1(p, lds);
    grid.sync();
    phase_moe2(p, lds);
    grid.sync();
    phase_final(p, lds);
}

extern "C" void kernel_launch(void* const* d_in, const int* in_sizes, int n_in, void* d_out, int out_size, void* d_ws, size_t ws_size, hipStream_t stream) {
    static int grid_blocks = 0;
    if (grid_blocks == 0) {
        if (n_in != 19 || out_size != T * D || ws_size < WS_END) { fprintf(stderr, "kernel_launch: unexpected shapes (n_in %d out %d ws %zu)\n", n_in, out_size, ws_size); grid_blocks = -1; return; }
        int dev = 0, cus = 0, per_cu = 0;
        hipGetDevice(&dev);
        hipDeviceGetAttribute(&cus, hipDeviceAttributeMultiprocessorCount, dev);
        hipFuncSetAttribute((const void*)fwd_megakernel, hipFuncAttributeMaxDynamicSharedMemorySize, LDS_BYTES);
        hipOccupancyMaxActiveBlocksPerMultiprocessor(&per_cu, (const void*)fwd_megakernel, NTHREADS, LDS_BYTES);
        if (per_cu < 1) { fprintf(stderr, "kernel_launch: occupancy query says %d blocks/CU\n", per_cu); grid_blocks = -1; return; }
        grid_blocks = cus;
    }
    if (grid_blocks < 0) return;
    Params p{};
    for (int i = 0; i < 19; ++i) p.in[i] = (const float*)d_in[i];
    p.out = (float*)d_out; p.ws = (unsigned char*)d_ws;
    void* args[] = {&p};
    hipError_t e = hipLaunchCooperativeKernel((const void*)fwd_megakernel, dim3(grid_blocks), dim3(NTHREADS), args, LDS_BYTES, stream);
    if (e != hipSuccess) fprintf(stderr, "cooperative launch failed: %s (grid %d)\n", hipGetErrorString(e), grid_blocks);
}
```

```cpp
#include <hip/hip_runtime.h>
#include <hip/hip_cooperative_groups.h>
#include <cstdio>
#include <cstdint>
namespace cg = cooperative_groups;

typedef _Float16 h16;
typedef _Float16 h16x2 __attribute__((ext_vector_type(2)));
typedef _Float16 h16x4 __attribute__((ext_vector_type(4)));
typedef _Float16 h16x8 __attribute__((ext_vector_type(8)));
typedef float f32x4 __attribute__((ext_vector_type(4)));
typedef float f32x2 __attribute__((ext_vector_type(2)));

constexpr int D = 1024, NB = 4, SEQ = 8192, T = NB * SEQ;
constexpr int AH = 8, AHD = 64, AW = 512;
constexpr int DH = 4, DKD = 128, DW = 512, DCONV = 1536;
constexpr int INC = 3592, INC_MAIN = 3584;
constexpr int NE = 32, TOPK = 4, FE = 1024;
constexpr int NASG = T * TOPK;
constexpr float EPS = 1e-6f;
constexpr int NTHREADS = 512, NWAVES = 8;

constexpr size_t MiB = (size_t)1 << 20;
constexpr size_t WS_CTL = 0;
constexpr size_t WS_MOD = 1 * MiB;
constexpr size_t WS_BA = 2 * MiB;
constexpr size_t WS_G = 3 * MiB;
constexpr size_t WS_ASG_E = 4 * MiB;
constexpr size_t WS_ASG_P = 4 * MiB + 512 * 1024;
constexpr size_t WS_ASG_G = 5 * MiB;
constexpr size_t WS_TOK = 6 * MiB;
constexpr size_t WS_WIN16 = 16 * MiB;
constexpr size_t WS_WOUT16 = 24 * MiB;
constexpr size_t WS_W116 = 32 * MiB;
constexpr size_t WS_W216 = 160 * MiB;
constexpr size_t WS_H16 = 224 * MiB;
constexpr size_t WS_X1 = 288 * MiB;
constexpr size_t WS_R = 416 * MiB;
constexpr size_t WS_Q16 = WS_R;
constexpr size_t WS_K16 = WS_R + 32 * MiB;
constexpr size_t WS_V16 = WS_R + 64 * MiB;
constexpr size_t WS_DQKV = WS_R + 96 * MiB;
constexpr size_t WS_Z16 = WS_R + 192 * MiB;
constexpr size_t WS_QN = WS_R + 224 * MiB;
constexpr size_t WS_KN = WS_R + 256 * MiB;
constexpr size_t WS_VV = WS_R + 288 * MiB;
constexpr size_t WS_O32 = WS_R + 320 * MiB;
constexpr size_t WS_MIX = WS_R + 384 * MiB;
constexpr size_t WS_ACT = WS_R;
constexpr size_t WS_Y16 = WS_R + 272 * MiB;
constexpr size_t WS_END = WS_R + 544 * MiB;

constexpr int LDS_STAGE = 131072, LDS_TAB = LDS_STAGE, LDS_GTAB = LDS_STAGE + 1024, GTAB_UNITS = 18;
constexpr int LDS_BYTES = LDS_GTAB + GTAB_UNITS * 256 * 4;
struct Params { const float* in[19]; float* out; unsigned char* ws; };

__device__ __forceinline__ float wave_sum(float v) {
#pragma unroll
    for (int o = 1; o < 64; o <<= 1) v += __shfl_xor(v, o);
    return v;
}
__device__ __forceinline__ float wave_max(float v) {
#pragma unroll
    for (int o = 1; o < 64; o <<= 1) v = fmaxf(v, __shfl_xor(v, o));
    return v;
}
__device__ __forceinline__ int otid() { int t = threadIdx.x; asm volatile("" : "+v"(t)); return t; }
__device__ __forceinline__ float silu_f(float v) { return v / (1.f + __expf(-v)); }
__device__ __forceinline__ float sigmoid_f(float v) { return 1.f / (1.f + __expf(-v)); }

template <class RowPtr, class ColMap, class Epi>
__device__ __forceinline__ void gemm_tile(float* lds, int K, const float* __restrict__ B, int ldb, RowPtr rowptr, ColMap colmap, Epi epi) {
    float* As = lds;
    float* Bs = lds + 16 * 132;
    const int tid = otid(), ty = tid >> 4, tx = tid & 15;
    const int ar = tid >> 2, ak = (tid & 3) * 4;
    const h16* arow = rowptr(ar);
    const int bk = tid >> 5, bc = (tid & 31) * 4;
    const int bcol = colmap(bc);
    float acc[4][8];
#pragma unroll
    for (int i = 0; i < 4; ++i)
#pragma unroll
        for (int j = 0; j < 8; ++j) acc[i][j] = 0.f;
    for (int k0 = 0; k0 < K; k0 += 16) {
        h16x4 av = (h16x4){(h16)0, (h16)0, (h16)0, (h16)0};
        if (arow) av = *(const h16x4*)(arow + k0 + ak);
        const f32x4 bv = *(const f32x4*)(B + (size_t)(k0 + bk) * ldb + bcol);
        __syncthreads();
        As[(ak + 0) * 132 + ar] = (float)av[0];
        As[(ak + 1) * 132 + ar] = (float)av[1];
        As[(ak + 2) * 132 + ar] = (float)av[2];
        As[(ak + 3) * 132 + ar] = (float)av[3];
        *(f32x4*)(Bs + bk * 128 + bc) = bv;
        __syncthreads();
#pragma unroll
        for (int k = 0; k < 16; ++k) {
            const f32x4 a = *(const f32x4*)(As + k * 132 + ty * 4);
            const f32x4 b0 = *(const f32x4*)(Bs + k * 128 + tx * 4);
            const f32x4 b1 = *(const f32x4*)(Bs + k * 128 + 64 + tx * 4);
#pragma unroll
            for (int i = 0; i < 4; ++i)
#pragma unroll
                for (int j = 0; j < 4; ++j) { acc[i][j] += a[i] * b0[j]; acc[i][4 + j] += a[i] * b1[j]; }
        }
    }
#pragma unroll
    for (int i = 0; i < 4; ++i) epi(ty * 4 + i, tx * 4, acc[i]);
}


namespace pg8 {
#define PG8_LAS __attribute__((address_space(3)))
constexpr int BM = 256, BK = 64, HALF = 128, HTB = HALF * BK * 2, STAGE_BYTES = 8 * HTB, NXCD = 8, WGM = 8;
__device__ __forceinline__ int lds_byte(int r, int c) { const int st = (r >> 4) * 2 + (c >> 5), rr = r & 15, cc = c & 31, ob = rr * 64 + cc * 2; return st * 1024 + (ob ^ (((ob >> 9) & 1) << 5)); }
__device__ __forceinline__ void stage_rc(int b, int& R, int& C) { const int st = b / 1024, sb = b % 1024, swz = sb ^ (((sb >> 9) & 1) << 5); R = (st >> 1) * 16 + swz / 64; C = (st & 1) * 32 + (swz % 64) / 2; }
__device__ __forceinline__ int perm32(int rho) { const int n = rho >> 4, i = rho & 15; return 8 * (i >> 2) + 4 * n + (i & 3); }

struct Unit { int pm, pn, e; };
struct Gemm { const h16* A; const h16* Bt; int N, K; };

struct Order {
    int nM, nN, nwg, G, c; PG8_LAS const int* tstart;
    __device__ __forceinline__ void init(int nM_, int nN_, int G_, int c_, PG8_LAS const int* ts) { nM = nM_; nN = nN_; nwg = nM * nN; G = G_; c = c_; tstart = ts; }
    __device__ __forceinline__ bool next(int i, Unit& u) const {
        const long L = (long)i * G + c; if (L >= nwg) return false;
        int wgid = (int)L; { const int q = nwg / NXCD, r = nwg % NXCD, xcd = wgid % NXCD, off = wgid / NXCD; wgid = (xcd < r ? xcd * (q + 1) : r * (q + 1) + (xcd - r) * q) + off; }
        const int nig = WGM * nN, gid = wgid / nig, fm = gid * WGM, gsz = (nM - fm) < WGM ? (nM - fm) : WGM;
        u.pm = fm + ((wgid % nig) % gsz); u.pn = (wgid % nig) / gsz;
        int e = 0;
        if (tstart) { for (int q = 1; q < 32; ++q) if (tstart[q] <= u.pm) e = q; }
        u.e = e; return true;
    }
};

template <class Epi, bool GATHER>
__device__ __forceinline__ void gemm_phase(PG8_LAS unsigned char* lds, const Gemm g, const Order& S, const Epi& E, PG8_LAS const int* gtab) {
    const int tid = otid(), wid = __builtin_amdgcn_readfirstlane(tid >> 6), lane = tid & 63, wr = wid >> 2, wc = wid & 3, fr = lane & 15, fq = lane >> 4;
    const int K = g.K, nt = K / BK;
    unsigned voffB[2]; int RA[2]; unsigned CA2[2];
#pragma unroll
    for (int i = 0; i < 2; ++i) { int R, C; stage_rc(tid * 16 + i * 8192, R, C); const int Rb = Epi::PERM ? ((R & ~31) + perm32(R & 31)) : R;
        RA[i] = R; CA2[i] = (unsigned)C * 2u; voffB[i] = (unsigned)(Rb * K + C) * 2u; }
    const size_t kstep = (size_t)(BK * 2);
    const size_t hstep = (size_t)HALF * K * 2;
    const size_t tstep = 2 * hstep;
    const unsigned ldsw = (unsigned)wid * 1024u;
    const int aoff = lds_byte(wr * 64 + fr, fq * 8), boff = lds_byte(wc * 32 + fr, fq * 8);
#define PG8_SA(b, h) (((b) * 2 + (h)) * HTB)
#define PG8_SB(b, h) ((4 + (b) * 2 + (h)) * HTB)
#define PG8_STAGE(bufoff, gbase, voff) do { _Pragma("unroll") for (int _i = 0; _i < 2; ++_i) \
        __builtin_amdgcn_global_load_lds((const unsigned*)((const char*)(gbase) + (voff)[_i]), (PG8_LAS unsigned*)(lds + (bufoff) + ldsw + _i * 8192), 16, 0, 0); } while (0)
#define PG8_LDA(dst, b, h) do { _Pragma("unroll") for (int m = 0; m < 4; ++m) _Pragma("unroll") for (int k = 0; k < 2; ++k) dst[m][k] = *(const PG8_LAS h16x8*)(lds + PG8_SA(b, h) + aoff + m * 2048 + k * 1024); } while (0)
#define PG8_LDB(dst, b, h) do { _Pragma("unroll") for (int n = 0; n < 2; ++n) _Pragma("unroll") for (int k = 0; k < 2; ++k) dst[n][k] = *(const PG8_LAS h16x8*)(lds + PG8_SB(b, h) + boff + n * 2048 + k * 1024); } while (0)
#define PG8_MMA(ai, bj, At, Bt) do { __builtin_amdgcn_s_setprio(1); _Pragma("unroll") for (int m = 0; m < 4; ++m) _Pragma("unroll") for (int n = 0; n < 2; ++n) _Pragma("unroll") for (int k = 0; k < 2; ++k) \
        acc[ai][bj][m][n] = __builtin_amdgcn_mfma_f32_16x16x32_f16(Bt[n][k], At[m][k], acc[ai][bj][m][n], 0, 0, 0); __builtin_amdgcn_s_setprio(0); } while (0)
#define PG8_WAIT_V(n) asm volatile("s_waitcnt vmcnt(" #n ")" ::: "memory")
#define PG8_WAIT_L(n) asm volatile("s_waitcnt lgkmcnt(" #n ")" ::: "memory")
#define PG8_BAR __builtin_amdgcn_s_barrier()
#define PG8_SCHED __builtin_amdgcn_sched_barrier(0)
#define PG8_AOFF(o, u, uix) do { _Pragma("unroll") for (int _h = 0; _h < 2; ++_h) _Pragma("unroll") for (int _i = 0; _i < 2; ++_i) { \
        const int _r = _h * HALF + RA[_i]; const unsigned _src = GATHER ? (unsigned)gtab[(uix) * BM + _r] : (unsigned)((u).pm * BM + _r); \
        o[_h][_i] = _src * (unsigned)(K * 2) + CA2[_i]; } } while (0)
    Unit cur, nxt; int ui = 0;
    if (!S.next(0, cur)) return;
    f32x4 acc[2][2][4][2];
#pragma unroll
    for (int a = 0; a < 2; ++a)
#pragma unroll
        for (int b = 0; b < 2; ++b)
#pragma unroll
            for (int m = 0; m < 4; ++m)
#pragma unroll
                for (int n = 0; n < 2; ++n) acc[a][b][m][n] = (f32x4){0.f, 0.f, 0.f, 0.f};
    h16x8 At[4][2], B0[2][2], B1[2][2];
    unsigned oc[2][2], on[2][2];
    PG8_AOFF(oc, cur, 0);
    const char* const A0 = (const char*)g.A;
    const char* cB = (const char*)g.Bt + ((size_t)cur.e * g.N + (size_t)cur.pn * BM) * K * 2;
    PG8_STAGE(PG8_SB(0, 0), cB, voffB); PG8_STAGE(PG8_SB(0, 1), cB + hstep, voffB); PG8_STAGE(PG8_SA(0, 0), A0, oc[0]); PG8_STAGE(PG8_SA(0, 1), A0, oc[1]);
    if (wr == 1) PG8_BAR;
    PG8_WAIT_V(2); PG8_BAR;
    PG8_STAGE(PG8_SB(1, 0), cB + kstep, voffB); PG8_STAGE(PG8_SA(1, 0), A0 + kstep, oc[0]); PG8_STAGE(PG8_SB(1, 1), cB + hstep + kstep, voffB);
    PG8_WAIT_V(6); PG8_BAR;
    for (;;) {
        const bool has_next = S.next(ui + 1, nxt);
        const char* nB = cB;
        if (has_next) { nB = (const char*)g.Bt + ((size_t)nxt.e * g.N + (size_t)nxt.pn * BM) * K * 2; PG8_AOFF(on, nxt, ui + 1); }
        else {
#pragma unroll
            for (int h = 0; h < 2; ++h)
#pragma unroll
                for (int i = 0; i < 2; ++i) on[h][i] = oc[h][i];
        }
        for (int t = 0; t < nt; t += 2) {
            const bool last = (t == nt - 2);
            const char* a1 = A0 + (size_t)(t + 1) * kstep;
            const char* a2 = last ? A0 : A0 + (size_t)(t + 2) * kstep; const char* b2 = last ? nB : cB + (size_t)(t + 2) * kstep;
            const char* a3 = a2 + kstep; const char* b3 = b2 + kstep;
            unsigned o2[2][2];
#pragma unroll
            for (int h = 0; h < 2; ++h)
#pragma unroll
                for (int i = 0; i < 2; ++i) o2[h][i] = last ? on[h][i] : oc[h][i];
            PG8_LDB(B0, 0, 0); PG8_LDB(B1, 0, 1); PG8_SCHED; PG8_LDA(At, 0, 0); PG8_STAGE(PG8_SA(1, 1), a1, oc[1]);
            PG8_WAIT_V(8); PG8_WAIT_L(0); PG8_BAR; PG8_MMA(0, 0, At, B0); PG8_MMA(0, 1, At, B1); PG8_BAR; PG8_SCHED;
            PG8_LDA(At, 0, 1); PG8_STAGE(PG8_SB(0, 0), b2, voffB); PG8_STAGE(PG8_SB(0, 1), b2 + hstep, voffB); PG8_STAGE(PG8_SA(0, 0), a2, o2[0]);
            PG8_WAIT_V(8); PG8_WAIT_L(0); PG8_BAR; PG8_MMA(1, 0, At, B0); PG8_MMA(1, 1, At, B1); PG8_BAR; PG8_SCHED;
            PG8_LDB(B0, 1, 0); PG8_LDB(B1, 1, 1); PG8_SCHED; PG8_LDA(At, 1, 0); PG8_STAGE(PG8_SA(0, 1), a2, o2[1]);
            PG8_WAIT_V(8); PG8_WAIT_L(0); PG8_BAR; PG8_MMA(0, 0, At, B0); PG8_MMA(0, 1, At, B1); PG8_BAR; PG8_SCHED;
            PG8_LDA(At, 1, 1); PG8_STAGE(PG8_SB(1, 0), b3, voffB); PG8_STAGE(PG8_SB(1, 1), b3 + hstep, voffB); PG8_STAGE(PG8_SA(1, 0), a3, o2[0]);
            PG8_WAIT_V(8); PG8_WAIT_L(0); PG8_BAR; PG8_MMA(1, 0, At, B0); PG8_MMA(1, 1, At, B1); PG8_BAR; PG8_SCHED;
        }
        if (wr == 0) PG8_BAR;
        E(acc, cur, wr, wc, fr, fq);
        if (!has_next) break;
#pragma unroll
        for (int a = 0; a < 2; ++a)
#pragma unroll
            for (int b = 0; b < 2; ++b)
#pragma unroll
                for (int m = 0; m < 4; ++m)
#pragma unroll
                    for (int n = 0; n < 2; ++n) acc[a][b][m][n] = (f32x4){0.f, 0.f, 0.f, 0.f};
        cur = nxt; cB = nB; ++ui;
#pragma unroll
        for (int h = 0; h < 2; ++h)
#pragma unroll
            for (int i = 0; i < 2; ++i) oc[h][i] = on[h][i];
        if (wr == 1) PG8_BAR;
    }
    PG8_WAIT_V(0);
    PG8_BAR;
#undef PG8_SA
#undef PG8_SB
#undef PG8_STAGE
#undef PG8_LDA
#undef PG8_LDB
#undef PG8_MMA
#undef PG8_WAIT_V
#undef PG8_WAIT_L
#undef PG8_BAR
#undef PG8_SCHED
#undef PG8_AOFF
}
}

__device__ __forceinline__ void phase_mod(const Params& p, float* lds) {
    const float* c = p.in[1]; const float* w = p.in[2]; const float* bias = p.in[3];
    float* mod = (float*)(p.ws + WS_MOD);
    const int tid = otid();
    for (int i = tid; i < 4096; i += NTHREADS) lds[i] = silu_f(c[i]);
    __syncthreads();
    float* red = lds + 4096;
    for (int cb = blockIdx.x; cb < 192; cb += gridDim.x) {
        const int cc = tid & 31, col = cb * 32 + cc, ks = tid >> 5;
        float a0 = 0.f, a1 = 0.f, a2 = 0.f, a3 = 0.f;
        for (int k = ks * 64; k < ks * 64 + 64; ++k) {
            const float wv = w[(size_t)k * 6144 + col];
            a0 += lds[k] * wv; a1 += lds[1024 + k] * wv; a2 += lds[2048 + k] * wv; a3 += lds[3072 + k] * wv;
        }
        red[(ks * 4 + 0) * 32 + cc] = a0; red[(ks * 4 + 1) * 32 + cc] = a1; red[(ks * 4 + 2) * 32 + cc] = a2; red[(ks * 4 + 3) * 32 + cc] = a3;
        __syncthreads();
        if (tid < 128) {
            const int b = tid >> 5; float s = 0.f;
            for (int q = 0; q < 16; ++q) s += red[(q * 4 + b) * 32 + cc];
            mod[b * 6144 + col] = s + bias[col];
        }
        __syncthreads();
    }
    if (blockIdx.x == 0 && tid < 64) ((int*)(p.ws + WS_CTL))[tid] = 0;
}

__device__ __forceinline__ void phase_mod1(const Params& p) {
    const float* x = p.in[0]; const float* nw = p.in[4]; const float* w_in = p.in[5];
    const float* mod = (const float*)(p.ws + WS_MOD);
    h16* hout = (h16*)(p.ws + WS_H16); float* ba = (float*)(p.ws + WS_BA);
    const int tid_ = otid(); const int lane = tid_ & 63, wave = tid_ >> 6;
    const int gw = blockIdx.x * NWAVES + wave, NGW = gridDim.x * NWAVES;
    for (int row = gw; row < T; row += NGW) {
        const int b = row / SEQ;
        const float* shift = mod + b * 6144; const float* scale = shift + 1024;
        const f32x4* xr = (const f32x4*)(x + (size_t)row * D) + lane;
        f32x4 v[4]; float ss = 0.f;
#pragma unroll
        for (int j = 0; j < 4; ++j) { v[j] = xr[64 * j]; ss += v[j][0] * v[j][0] + v[j][1] * v[j][1] + v[j][2] * v[j][2] + v[j][3] * v[j][3]; }
        const float rstd = rsqrtf(wave_sum(ss) * (1.f / D) + EPS);
        float pb[8];
#pragma unroll
        for (int e = 0; e < 8; ++e) pb[e] = 0.f;
#pragma unroll
        for (int j = 0; j < 4; ++j) {
            const int col = 256 * j + 4 * lane;
            const f32x4 w4 = *(const f32x4*)(nw + col), sc = *(const f32x4*)(scale + col), sh = *(const f32x4*)(shift + col);
            f32x4 hv;
#pragma unroll
            for (int i = 0; i < 4; ++i) hv[i] = v[j][i] * rstd * w4[i] * (1.f + sc[i]) + sh[i];
            h16x4 o; o[0] = (h16)hv[0]; o[1] = (h16)hv[1]; o[2] = (h16)hv[2]; o[3] = (h16)hv[3];
            *(h16x4*)(hout + (size_t)row * D + col) = o;
#pragma unroll
            for (int i = 0; i < 4; ++i) {
                const f32x4 wa = *(const f32x4*)(w_in + (size_t)(col + i) * INC + INC_MAIN);
                const f32x4 wb = *(const f32x4*)(w_in + (size_t)(col + i) * INC + INC_MAIN + 4);
#pragma unroll
                for (int e = 0; e < 4; ++e) { pb[e] += hv[i] * wa[e]; pb[4 + e] += hv[i] * wb[e]; }
            }
        }
#pragma unroll
        for (int e = 0; e < 8; ++e) pb[e] = wave_sum(pb[e]);
        if (lane == 0) {
            *(f32x4*)(ba + (size_t)row * 8) = (f32x4){pb[0], pb[1], pb[2], pb[3]};
            *(f32x4*)(ba + (size_t)row * 8 + 4) = (f32x4){pb[4], pb[5], pb[6], pb[7]};
        }
    }
}

struct RowPlain { const h16* base; int row0; __device__ __forceinline__ const h16* operator()(int r) const { return base + (size_t)(row0 + r) * D; } };
struct ColPlain { int n0; __device__ __forceinline__ int operator()(int n) const { return n0 + n; } };
struct EpiInProj {
    unsigned char* ws; int row0, n0;
    __device__ __forceinline__ void st(int row, int c, const float* a) const {
        h16* dst; int ld, cc;
        if (c < 512) { dst = (h16*)(ws + WS_Q16); ld = 512; cc = c; }
        else if (c < 1024) { dst = (h16*)(ws + WS_K16); ld = 512; cc = c - 512; }
        else if (c < 1536) { dst = (h16*)(ws + WS_V16); ld = 512; cc = c - 1024; }
        else if (c < 3072) { dst = (h16*)(ws + WS_DQKV); ld = 1536; cc = c - 1536; }
        else { dst = (h16*)(ws + WS_Z16); ld = 512; cc = c - 3072; }
        h16x4 o; o[0] = (h16)a[0]; o[1] = (h16)a[1]; o[2] = (h16)a[2]; o[3] = (h16)a[3];
        *(h16x4*)(dst + (size_t)row * ld + cc) = o;
    }
    __device__ __forceinline__ void operator()(int r, int n, const float* a) const { st(row0 + r, n0 + n, a); st(row0 + r, n0 + 64 + n, a + 4); }
};
__device__ __forceinline__ void phase_inproj(const Params& p, float* lds) {
    const h16* h = (const h16*)(p.ws + WS_H16);
    constexpr int NT = INC_MAIN / 128, MT = T / 128;
    for (int u = blockIdx.x; u < NT * MT; u += gridDim.x) {
        const int mt = u / NT, nt = u % NT;
        gemm_tile(lds, D, p.in[5], INC, RowPlain{h, mt * 128}, ColPlain{nt * 128}, EpiInProj{p.ws, mt * 128, nt * 128});
    }
}

__device__ __forceinline__ void phase_dnprep(const Params& p) {
    const h16* dqkv = (const h16*)(p.ws + WS_DQKV);
    const float* cw = p.in[6]; const float* A_log = p.in[7]; const float* dt_bias = p.in[8];
    const float* ba = (const float*)(p.ws + WS_BA);
    h16* qn = (h16*)(p.ws + WS_QN); h16* kn = (h16*)(p.ws + WS_KN); h16* vv = (h16*)(p.ws + WS_VV);
    float* g = (float*)(p.ws + WS_G); float* beta = g + (size_t)T * 4;
    const int tid_ = otid(); const int lane = tid_ & 63, wave = tid_ >> 6;
    const int gw = blockIdx.x * NWAVES + wave, NGW = gridDim.x * NWAVES;
    for (int it = gw; it < T * DH; it += NGW) {
        const int row = it >> 2, hd = it & 3, tpos = row % SEQ;
        float y[3][2];
#pragma unroll
        for (int part = 0; part < 3; ++part) {
            const int ch = part * 512 + hd * 128 + 2 * lane;
            float a0 = 0.f, a1 = 0.f;
#pragma unroll
            for (int j = 0; j < 4; ++j) {
                const int tt = tpos - 3 + j;
                if (tt >= 0) {
                    const h16x2 xv = *(const h16x2*)(dqkv + (size_t)(row - 3 + j) * DCONV + ch);
                    const f32x2 wv = *(const f32x2*)(cw + j * DCONV + ch);
                    a0 += (float)xv[0] * wv[0]; a1 += (float)xv[1] * wv[1];
                }
            }
            y[part][0] = silu_f(a0); y[part][1] = silu_f(a1);
        }
        const float sq = wave_sum(y[0][0] * y[0][0] + y[0][1] * y[0][1]);
        const float sk = wave_sum(y[1][0] * y[1][0] + y[1][1] * y[1][1]);
        const float rq = rsqrtf(sq + EPS) * 0.08838834764831845f, rk = rsqrtf(sk + EPS);
        const size_t o = (size_t)row * DW + hd * 128 + 2 * lane;
        h16x2 t2;
        t2[0] = (h16)(y[0][0] * rq); t2[1] = (h16)(y[0][1] * rq); *(h16x2*)(qn + o) = t2;
        t2[0] = (h16)(y[1][0] * rk); t2[1] = (h16)(y[1][1] * rk); *(h16x2*)(kn + o) = t2;
        t2[0] = (h16)y[2][0]; t2[1] = (h16)y[2][1]; *(h16x2*)(vv + o) = t2;
        if (lane == 0) {
            const float dbv = ba[(size_t)row * 8 + hd], dav = ba[(size_t)row * 8 + 4 + hd];
            const float xsp = dav + dt_bias[hd];
            const float sp = (xsp > 20.f) ? xsp : log1pf(__expf(xsp));
            g[(size_t)row * 4 + hd] = -__expf(A_log[hd]) * sp;
            beta[(size_t)row * 4 + hd] = sigmoid_f(dbv);
        }
    }
}

__device__ __forceinline__ void phase_scan_naive(const Params& p, float* ldsf, int bh) {
    const h16* qn = (const h16*)(p.ws + WS_QN); const h16* kn = (const h16*)(p.ws + WS_KN); const h16* vv = (const h16*)(p.ws + WS_VV);
    const float* g = (const float*)(p.ws + WS_G); const float* beta = g + (size_t)T * 4;
    float* o32 = (float*)(p.ws + WS_O32);
    h16* qs = (h16*)ldsf; h16* ks = qs + 64 * 128; h16* vs = ks + 64 * 128; float* gs = (float*)(vs + 64 * 128); float* bs = gs + 64;
    const int tid = otid(), b = bh >> 2, hd = bh & 3;
    float S[64];
#pragma unroll
    for (int i = 0; i < 64; ++i) S[i] = 0.f;
    const int col = tid >> 1, hf = tid & 1;
    for (int chunk = 0; chunk < SEQ / 64; ++chunk) {
        const size_t t0 = (size_t)b * SEQ + chunk * 64;
        for (int i = tid; i < 1024; i += NTHREADS) {
            const int r = i >> 4, c = (i & 15) * 8; const size_t go = (t0 + r) * DW + hd * 128 + c;
            *(h16x8*)(qs + r * 128 + c) = *(const h16x8*)(qn + go);
            *(h16x8*)(ks + r * 128 + c) = *(const h16x8*)(kn + go);
            *(h16x8*)(vs + r * 128 + c) = *(const h16x8*)(vv + go);
        }
        if (tid < 64) { gs[tid] = g[(t0 + tid) * 4 + hd]; bs[tid] = beta[(t0 + tid) * 4 + hd]; }
        __syncthreads();
        if (tid < 256) {
            for (int s = 0; s < 64; ++s) {
                const float eg = __expf(gs[s]), bt = bs[s];
                float dot = 0.f;
#pragma unroll
                for (int i = 0; i < 64; i += 8) {
                    const h16x8 kk = *(const h16x8*)(ks + s * 128 + hf * 64 + i);
#pragma unroll
                    for (int j = 0; j < 8; ++j) dot += (float)kk[j] * S[i + j];
                }
                dot += __shfl_xor(dot, 1);
                const float vn = bt * ((float)vs[s * 128 + col] - eg * dot);
                float o = 0.f;
#pragma unroll
                for (int i = 0; i < 64; i += 8) {
                    const h16x8 kk = *(const h16x8*)(ks + s * 128 + hf * 64 + i);
                    const h16x8 qq = *(const h16x8*)(qs + s * 128 + hf * 64 + i);
#pragma unroll
                    for (int j = 0; j < 8; ++j) { S[i + j] = eg * S[i + j] + (float)kk[j] * vn; o += (float)qq[j] * S[i + j]; }
                }
                o += __shfl_xor(o, 1);
                if (hf == 0) o32[(t0 + s) * DW + hd * 128 + col] = o;
            }
        }
        __syncthreads();
    }
}

__device__ __forceinline__ void phase_attn_naive(const Params& p, int vblock, int nvblocks) {
    const h16* q16 = (const h16*)(p.ws + WS_Q16); const h16* k16 = (const h16*)(p.ws + WS_K16); const h16* v16 = (const h16*)(p.ws + WS_V16);
    h16* mix = (h16*)(p.ws + WS_MIX);
    const int tid_ = otid(); const int lane = tid_ & 63, wave = tid_ >> 6;
    const int gw = vblock * NWAVES + wave, NGW = nvblocks * NWAVES;
    for (int it = gw; it < T * AH; it += NGW) {
        const int row = it >> 3, hd = it & 7, tpos = row % SEQ;
        float q[64];
        {
            const h16x8* qp = (const h16x8*)(q16 + (size_t)row * AW + hd * 64);
#pragma unroll
            for (int i = 0; i < 8; ++i) { const h16x8 t8 = qp[i];
#pragma unroll
                for (int j = 0; j < 8; ++j) q[i * 8 + j] = (float)t8[j]; }
        }
        float s[7]; int tk[7];
        float m = -INFINITY;
#pragma unroll
        for (int e = 0; e < 7; ++e) {
            const int idx = e * 64 + lane;
            const int br = idx / 129, j = idx - br * 129;
            const int dil = (br == 0) ? 1 : ((br == 1) ? 4 : 16);
            const int tkk = tpos - j * dil;
            const bool valid = (idx < 387) && (tkk >= 0);
            tk[e] = valid ? (row - j * dil) : -1;
            float sc = -INFINITY;
            if (valid) {
                const h16x8* kp = (const h16x8*)(k16 + (size_t)(row - j * dil) * AW + hd * 64);
                float acc = 0.f;
#pragma unroll
                for (int i = 0; i < 8; ++i) { const h16x8 t8 = kp[i];
#pragma unroll
                    for (int jj = 0; jj < 8; ++jj) acc += q[i * 8 + jj] * (float)t8[jj]; }
                sc = acc * 0.125f;
            }
            s[e] = sc; m = fmaxf(m, sc);
        }
        m = wave_max(m);
        float l = 0.f;
#pragma unroll
        for (int e = 0; e < 7; ++e) { s[e] = (tk[e] >= 0) ? __expf(s[e] - m) : 0.f; l += s[e]; }
        l = wave_sum(l);
        float o = 0.f;
#pragma unroll
        for (int e = 0; e < 7; ++e) {
            const int nsrc = (e < 6) ? 64 : 3;
            for (int src = 0; src < nsrc; ++src) {
                const float pp = __shfl(s[e], src); const int tr = __shfl(tk[e], src);
                if (tr >= 0) o += pp * (float)v16[(size_t)tr * AW + hd * 64 + lane];
            }
        }
        mix[(size_t)row * D + hd * 64 + lane] = (h16)(o / l);
    }
}

__device__ __forceinline__ void phase_dnout(const Params& p) {
    const float* o32 = (const float*)(p.ws + WS_O32); const h16* z16 = (const h16*)(p.ws + WS_Z16); const float* nw = p.in[9];
    h16* mix = (h16*)(p.ws + WS_MIX);
    const int tid_ = otid(); const int lane = tid_ & 63, wave = tid_ >> 6;
    const int gw = blockIdx.x * NWAVES + wave, NGW = gridDim.x * NWAVES;
    for (int it = gw; it < T * DH; it += NGW) {
        const int row = it >> 2, hd = it & 3;
        const f32x2 ov = *(const f32x2*)(o32 + (size_t)row * DW + hd * 128 + 2 * lane);
        const float rstd = rsqrtf(wave_sum(ov[0] * ov[0] + ov[1] * ov[1]) * (1.f / 128.f) + EPS);
        const h16x2 zv = *(const h16x2*)(z16 + (size_t)row * DW + hd * 128 + 2 * lane);
        const f32x2 w2 = *(const f32x2*)(nw + 2 * lane);
        h16x2 r; r[0] = (h16)(ov[0] * rstd * w2[0] * silu_f((float)zv[0])); r[1] = (h16)(ov[1] * rstd * w2[1] * silu_f((float)zv[1]));
        *(h16x2*)(mix + (size_t)row * D + 512 + hd * 128 + 2 * lane) = r;
    }
}

struct EpiOutProj {
    const float* x; const float* mod; float* x1; int row0, n0;
    __device__ __forceinline__ void st(int row, int c, const float* a) const {
        const int b = row / SEQ; const f32x4 gt = *(const f32x4*)(mod + b * 6144 + 2048 + c); const f32x4 xv = *(const f32x4*)(x + (size_t)row * D + c);
        f32x4 o; o[0] = xv[0] + gt[0] * a[0]; o[1] = xv[1] + gt[1] * a[1]; o[2] = xv[2] + gt[2] * a[2]; o[3] = xv[3] + gt[3] * a[3];
        *(f32x4*)(x1 + (size_t)row * D + c) = o;
    }
    __device__ __forceinline__ void operator()(int r, int n, const float* a) const { st(row0 + r, n0 + n, a); st(row0 + r, n0 + 64 + n, a + 4); }
};
__device__ __forceinline__ void phase_outproj(const Params& p, float* lds) {
    const h16* mix = (const h16*)(p.ws + WS_MIX);
    constexpr int NT = D / 128, MT = T / 128;
    for (int u = blockIdx.x; u < NT * MT; u += gridDim.x) {
        const int mt = u / NT, nt = u % NT;
        gemm_tile(lds, D, p.in[10], D, RowPlain{mix, mt * 128}, ColPlain{nt * 128},
                  EpiOutProj{p.in[0], (const float*)(p.ws + WS_MOD), (float*)(p.ws + WS_X1), mt * 128, nt * 128});
    }
}

__device__ __forceinline__ void phase_router(const Params& p) {
    const float* x1 = (const float*)(p.ws + WS_X1); const float* nw = p.in[11]; const float* wr = p.in[12]; const float* br = p.in[13];
    const float* mod = (const float*)(p.ws + WS_MOD);
    h16* hout = (h16*)(p.ws + WS_H16);
    int* cnt = (int*)(p.ws + WS_CTL); int* tok = (int*)(p.ws + WS_TOK);
    int* asg_e = (int*)(p.ws + WS_ASG_E); int* asg_p = (int*)(p.ws + WS_ASG_P); float* asg_g = (float*)(p.ws + WS_ASG_G);
    const int tid_ = otid(); const int lane = tid_ & 63, wave = tid_ >> 6;
    const int gw = blockIdx.x * NWAVES + wave, NGW = gridDim.x * NWAVES;
    for (int row = gw; row < T; row += NGW) {
        const int b = row / SEQ;
        const float* shift = mod + b * 6144 + 3072; const float* scale = shift + 1024;
        const f32x4* xr = (const f32x4*)(x1 + (size_t)row * D) + lane;
        float ss = 0.f;
#pragma unroll
        for (int j = 0; j < 4; ++j) { const f32x4 t4 = xr[64 * j]; ss += t4[0] * t4[0] + t4[1] * t4[1] + t4[2] * t4[2] + t4[3] * t4[3]; }
        const float rstd = rsqrtf(wave_sum(ss) * (1.f / D) + EPS);
        float lg[32];
#pragma unroll
        for (int e = 0; e < 32; ++e) lg[e] = 0.f;
#pragma unroll 1
        for (int j = 0; j < 4; ++j) {
            const int col = 256 * j + 4 * lane;
            const f32x4 vj = xr[64 * j];
            const f32x4 w4 = *(const f32x4*)(nw + col), sc = *(const f32x4*)(scale + col), sh = *(const f32x4*)(shift + col);
            f32x4 hv;
#pragma unroll
            for (int i = 0; i < 4; ++i) hv[i] = vj[i] * rstd * w4[i] * (1.f + sc[i]) + sh[i];
            h16x4 o; o[0] = (h16)hv[0]; o[1] = (h16)hv[1]; o[2] = (h16)hv[2]; o[3] = (h16)hv[3];
            *(h16x4*)(hout + (size_t)row * D + col) = o;
#pragma unroll
            for (int i = 0; i < 4; ++i) {
                const f32x4* wp = (const f32x4*)(wr + (size_t)(col + i) * NE);
#pragma unroll
                for (int e4 = 0; e4 < 8; ++e4) { const f32x4 wv = wp[e4];
#pragma unroll
                    for (int e = 0; e < 4; ++e) lg[e4 * 4 + e] += hv[i] * wv[e]; }
            }
        }
#pragma unroll
        for (int e = 0; e < 32; ++e) lg[e] = wave_sum(lg[e]) + br[e];
        unsigned used = 0u; float tv[4]; int te[4];
#pragma unroll
        for (int k = 0; k < 4; ++k) {
            float best = -INFINITY; int bi = 0;
#pragma unroll
            for (int e = 0; e < 32; ++e) { const bool ok = !((used >> e) & 1u) && (lg[e] > best); best = ok ? lg[e] : best; bi = ok ? e : bi; }
            used |= 1u << bi; tv[k] = best; te[k] = bi;
        }
        float ex[4]; float sum = 0.f;
#pragma unroll
        for (int k = 0; k < 4; ++k) { ex[k] = __expf(tv[k] - tv[0]); sum += ex[k]; }
        if (lane < 4) {
            const int e = (lane == 0) ? te[0] : (lane == 1) ? te[1] : (lane == 2) ? te[2] : te[3];
            const float gt = ((lane == 0) ? ex[0] : (lane == 1) ? ex[1] : (lane == 2) ? ex[2] : ex[3]) / sum;
            const int pos = atomicAdd(cnt + e, 1);
            tok[(size_t)e * T + pos] = row;
            asg_e[row * 4 + lane] = e; asg_p[row * 4 + lane] = pos; asg_g[row * 4 + lane] = gt;
        }
    }
}

struct RowGather { const h16* base; const int* list; int nvalid; __device__ __forceinline__ const h16* operator()(int r) const { return (r < nvalid) ? base + (size_t)list[r] * D : nullptr; } };
struct RowAct { const h16* base; int nvalid; __device__ __forceinline__ const h16* operator()(int r) const { return (r < nvalid) ? base + (size_t)r * FE : nullptr; } };
struct ColGateUp { int j0; __device__ __forceinline__ int operator()(int n) const { return (n < 64) ? (j0 + n) : (1024 + j0 + (n - 64)); } };
struct EpiSwiglu {
    h16* act; const float* b1; int nvalid, j0;
    __device__ __forceinline__ void operator()(int r, int n, const float* a) const {
        if (r >= nvalid) return;
        const f32x4 bg = *(const f32x4*)(b1 + j0 + n), bu = *(const f32x4*)(b1 + 1024 + j0 + n);
        h16x4 o;
#pragma unroll
        for (int i = 0; i < 4; ++i) {
            float gt = fminf(a[i] + bg[i], 7.f); float up = fminf(fmaxf(a[4 + i] + bu[i], -7.f), 7.f);
            o[i] = (h16)(gt * sigmoid_f(1.702f * gt) * (up + 1.f));
        }
        *(h16x4*)(act + (size_t)r * FE + j0 + n) = o;
    }
};
struct EpiDown {
    h16* y; const float* b2; int nvalid, n0;
    __device__ __forceinline__ void st(int r, int c, const float* a) const {
        const f32x4 bv = *(const f32x4*)(b2 + c);
        h16x4 o; o[0] = (h16)(a[0] + bv[0]); o[1] = (h16)(a[1] + bv[1]); o[2] = (h16)(a[2] + bv[2]); o[3] = (h16)(a[3] + bv[3]);
        *(h16x4*)(y + (size_t)r * D + c) = o;
    }
    __device__ __forceinline__ void operator()(int r, int n, const float* a) const { if (r >= nvalid) return; st(r, n0 + n, a); st(r, n0 + 64 + n, a + 4); }
};
__device__ __forceinline__ void moe_prefix(const Params& p, int* li) {
    const int* cnt = (const int*)(p.ws + WS_CTL);
    if (threadIdx.x == 0) {
        int b = 0, t = 0;
        for (int e = 0; e < NE; ++e) { li[e] = b; li[40 + e] = t; const int c = cnt[e]; b += c; t += (c + 127) / 128; }
        li[NE] = b; li[40 + NE] = t;
    }
    __syncthreads();
}
__device__ __forceinline__ void phase_moe1(const Params& p, float* lds) {
    int* li = (int*)(lds + 16 * 132 + 16 * 128);
    moe_prefix(p, li);
    const int* cnt = (const int*)(p.ws + WS_CTL); const int* tok = (const int*)(p.ws + WS_TOK);
    const h16* h = (const h16*)(p.ws + WS_H16); h16* act = (h16*)(p.ws + WS_ACT);
    const int ntile = li[40 + NE]; constexpr int NT = FE / 64;
    for (int u = blockIdx.x; u < ntile * NT; u += gridDim.x) {
        const int tl = u / NT, nt = u % NT;
        int e = 0;
        for (int q = 1; q < NE; ++q) if (li[40 + q] <= tl) e = q;
        const int rt = tl - li[40 + e], nvalid = min(128, cnt[e] - rt * 128);
        gemm_tile(lds, D, p.in[14] + (size_t)e * D * 2 * FE, 2 * FE, RowGather{h, tok + (size_t)e * T + rt * 128, nvalid}, ColGateUp{nt * 64},
                  EpiSwiglu{act + (size_t)(li[e] + rt * 128) * FE, p.in[15] + (size_t)e * 2 * FE, nvalid, nt * 64});
    }
}
__device__ __forceinline__ void phase_moe2(const Params& p, float* lds) {
    int* li = (int*)(lds + 16 * 132 + 16 * 128);
    moe_prefix(p, li);
    const int* cnt = (const int*)(p.ws + WS_CTL);
    const h16* act = (const h16*)(p.ws + WS_ACT); h16* y = (h16*)(p.ws + WS_Y16);
    const int ntile = li[40 + NE]; constexpr int NT = D / 128;
    for (int u = blockIdx.x; u < ntile * NT; u += gridDim.x) {
        const int tl = u / NT, nt = u % NT;
        int e = 0;
        for (int q = 1; q < NE; ++q) if (li[40 + q] <= tl) e = q;
        const int rt = tl - li[40 + e], nvalid = min(128, cnt[e] - rt * 128);
        const size_t slot0 = (size_t)(li[e] + rt * 128);
        gemm_tile(lds, FE, p.in[16] + (size_t)e * FE * D, D, RowAct{act + slot0 * FE, nvalid}, ColPlain{nt * 128},
                  EpiDown{y + slot0 * D, p.in[17] + (size_t)e * D, nvalid, nt * 128});
    }
}

__device__ __forceinline__ void phase_final(const Params& p, float* lds) {
    int* li = (int*)lds;
    { const int* cnt = (const int*)(p.ws + WS_CTL);
      if (otid() == 0) { int t = 0; for (int e = 0; e < NE; ++e) { li[e] = t * 256; t += (cnt[e] + 255) / 256; } }
      __syncthreads(); }
    const float* x1 = (const float*)(p.ws + WS_X1); const float* mod = (const float*)(p.ws + WS_MOD); const float* fw = p.in[18];
    const h16* y = (const h16*)(p.ws + WS_Y16);
    const int* asg_e = (const int*)(p.ws + WS_ASG_E); const int* asg_p = (const int*)(p.ws + WS_ASG_P); const float* asg_g = (const float*)(p.ws + WS_ASG_G);
    const int tid_ = otid(); const int lane = tid_ & 63, wave = tid_ >> 6;
    const int gw = blockIdx.x * NWAVES + wave, NGW = gridDim.x * NWAVES;
    for (int row = gw; row < T; row += NGW) {
        const int b = row / SEQ; const float* gate2 = mod + b * 6144 + 5120;
        size_t slot[4]; float gk[4];
#pragma unroll
        for (int k = 0; k < 4; ++k) { slot[k] = (size_t)(li[asg_e[row * 4 + k]] + asg_p[row * 4 + k]); gk[k] = asg_g[row * 4 + k]; }
        f32x4 v[4]; float ss = 0.f;
#pragma unroll
        for (int j = 0; j < 4; ++j) {
            const int col = 256 * j + 4 * lane;
            f32x4 acc = (f32x4){0.f, 0.f, 0.f, 0.f};
#pragma unroll
            for (int k = 0; k < 4; ++k) { const h16x4 yv = *(const h16x4*)(y + slot[k] * D + col);
#pragma unroll
                for (int i = 0; i < 4; ++i) acc[i] += gk[k] * (float)yv[i]; }
            const f32x4 xv = *(const f32x4*)(x1 + (size_t)row * D + col), g2 = *(const f32x4*)(gate2 + col);
#pragma unroll
            for (int i = 0; i < 4; ++i) { v[j][i] = xv[i] + g2[i] * acc[i]; ss += v[j][i] * v[j][i]; }
        }
        const float rstd = rsqrtf(wave_sum(ss) * (1.f / D) + EPS);
#pragma unroll
        for (int j = 0; j < 4; ++j) {
            const int col = 256 * j + 4 * lane; const f32x4 w4 = *(const f32x4*)(fw + col);
            f32x4 o; o[0] = v[j][0] * rstd * w4[0]; o[1] = v[j][1] * rstd * w4[1]; o[2] = v[j][2] * rstd * w4[2]; o[3] = v[j][3] * rstd * w4[3];
            *(f32x4*)(p.out + (size_t)row * D + col) = o;
        }
    }
}


__device__ __forceinline__ void cvt_item(const float* W, int K, int N, h16* WT, int dst_row0, int k0, int n0, float* scr, int lane) {
#pragma unroll 8
    for (int i = 0; i < 32; ++i) { const int kk = 2 * i + (lane >> 5); scr[kk * 33 + (lane & 31)] = W[(size_t)(k0 + kk) * N + n0 + (lane & 31)]; }
    asm volatile("s_waitcnt lgkmcnt(0)" ::: "memory");
    const int c = lane & 7;
#pragma unroll
    for (int j = 0; j < 4; ++j) { const int n = (lane >> 3) + 8 * j; const float* sp = scr + (8 * c) * 33 + n;
        h16x8 o;
#pragma unroll
        for (int q = 0; q < 8; ++q) o[q] = (h16)sp[q * 33];
        *(h16x8*)(WT + (size_t)(dst_row0 + n) * K + k0 + 8 * c) = o; }
    asm volatile("s_waitcnt lgkmcnt(0)" ::: "memory");
}
__device__ __forceinline__ void phase_cvt(const Params& p, float* lds) {
    const int tid_ = otid(); const int lane = tid_ & 63, wave = tid_ >> 6;
    float* scr = lds + wave * (64 * 33);
    const int gw = blockIdx.x * NWAVES + wave, NGW = gridDim.x * NWAVES;
    constexpr int I_IN = 16 * 112, I_OUT = 16 * 32, I_W1 = 32 * 16 * 64, I_W2 = 32 * 16 * 32;
    for (int it = gw; it < I_IN + I_OUT + I_W1 + I_W2; it += NGW) {
        int r = it;
        if (r < I_IN) { const int kb = r / 112, nb = r % 112; cvt_item(p.in[5], D, INC, (h16*)(p.ws + WS_WIN16), nb * 32, kb * 64, nb * 32, scr, lane); continue; } r -= I_IN;
        if (r < I_OUT) { const int kb = r / 32, nb = r % 32; cvt_item(p.in[10], D, D, (h16*)(p.ws + WS_WOUT16), nb * 32, kb * 64, nb * 32, scr, lane); continue; } r -= I_OUT;
        if (r < I_W1) { const int e = r / 1024, q = r % 1024, kb = q / 64, nb = q % 64, n0 = nb * 32, hh = n0 / 1024, j = n0 % 1024;
            cvt_item(p.in[14] + (size_t)e * D * 2 * FE, D, 2 * FE, (h16*)(p.ws + WS_W116) + (size_t)e * 2 * FE * D, (j / 128) * 256 + hh * 128 + (j % 128), kb * 64, n0, scr, lane); continue; } r -= I_W1;
        { const int e = r / 512, q = r % 512, kb = q / 32, nb = q % 32;
            cvt_item(p.in[16] + (size_t)e * FE * D, FE, D, (h16*)(p.ws + WS_W216) + (size_t)e * D * FE, nb * 32, kb * 64, nb * 32, scr, lane); }
    }
}

typedef pg8::Unit PUnit;
struct EpiInProjM {
    static constexpr bool PERM = true; unsigned char* ws;
    __device__ __forceinline__ void operator()(const f32x4 (&acc)[2][2][4][2], const PUnit& u, int wr, int wc, int fr, int fq) const {
        const int c0 = u.pn * 256; h16* dst; int ld, cc;
        if (c0 < 512) { dst = (h16*)(ws + WS_Q16); ld = 512; cc = c0; }
        else if (c0 < 1024) { dst = (h16*)(ws + WS_K16); ld = 512; cc = c0 - 512; }
        else if (c0 < 1536) { dst = (h16*)(ws + WS_V16); ld = 512; cc = c0 - 1024; }
        else if (c0 < 3072) { dst = (h16*)(ws + WS_DQKV); ld = 1536; cc = c0 - 1536; }
        else { dst = (h16*)(ws + WS_Z16); ld = 512; cc = c0 - 3072; }
        const int col0 = cc + wc * 32 + 8 * fq;
#pragma unroll
        for (int ai = 0; ai < 2; ++ai)
#pragma unroll
            for (int m = 0; m < 4; ++m) { const size_t row = (size_t)u.pm * 256 + ai * 128 + wr * 64 + m * 16 + fr;
#pragma unroll
                for (int bj = 0; bj < 2; ++bj) { h16x8 o;
#pragma unroll
                    for (int n = 0; n < 2; ++n)
#pragma unroll
                        for (int i = 0; i < 4; ++i) o[4 * n + i] = (h16)acc[ai][bj][m][n][i];
                    *(h16x8*)(dst + row * ld + col0 + bj * 128) = o; } }
    }
};
struct EpiOutProjM {
    static constexpr bool PERM = false; const float* x; const float* mod; float* x1;
    __device__ __forceinline__ void operator()(const f32x4 (&acc)[2][2][4][2], const PUnit& u, int wr, int wc, int fr, int fq) const {
        const int col0 = u.pn * 256 + wc * 32 + 4 * fq;
#pragma unroll
        for (int ai = 0; ai < 2; ++ai)
#pragma unroll
            for (int m = 0; m < 4; ++m) { const size_t row = (size_t)u.pm * 256 + ai * 128 + wr * 64 + m * 16 + fr; const int b = (int)(row / SEQ);
#pragma unroll
                for (int bj = 0; bj < 2; ++bj)
#pragma unroll
                    for (int n = 0; n < 2; ++n) { const int c = col0 + bj * 128 + n * 16;
                        const f32x4 gt = *(const f32x4*)(mod + b * 6144 + 2048 + c); const f32x4 xv = *(const f32x4*)(x + row * D + c);
                        *(f32x4*)(x1 + row * D + c) = xv + gt * acc[ai][bj][m][n]; } }
    }
};
struct EpiSwigluM {
    static constexpr bool PERM = true; h16* act; const float* b1;
    __device__ __forceinline__ void operator()(const f32x4 (&acc)[2][2][4][2], const PUnit& u, int wr, int wc, int fr, int fq) const {
        const float* bb = b1 + (size_t)u.e * 2 * FE; const int j0 = u.pn * 128 + wc * 32 + 8 * fq;
        f32x4 bg[2], bu[2];
#pragma unroll
        for (int n = 0; n < 2; ++n) { bg[n] = *(const f32x4*)(bb + j0 + 4 * n); bu[n] = *(const f32x4*)(bb + FE + j0 + 4 * n); }
#pragma unroll
        for (int ai = 0; ai < 2; ++ai)
#pragma unroll
            for (int m = 0; m < 4; ++m) { const size_t row = (size_t)u.pm * 256 + ai * 128 + wr * 64 + m * 16 + fr; h16x8 o;
#pragma unroll
                for (int n = 0; n < 2; ++n)
#pragma unroll
                    for (int i = 0; i < 4; ++i) { const float gt = fminf(acc[ai][0][m][n][i] + bg[n][i], 7.f); const float up = fminf(fmaxf(acc[ai][1][m][n][i] + bu[n][i], -7.f), 7.f);
                        o[4 * n + i] = (h16)(gt * sigmoid_f(1.702f * gt) * (up + 1.f)); }
                *(h16x8*)(act + row * FE + j0) = o; }
    }
};
struct EpiDownM {
    static constexpr bool PERM = true; h16* y; const float* b2;
    __device__ __forceinline__ void operator()(const f32x4 (&acc)[2][2][4][2], const PUnit& u, int wr, int wc, int fr, int fq) const {
        const float* bb = b2 + (size_t)u.e * D; const int col0 = u.pn * 256 + wc * 32 + 8 * fq;
#pragma unroll
        for (int bj = 0; bj < 2; ++bj) { f32x4 bv[2];
#pragma unroll
            for (int n = 0; n < 2; ++n) bv[n] = *(const f32x4*)(bb + col0 + bj * 128 + 4 * n);
#pragma unroll
            for (int ai = 0; ai < 2; ++ai)
#pragma unroll
                for (int m = 0; m < 4; ++m) { const size_t row = (size_t)u.pm * 256 + ai * 128 + wr * 64 + m * 16 + fr; h16x8 o;
#pragma unroll
                    for (int n = 0; n < 2; ++n)
#pragma unroll
                        for (int i = 0; i < 4; ++i) o[4 * n + i] = (h16)(acc[ai][bj][m][n][i] + bv[n][i]);
                    *(h16x8*)(y + row * D + col0 + bj * 128) = o; } }
    }
};
#define LAS3 __attribute__((address_space(3)))
__device__ __forceinline__ void phase_inproj_m(const Params& p, LAS3 unsigned char* lds) {
    pg8::Order S; S.init(T / 256, INC_MAIN / 256, gridDim.x, blockIdx.x, nullptr);
    pg8::gemm_phase<EpiInProjM, false>(lds, pg8::Gemm{(const h16*)(p.ws + WS_H16), (const h16*)(p.ws + WS_WIN16), INC_MAIN, D}, S, EpiInProjM{p.ws}, nullptr);
}
__device__ __forceinline__ void phase_outproj_m(const Params& p, LAS3 unsigned char* lds) {
    pg8::Order S; S.init(T / 256, D / 256, gridDim.x, blockIdx.x, nullptr);
    pg8::gemm_phase<EpiOutProjM, false>(lds, pg8::Gemm{(const h16*)(p.ws + WS_MIX), (const h16*)(p.ws + WS_WOUT16), D, D}, S,
                                         EpiOutProjM{p.in[0], (const float*)(p.ws + WS_MOD), (float*)(p.ws + WS_X1)}, nullptr);
}
__device__ __forceinline__ void moe_prefix_m(const Params& p, LAS3 int* tab) {
    const int* cnt = (const int*)(p.ws + WS_CTL);
    if (otid() == 0) { int t = 0; for (int e = 0; e < NE; ++e) { tab[e] = t; t += (cnt[e] + 255) / 256; } tab[NE] = t; }
    __syncthreads();
}
__device__ __forceinline__ void phase_moe1_m(const Params& p, LAS3 unsigned char* lds) {
    LAS3 int* tab = (LAS3 int*)(lds + LDS_TAB); LAS3 int* gtab = (LAS3 int*)(lds + LDS_GTAB);
    moe_prefix_m(p, tab);
    const int* cnt = (const int*)(p.ws + WS_CTL); const int* tok = (const int*)(p.ws + WS_TOK);
    pg8::Order S; S.init(tab[NE], 2 * FE / 256, gridDim.x, blockIdx.x, tab);
    const int tid = otid();
    for (int ui = 0; ui < GTAB_UNITS; ++ui) { PUnit u; if (!S.next(ui, u)) break;
        if (tid < 256) { const int c = cnt[u.e]; int li = (u.pm - tab[u.e]) * 256 + tid; li = li < c ? li : c - 1; gtab[ui * 256 + tid] = tok[(size_t)u.e * T + li]; } }
    __syncthreads();
    pg8::gemm_phase<EpiSwigluM, true>(lds, pg8::Gemm{(const h16*)(p.ws + WS_H16), (const h16*)(p.ws + WS_W116), 2 * FE, D}, S,
                                       EpiSwigluM{(h16*)(p.ws + WS_ACT), p.in[15]}, gtab);
}
__device__ __forceinline__ void phase_moe2_m(const Params& p, LAS3 unsigned char* lds) {
    LAS3 int* tab = (LAS3 int*)(lds + LDS_TAB);
    moe_prefix_m(p, tab);
    pg8::Order S; S.init(tab[NE], D / 256, gridDim.x, blockIdx.x, tab);
    pg8::gemm_phase<EpiDownM, false>(lds, pg8::Gemm{(const h16*)(p.ws + WS_ACT), (const h16*)(p.ws + WS_W216), D, FE}, S,
                                      EpiDownM{(h16*)(p.ws + WS_Y16), p.in[17]}, nullptr);
}

__global__ void __launch_bounds__(NTHREADS) fwd_megakernel(Params p) {
    extern __shared__ __attribute__((aligned(16))) unsigned char lds_raw[];
    float* lds = (float*)lds_raw;
    cg::grid_group grid = cg::this_grid();
    LAS3 unsigned char* l3 = (LAS3 unsigned char*)lds_raw;
    phase_mod(p, lds);
    phase_cvt(p, lds);
    grid.sync();
    phase_mod1(p);
    grid.sync();
    phase_inproj_m(p, l3);
    grid.sync();
    phase_dnprep(p);
    grid.sync();
    {
        const int nscan = NB * DH;
        if (gridDim.x >= 2 * nscan) {
            if (blockIdx.x < nscan) phase_scan_naive(p, lds, blockIdx.x);
            else phase_attn_naive(p, blockIdx.x - nscan, gridDim.x - nscan);
        } else {
            for (int bh = blockIdx.x; bh < nscan; bh += gridDim.x) phase_scan_naive(p, lds, bh);
            phase_attn_naive(p, blockIdx.x, gridDim.x);
        }
    }
    grid.sync();
    phase_dnout(p);
    grid.sync();
    phase_outproj_m(p, l3);
    grid.sync();
    phase_router(p);
    grid.sync();
    phase_moe1_m(p, l3);
    grid.sync();
    phase_moe2_m(p, l3);
    grid.sync();
    phase_final(p, lds);
}

extern "C" void kernel_launch(void* const* d_in, const int* in_sizes, int n_in, void* d_out, int out_size, void* d_ws, size_t ws_size, hipStream_t stream) {
    static int grid_blocks = 0;
    if (grid_blocks == 0) {
        if (n_in != 19 || out_size != T * D || ws_size < WS_END) { fprintf(stderr, "kernel_launch: unexpected shapes (n_in %d out %d ws %zu)\n", n_in, out_size, ws_size); grid_blocks = -1; return; }
        int dev = 0, cus = 0, per_cu = 0;
        hipGetDevice(&dev);
        hipDeviceGetAttribute(&cus, hipDeviceAttributeMultiprocessorCount, dev);
        hipFuncSetAttribute((const void*)fwd_megakernel, hipFuncAttributeMaxDynamicSharedMemorySize, LDS_BYTES);
        hipOccupancyMaxActiveBlocksPerMultiprocessor(&per_cu, (const void*)fwd_megakernel, NTHREADS, LDS_BYTES);
        if (per_cu < 1) { fprintf(stderr, "kernel_launch: occupancy query says %d blocks/CU\n", per_cu); grid_blocks = -1; return; }
        grid_blocks = cus;
    }
    if (grid_blocks < 0) return;
    Params p{};
    for (int i = 0; i < 19; ++i) p.in[i] = (const float*)d_in[i];
    p.out = (float*)d_out; p.ws = (unsigned char*)d_ws;
    void* args[] = {&p};
    hipError_t e = hipLaunchCooperativeKernel((const void*)fwd_megakernel, dim3(grid_blocks), dim3(NTHREADS), args, LDS_BYTES, stream);
    if (e != hipSuccess) fprintf(stderr, "cooperative launch failed: %s (grid %d)\n", hipGetErrorString(e), grid_blocks);
}
```

```cpp
#include <hip/hip_runtime.h>
#include <hip/hip_cooperative_groups.h>
#include <cstdio>
#include <cstdint>
namespace cg = cooperative_groups;

typedef _Float16 h16;
typedef _Float16 h16x2 __attribute__((ext_vector_type(2)));
typedef _Float16 h16x4 __attribute__((ext_vector_type(4)));
typedef _Float16 h16x8 __attribute__((ext_vector_type(8)));
typedef float f32x4 __attribute__((ext_vector_type(4)));
typedef float f32x2 __attribute__((ext_vector_type(2)));

constexpr int D = 1024, NB = 4, SEQ = 8192, T = NB * SEQ;
constexpr int AH = 8, AHD = 64, AW = 512;
constexpr int DH = 4, DKD = 128, DW = 512, DCONV = 1536;
constexpr int INC = 3592, INC_MAIN = 3584;
constexpr int NE = 32, TOPK = 4, FE = 1024;
constexpr int NASG = T * TOPK;
constexpr float EPS = 1e-6f;
constexpr int NTHREADS = 512, NWAVES = 8;

constexpr size_t MiB = (size_t)1 << 20;
constexpr size_t WS_CTL = 0;
constexpr size_t WS_MOD = 1 * MiB;
constexpr size_t WS_BA = 2 * MiB;
constexpr size_t WS_G = 3 * MiB;
constexpr size_t WS_ASG_E = 4 * MiB;
constexpr size_t WS_ASG_P = 4 * MiB + 512 * 1024;
constexpr size_t WS_ASG_G = 5 * MiB;
constexpr size_t WS_TOK = 6 * MiB;
constexpr size_t WS_WIN16 = 16 * MiB;
constexpr size_t WS_WOUT16 = 24 * MiB;
constexpr size_t WS_W116 = 32 * MiB;
constexpr size_t WS_W216 = 160 * MiB;
constexpr size_t WS_H16 = 224 * MiB;
constexpr size_t WS_X1 = 288 * MiB;
constexpr size_t WS_R = 416 * MiB;
constexpr size_t WS_Q16 = WS_R;
constexpr size_t WS_K16 = WS_R + 32 * MiB;
constexpr size_t WS_V16 = WS_R + 64 * MiB;
constexpr size_t WS_DQKV = WS_R + 96 * MiB;
constexpr size_t WS_Z16 = WS_R + 192 * MiB;
constexpr size_t WS_QN = WS_R + 224 * MiB;
constexpr size_t WS_KN = WS_R + 256 * MiB;
constexpr size_t WS_VV = WS_R + 288 * MiB;
constexpr size_t WS_O32 = WS_R + 320 * MiB;
constexpr size_t WS_MIX = WS_R + 384 * MiB;
constexpr size_t WS_ACT = WS_R;
constexpr size_t WS_Y16 = WS_R + 272 * MiB;
constexpr size_t WS_AO = WS_DQKV;
constexpr size_t WS_LSE = WS_QN;
constexpr size_t WS_DNREC = WS_R + 448 * MiB;
constexpr size_t WS_END = WS_R + 592 * MiB;

constexpr int LDS_STAGE = 131072, LDS_TAB = LDS_STAGE, LDS_GTAB = LDS_STAGE + 1024, GTAB_UNITS = 18;
constexpr int LDS_BYTES = LDS_GTAB + GTAB_UNITS * 256 * 4;
struct Params { const float* in[19]; float* out; unsigned char* ws; };

__device__ __forceinline__ float wave_sum(float v) {
#pragma unroll
    for (int o = 1; o < 64; o <<= 1) v += __shfl_xor(v, o);
    return v;
}
__device__ __forceinline__ float wave_max(float v) {
#pragma unroll
    for (int o = 1; o < 64; o <<= 1) v = fmaxf(v, __shfl_xor(v, o));
    return v;
}
__device__ __forceinline__ int otid() { int t = threadIdx.x; asm volatile("" : "+v"(t)); return t; }
__device__ __forceinline__ float silu_f(float v) { return v / (1.f + __expf(-v)); }
__device__ __forceinline__ float sigmoid_f(float v) { return 1.f / (1.f + __expf(-v)); }

template <class RowPtr, class ColMap, class Epi>
__device__ __forceinline__ void gemm_tile(float* lds, int K, const float* __restrict__ B, int ldb, RowPtr rowptr, ColMap colmap, Epi epi) {
    float* As = lds;
    float* Bs = lds + 16 * 132;
    const int tid = otid(), ty = tid >> 4, tx = tid & 15;
    const int ar = tid >> 2, ak = (tid & 3) * 4;
    const h16* arow = rowptr(ar);
    const int bk = tid >> 5, bc = (tid & 31) * 4;
    const int bcol = colmap(bc);
    float acc[4][8];
#pragma unroll
    for (int i = 0; i < 4; ++i)
#pragma unroll
        for (int j = 0; j < 8; ++j) acc[i][j] = 0.f;
    for (int k0 = 0; k0 < K; k0 += 16) {
        h16x4 av = (h16x4){(h16)0, (h16)0, (h16)0, (h16)0};
        if (arow) av = *(const h16x4*)(arow + k0 + ak);
        const f32x4 bv = *(const f32x4*)(B + (size_t)(k0 + bk) * ldb + bcol);
        __syncthreads();
        As[(ak + 0) * 132 + ar] = (float)av[0];
        As[(ak + 1) * 132 + ar] = (float)av[1];
        As[(ak + 2) * 132 + ar] = (float)av[2];
        As[(ak + 3) * 132 + ar] = (float)av[3];
        *(f32x4*)(Bs + bk * 128 + bc) = bv;
        __syncthreads();
#pragma unroll
        for (int k = 0; k < 16; ++k) {
            const f32x4 a = *(const f32x4*)(As + k * 132 + ty * 4);
            const f32x4 b0 = *(const f32x4*)(Bs + k * 128 + tx * 4);
            const f32x4 b1 = *(const f32x4*)(Bs + k * 128 + 64 + tx * 4);
#pragma unroll
            for (int i = 0; i < 4; ++i)
#pragma unroll
                for (int j = 0; j < 4; ++j) { acc[i][j] += a[i] * b0[j]; acc[i][4 + j] += a[i] * b1[j]; }
        }
    }
#pragma unroll
    for (int i = 0; i < 4; ++i) epi(ty * 4 + i, tx * 4, acc[i]);
}


namespace pg8 {
#define PG8_LAS __attribute__((address_space(3)))
constexpr int BM = 256, BK = 64, HALF = 128, HTB = HALF * BK * 2, STAGE_BYTES = 8 * HTB, NXCD = 8, WGM = 8;
__device__ __forceinline__ int lds_byte(int r, int c) { const int st = (r >> 4) * 2 + (c >> 5), rr = r & 15, cc = c & 31, ob = rr * 64 + cc * 2; return st * 1024 + (ob ^ (((ob >> 9) & 1) << 5)); }
__device__ __forceinline__ void stage_rc(int b, int& R, int& C) { const int st = b / 1024, sb = b % 1024, swz = sb ^ (((sb >> 9) & 1) << 5); R = (st >> 1) * 16 + swz / 64; C = (st & 1) * 32 + (swz % 64) / 2; }
__device__ __forceinline__ int perm32(int rho) { const int n = rho >> 4, i = rho & 15; return 8 * (i >> 2) + 4 * n + (i & 3); }

struct Unit { int pm, pn, e; };
struct Gemm { const h16* A; const h16* Bt; int N, K; };

struct Order {
    int nM, nN, nwg, G, c; PG8_LAS const int* tstart;
    __device__ __forceinline__ void init(int nM_, int nN_, int G_, int c_, PG8_LAS const int* ts) { nM = nM_; nN = nN_; nwg = nM * nN; G = G_; c = c_; tstart = ts; }
    __device__ __forceinline__ bool next(int i, Unit& u) const {
        const long L = (long)i * G + c; if (L >= nwg) return false;
        int wgid = (int)L; { const int q = nwg / NXCD, r = nwg % NXCD, xcd = wgid % NXCD, off = wgid / NXCD; wgid = (xcd < r ? xcd * (q + 1) : r * (q + 1) + (xcd - r) * q) + off; }
        const int nig = WGM * nN, gid = wgid / nig, fm = gid * WGM, gsz = (nM - fm) < WGM ? (nM - fm) : WGM;
        u.pm = fm + ((wgid % nig) % gsz); u.pn = (wgid % nig) / gsz;
        int e = 0;
        if (tstart) { for (int q = 1; q < 32; ++q) if (tstart[q] <= u.pm) e = q; }
        u.e = e; return true;
    }
};

template <class Epi, bool GATHER>
__device__ __forceinline__ void gemm_phase(PG8_LAS unsigned char* lds, const Gemm g, const Order& S, const Epi& E, PG8_LAS const int* gtab) {
    const int tid = otid(), wid = __builtin_amdgcn_readfirstlane(tid >> 6), lane = tid & 63, wr = wid >> 2, wc = wid & 3, fr = lane & 15, fq = lane >> 4;
    const int K = g.K, nt = K / BK;
    unsigned voffB[2]; int RA[2]; unsigned CA2[2];
#pragma unroll
    for (int i = 0; i < 2; ++i) { int R, C; stage_rc(tid * 16 + i * 8192, R, C); const int Rb = Epi::PERM ? ((R & ~31) + perm32(R & 31)) : R;
        RA[i] = R; CA2[i] = (unsigned)C * 2u; voffB[i] = (unsigned)(Rb * K + C) * 2u; }
    const size_t kstep = (size_t)(BK * 2);
    const size_t hstep = (size_t)HALF * K * 2;
    const size_t tstep = 2 * hstep;
    const unsigned ldsw = (unsigned)wid * 1024u;
    const int aoff = lds_byte(wr * 64 + fr, fq * 8), boff = lds_byte(wc * 32 + fr, fq * 8);
#define PG8_SA(b, h) (((b) * 2 + (h)) * HTB)
#define PG8_SB(b, h) ((4 + (b) * 2 + (h)) * HTB)
#define PG8_STAGE(bufoff, gbase, voff) do { _Pragma("unroll") for (int _i = 0; _i < 2; ++_i) \
        __builtin_amdgcn_global_load_lds((const unsigned*)((const char*)(gbase) + (voff)[_i]), (PG8_LAS unsigned*)(lds + (bufoff) + ldsw + _i * 8192), 16, 0, 0); } while (0)
#define PG8_LDA(dst, b, h) do { _Pragma("unroll") for (int m = 0; m < 4; ++m) _Pragma("unroll") for (int k = 0; k < 2; ++k) dst[m][k] = *(const PG8_LAS h16x8*)(lds + PG8_SA(b, h) + aoff + m * 2048 + k * 1024); } while (0)
#define PG8_LDB(dst, b, h) do { _Pragma("unroll") for (int n = 0; n < 2; ++n) _Pragma("unroll") for (int k = 0; k < 2; ++k) dst[n][k] = *(const PG8_LAS h16x8*)(lds + PG8_SB(b, h) + boff + n * 2048 + k * 1024); } while (0)
#define PG8_MMA(ai, bj, At, Bt) do { __builtin_amdgcn_s_setprio(1); _Pragma("unroll") for (int m = 0; m < 4; ++m) _Pragma("unroll") for (int n = 0; n < 2; ++n) _Pragma("unroll") for (int k = 0; k < 2; ++k) \
        acc[ai][bj][m][n] = __builtin_amdgcn_mfma_f32_16x16x32_f16(Bt[n][k], At[m][k], acc[ai][bj][m][n], 0, 0, 0); __builtin_amdgcn_s_setprio(0); } while (0)
#define PG8_WAIT_V(n) asm volatile("s_waitcnt vmcnt(" #n ")" ::: "memory")
#define PG8_WAIT_L(n) asm volatile("s_waitcnt lgkmcnt(" #n ")" ::: "memory")
#define PG8_BAR __builtin_amdgcn_s_barrier()
#define PG8_SCHED __builtin_amdgcn_sched_barrier(0)
#define PG8_AOFF(o, u, uix) do { _Pragma("unroll") for (int _h = 0; _h < 2; ++_h) _Pragma("unroll") for (int _i = 0; _i < 2; ++_i) { \
        const int _r = _h * HALF + RA[_i]; const unsigned _src = GATHER ? (unsigned)gtab[(uix) * BM + _r] : (unsigned)((u).pm * BM + _r); \
        o[_h][_i] = _src * (unsigned)(K * 2) + CA2[_i]; } } while (0)
    Unit cur, nxt; int ui = 0;
    if (!S.next(0, cur)) return;
    f32x4 acc[2][2][4][2];
#pragma unroll
    for (int a = 0; a < 2; ++a)
#pragma unroll
        for (int b = 0; b < 2; ++b)
#pragma unroll
            for (int m = 0; m < 4; ++m)
#pragma unroll
                for (int n = 0; n < 2; ++n) acc[a][b][m][n] = (f32x4){0.f, 0.f, 0.f, 0.f};
    h16x8 At[4][2], B0[2][2], B1[2][2];
    unsigned oc[2][2], on[2][2];
    PG8_AOFF(oc, cur, 0);
    const char* const A0 = (const char*)g.A;
    const char* cB = (const char*)g.Bt + ((size_t)cur.e * g.N + (size_t)cur.pn * BM) * K * 2;
    PG8_STAGE(PG8_SB(0, 0), cB, voffB); PG8_STAGE(PG8_SB(0, 1), cB + hstep, voffB); PG8_STAGE(PG8_SA(0, 0), A0, oc[0]); PG8_STAGE(PG8_SA(0, 1), A0, oc[1]);
    if (wr == 1) PG8_BAR;
    PG8_WAIT_V(2); PG8_BAR;
    PG8_STAGE(PG8_SB(1, 0), cB + kstep, voffB); PG8_STAGE(PG8_SA(1, 0), A0 + kstep, oc[0]); PG8_STAGE(PG8_SB(1, 1), cB + hstep + kstep, voffB);
    PG8_WAIT_V(6); PG8_BAR;
    for (;;) {
        const bool has_next = S.next(ui + 1, nxt);
        const char* nB = cB;
        if (has_next) { nB = (const char*)g.Bt + ((size_t)nxt.e * g.N + (size_t)nxt.pn * BM) * K * 2; PG8_AOFF(on, nxt, ui + 1); }
        else {
#pragma unroll
            for (int h = 0; h < 2; ++h)
#pragma unroll
                for (int i = 0; i < 2; ++i) on[h][i] = oc[h][i];
        }
        for (int t = 0; t < nt; t += 2) {
            const bool last = (t == nt - 2);
            const char* a1 = A0 + (size_t)(t + 1) * kstep;
            const char* a2 = last ? A0 : A0 + (size_t)(t + 2) * kstep; const char* b2 = last ? nB : cB + (size_t)(t + 2) * kstep;
            const char* a3 = a2 + kstep; const char* b3 = b2 + kstep;
            unsigned o2[2][2];
#pragma unroll
            for (int h = 0; h < 2; ++h)
#pragma unroll
                for (int i = 0; i < 2; ++i) o2[h][i] = last ? on[h][i] : oc[h][i];
            PG8_LDB(B0, 0, 0); PG8_LDB(B1, 0, 1); PG8_SCHED; PG8_LDA(At, 0, 0); PG8_STAGE(PG8_SA(1, 1), a1, oc[1]);
            PG8_WAIT_V(8); PG8_WAIT_L(0); PG8_BAR; PG8_MMA(0, 0, At, B0); PG8_MMA(0, 1, At, B1); PG8_BAR; PG8_SCHED;
            PG8_LDA(At, 0, 1); PG8_STAGE(PG8_SB(0, 0), b2, voffB); PG8_STAGE(PG8_SB(0, 1), b2 + hstep, voffB); PG8_STAGE(PG8_SA(0, 0), a2, o2[0]);
            PG8_WAIT_V(8); PG8_WAIT_L(0); PG8_BAR; PG8_MMA(1, 0, At, B0); PG8_MMA(1, 1, At, B1); PG8_BAR; PG8_SCHED;
            PG8_LDB(B0, 1, 0); PG8_LDB(B1, 1, 1); PG8_SCHED; PG8_LDA(At, 1, 0); PG8_STAGE(PG8_SA(0, 1), a2, o2[1]);
            PG8_WAIT_V(8); PG8_WAIT_L(0); PG8_BAR; PG8_MMA(0, 0, At, B0); PG8_MMA(0, 1, At, B1); PG8_BAR; PG8_SCHED;
            PG8_LDA(At, 1, 1); PG8_STAGE(PG8_SB(1, 0), b3, voffB); PG8_STAGE(PG8_SB(1, 1), b3 + hstep, voffB); PG8_STAGE(PG8_SA(1, 0), a3, o2[0]);
            PG8_WAIT_V(8); PG8_WAIT_L(0); PG8_BAR; PG8_MMA(1, 0, At, B0); PG8_MMA(1, 1, At, B1); PG8_BAR; PG8_SCHED;
        }
        if (wr == 0) PG8_BAR;
        E(acc, cur, wr, wc, fr, fq);
        if (!has_next) break;
#pragma unroll
        for (int a = 0; a < 2; ++a)
#pragma unroll
            for (int b = 0; b < 2; ++b)
#pragma unroll
                for (int m = 0; m < 4; ++m)
#pragma unroll
                    for (int n = 0; n < 2; ++n) acc[a][b][m][n] = (f32x4){0.f, 0.f, 0.f, 0.f};
        cur = nxt; cB = nB; ++ui;
#pragma unroll
        for (int h = 0; h < 2; ++h)
#pragma unroll
            for (int i = 0; i < 2; ++i) oc[h][i] = on[h][i];
        if (wr == 1) PG8_BAR;
    }
    PG8_WAIT_V(0);
    PG8_BAR;
#undef PG8_SA
#undef PG8_SB
#undef PG8_STAGE
#undef PG8_LDA
#undef PG8_LDB
#undef PG8_MMA
#undef PG8_WAIT_V
#undef PG8_WAIT_L
#undef PG8_BAR
#undef PG8_SCHED
#undef PG8_AOFF
}
}

__device__ __forceinline__ void phase_mod(const Params& p, float* lds) {
    const float* c = p.in[1]; const float* w = p.in[2]; const float* bias = p.in[3];
    float* mod = (float*)(p.ws + WS_MOD);
    const int tid = otid();
    for (int i = tid; i < 4096; i += NTHREADS) lds[i] = silu_f(c[i]);
    __syncthreads();
    float* red = lds + 4096;
    for (int cb = blockIdx.x; cb < 192; cb += gridDim.x) {
        const int cc = tid & 31, col = cb * 32 + cc, ks = tid >> 5;
        float a0 = 0.f, a1 = 0.f, a2 = 0.f, a3 = 0.f;
        for (int k = ks * 64; k < ks * 64 + 64; ++k) {
            const float wv = w[(size_t)k * 6144 + col];
            a0 += lds[k] * wv; a1 += lds[1024 + k] * wv; a2 += lds[2048 + k] * wv; a3 += lds[3072 + k] * wv;
        }
        red[(ks * 4 + 0) * 32 + cc] = a0; red[(ks * 4 + 1) * 32 + cc] = a1; red[(ks * 4 + 2) * 32 + cc] = a2; red[(ks * 4 + 3) * 32 + cc] = a3;
        __syncthreads();
        if (tid < 128) {
            const int b = tid >> 5; float s = 0.f;
            for (int q = 0; q < 16; ++q) s += red[(q * 4 + b) * 32 + cc];
            mod[b * 6144 + col] = s + bias[col];
        }
        __syncthreads();
    }
    if (blockIdx.x == 0 && tid < 64) ((int*)(p.ws + WS_CTL))[tid] = 0;
}

__device__ __forceinline__ void phase_mod1(const Params& p) {
    const float* x = p.in[0]; const float* nw = p.in[4]; const float* w_in = p.in[5];
    const float* mod = (const float*)(p.ws + WS_MOD);
    h16* hout = (h16*)(p.ws + WS_H16); float* ba = (float*)(p.ws + WS_BA);
    const int tid_ = otid(); const int lane = tid_ & 63, wave = tid_ >> 6;
    const int gw = blockIdx.x * NWAVES + wave, NGW = gridDim.x * NWAVES;
    for (int row = gw; row < T; row += NGW) {
        const int b = row / SEQ;
        const float* shift = mod + b * 6144; const float* scale = shift + 1024;
        const f32x4* xr = (const f32x4*)(x + (size_t)row * D) + lane;
        f32x4 v[4]; float ss = 0.f;
#pragma unroll
        for (int j = 0; j < 4; ++j) { v[j] = xr[64 * j]; ss += v[j][0] * v[j][0] + v[j][1] * v[j][1] + v[j][2] * v[j][2] + v[j][3] * v[j][3]; }
        const float rstd = rsqrtf(wave_sum(ss) * (1.f / D) + EPS);
        float pb[8];
#pragma unroll
        for (int e = 0; e < 8; ++e) pb[e] = 0.f;
#pragma unroll
        for (int j = 0; j < 4; ++j) {
            const int col = 256 * j + 4 * lane;
            const f32x4 w4 = *(const f32x4*)(nw + col), sc = *(const f32x4*)(scale + col), sh = *(const f32x4*)(shift + col);
            f32x4 hv;
#pragma unroll
            for (int i = 0; i < 4; ++i) hv[i] = v[j][i] * rstd * w4[i] * (1.f + sc[i]) + sh[i];
            h16x4 o; o[0] = (h16)hv[0]; o[1] = (h16)hv[1]; o[2] = (h16)hv[2]; o[3] = (h16)hv[3];
            *(h16x4*)(hout + (size_t)row * D + col) = o;
#pragma unroll
            for (int i = 0; i < 4; ++i) {
                const f32x4 wa = *(const f32x4*)(w_in + (size_t)(col + i) * INC + INC_MAIN);
                const f32x4 wb = *(const f32x4*)(w_in + (size_t)(col + i) * INC + INC_MAIN + 4);
#pragma unroll
                for (int e = 0; e < 4; ++e) { pb[e] += hv[i] * wa[e]; pb[4 + e] += hv[i] * wb[e]; }
            }
        }
#pragma unroll
        for (int e = 0; e < 8; ++e) pb[e] = wave_sum(pb[e]);
        if (lane == 0) {
            *(f32x4*)(ba + (size_t)row * 8) = (f32x4){pb[0], pb[1], pb[2], pb[3]};
            *(f32x4*)(ba + (size_t)row * 8 + 4) = (f32x4){pb[4], pb[5], pb[6], pb[7]};
        }
    }
}

struct RowPlain { const h16* base; int row0; __device__ __forceinline__ const h16* operator()(int r) const { return base + (size_t)(row0 + r) * D; } };
struct ColPlain { int n0; __device__ __forceinline__ int operator()(int n) const { return n0 + n; } };
struct EpiInProj {
    unsigned char* ws; int row0, n0;
    __device__ __forceinline__ void st(int row, int c, const float* a) const {
        h16* dst; int ld, cc;
        if (c < 512) { dst = (h16*)(ws + WS_Q16); ld = 512; cc = c; }
        else if (c < 1024) { dst = (h16*)(ws + WS_K16); ld = 512; cc = c - 512; }
        else if (c < 1536) { dst = (h16*)(ws + WS_V16); ld = 512; cc = c - 1024; }
        else if (c < 3072) { dst = (h16*)(ws + WS_DQKV); ld = 1536; cc = c - 1536; }
        else { dst = (h16*)(ws + WS_Z16); ld = 512; cc = c - 3072; }
        h16x4 o; o[0] = (h16)a[0]; o[1] = (h16)a[1]; o[2] = (h16)a[2]; o[3] = (h16)a[3];
        *(h16x4*)(dst + (size_t)row * ld + cc) = o;
    }
    __device__ __forceinline__ void operator()(int r, int n, const float* a) const { st(row0 + r, n0 + n, a); st(row0 + r, n0 + 64 + n, a + 4); }
};
__device__ __forceinline__ void phase_inproj(const Params& p, float* lds) {
    const h16* h = (const h16*)(p.ws + WS_H16);
    constexpr int NT = INC_MAIN / 128, MT = T / 128;
    for (int u = blockIdx.x; u < NT * MT; u += gridDim.x) {
        const int mt = u / NT, nt = u % NT;
        gemm_tile(lds, D, p.in[5], INC, RowPlain{h, mt * 128}, ColPlain{nt * 128}, EpiInProj{p.ws, mt * 128, nt * 128});
    }
}

__device__ __forceinline__ void phase_dnprep(const Params& p) {
    const h16* dqkv = (const h16*)(p.ws + WS_DQKV);
    const float* cw = p.in[6]; const float* A_log = p.in[7]; const float* dt_bias = p.in[8];
    const float* ba = (const float*)(p.ws + WS_BA);
    h16* qn = (h16*)(p.ws + WS_QN); h16* kn = (h16*)(p.ws + WS_KN); h16* vv = (h16*)(p.ws + WS_VV);
    float* g = (float*)(p.ws + WS_G); float* beta = g + (size_t)T * 4;
    const int tid_ = otid(); const int lane = tid_ & 63, wave = tid_ >> 6;
    const int gw = blockIdx.x * NWAVES + wave, NGW = gridDim.x * NWAVES;
    for (int it = gw; it < T * DH; it += NGW) {
        const int row = it >> 2, hd = it & 3, tpos = row % SEQ;
        float y[3][2];
#pragma unroll
        for (int part = 0; part < 3; ++part) {
            const int ch = part * 512 + hd * 128 + 2 * lane;
            float a0 = 0.f, a1 = 0.f;
#pragma unroll
            for (int j = 0; j < 4; ++j) {
                const int tt = tpos - 3 + j;
                if (tt >= 0) {
                    const h16x2 xv = *(const h16x2*)(dqkv + (size_t)(row - 3 + j) * DCONV + ch);
                    const f32x2 wv = *(const f32x2*)(cw + j * DCONV + ch);
                    a0 += (float)xv[0] * wv[0]; a1 += (float)xv[1] * wv[1];
                }
            }
            y[part][0] = silu_f(a0); y[part][1] = silu_f(a1);
        }
        const float sq = wave_sum(y[0][0] * y[0][0] + y[0][1] * y[0][1]);
        const float sk = wave_sum(y[1][0] * y[1][0] + y[1][1] * y[1][1]);
        const float rq = rsqrtf(sq + EPS) * 0.08838834764831845f, rk = rsqrtf(sk + EPS);
        const size_t o = (size_t)row * DW + hd * 128 + 2 * lane;
        h16x2 t2;
        t2[0] = (h16)(y[0][0] * rq); t2[1] = (h16)(y[0][1] * rq); *(h16x2*)(qn + o) = t2;
        t2[0] = (h16)(y[1][0] * rk); t2[1] = (h16)(y[1][1] * rk); *(h16x2*)(kn + o) = t2;
        t2[0] = (h16)y[2][0]; t2[1] = (h16)y[2][1]; *(h16x2*)(vv + o) = t2;
        if (lane == 0) {
            const float dbv = ba[(size_t)row * 8 + hd], dav = ba[(size_t)row * 8 + 4 + hd];
            const float xsp = dav + dt_bias[hd];
            const float sp = (xsp > 20.f) ? xsp : log1pf(__expf(xsp));
            g[(size_t)row * 4 + hd] = -__expf(A_log[hd]) * sp;
            beta[(size_t)row * 4 + hd] = sigmoid_f(dbv);
        }
    }
}

__device__ __forceinline__ void phase_scan_naive(const Params& p, float* ldsf, int bh) {
    const h16* qn = (const h16*)(p.ws + WS_QN); const h16* kn = (const h16*)(p.ws + WS_KN); const h16* vv = (const h16*)(p.ws + WS_VV);
    const float* g = (const float*)(p.ws + WS_G); const float* beta = g + (size_t)T * 4;
    float* o32 = (float*)(p.ws + WS_O32);
    h16* qs = (h16*)ldsf; h16* ks = qs + 64 * 128; h16* vs = ks + 64 * 128; float* gs = (float*)(vs + 64 * 128); float* bs = gs + 64;
    const int tid = otid(), b = bh >> 2, hd = bh & 3;
    float S[64];
#pragma unroll
    for (int i = 0; i < 64; ++i) S[i] = 0.f;
    const int col = tid >> 1, hf = tid & 1;
    for (int chunk = 0; chunk < SEQ / 64; ++chunk) {
        const size_t t0 = (size_t)b * SEQ + chunk * 64;
        for (int i = tid; i < 1024; i += NTHREADS) {
            const int r = i >> 4, c = (i & 15) * 8; const size_t go = (t0 + r) * DW + hd * 128 + c;
            *(h16x8*)(qs + r * 128 + c) = *(const h16x8*)(qn + go);
            *(h16x8*)(ks + r * 128 + c) = *(const h16x8*)(kn + go);
            *(h16x8*)(vs + r * 128 + c) = *(const h16x8*)(vv + go);
        }
        if (tid < 64) { gs[tid] = g[(t0 + tid) * 4 + hd]; bs[tid] = beta[(t0 + tid) * 4 + hd]; }
        __syncthreads();
        if (tid < 256) {
            for (int s = 0; s < 64; ++s) {
                const float eg = __expf(gs[s]), bt = bs[s];
                float dot = 0.f;
#pragma unroll
                for (int i = 0; i < 64; i += 8) {
                    const h16x8 kk = *(const h16x8*)(ks + s * 128 + hf * 64 + i);
#pragma unroll
                    for (int j = 0; j < 8; ++j) dot += (float)kk[j] * S[i + j];
                }
                dot += __shfl_xor(dot, 1);
                const float vn = bt * ((float)vs[s * 128 + col] - eg * dot);
                float o = 0.f;
#pragma unroll
                for (int i = 0; i < 64; i += 8) {
                    const h16x8 kk = *(const h16x8*)(ks + s * 128 + hf * 64 + i);
                    const h16x8 qq = *(const h16x8*)(qs + s * 128 + hf * 64 + i);
#pragma unroll
                    for (int j = 0; j < 8; ++j) { S[i + j] = eg * S[i + j] + (float)kk[j] * vn; o += (float)qq[j] * S[i + j]; }
                }
                o += __shfl_xor(o, 1);
                if (hf == 0) o32[(t0 + s) * DW + hd * 128 + col] = o;
            }
        }
        __syncthreads();
    }
}


constexpr int DN_REC = 73728, DN_NW = 0, DN_QD = 16384, DN_KD = 32768, DN_IN = 49152, DN_U = 57344, DN_GL = 51200;
__device__ __forceinline__ void phase_dnchunk(const Params& p, unsigned char* lds) {
    const h16* qn = (const h16*)(p.ws + WS_QN); const h16* kn = (const h16*)(p.ws + WS_KN); const h16* vv = (const h16*)(p.ws + WS_VV);
    const float* g = (const float*)(p.ws + WS_G); const float* beta = g + (size_t)T * 4;
    h16* QS = (h16*)lds; h16* KS = (h16*)(lds + 17408); h16* VS = (h16*)(lds + 34816);
    float* KKA = (float*)(lds + 52224); float* QKA = (float*)(lds + 69632); float* TMA = (float*)(lds + 87040);
    h16* UL = (h16*)(lds + 104448); h16* WL = (h16*)(lds + 121856);
    float* GC = (float*)(lds + 139264); float* BT = GC + 64; float* EG = GC + 128;
    const int tid = otid(), lane = tid & 63, wave = tid >> 6;
    for (int item = blockIdx.x; item < NB * DH * (SEQ / 64); item += gridDim.x) {
        const int bh = item >> 7, n = item & 127, b = bh >> 2, hd = bh & 3;
        const size_t t0 = (size_t)b * SEQ + n * 64;
        unsigned char* rec = p.ws + WS_DNREC + (size_t)item * DN_REC;
        for (int i = tid; i < 1024; i += NTHREADS) {
            const int r = i >> 4, c = (i & 15) * 8; const size_t go = (t0 + r) * DW + hd * 128 + c;
            *(h16x8*)(QS + r * 136 + c) = *(const h16x8*)(qn + go);
            *(h16x8*)(KS + r * 136 + c) = *(const h16x8*)(kn + go);
            *(h16x8*)(VS + r * 136 + c) = *(const h16x8*)(vv + go);
        }
        if (wave == 0) {
            float x = g[(t0 + lane) * 4 + hd];
#pragma unroll
            for (int o = 1; o < 64; o <<= 1) { const float y = __shfl_up(x, o); if (lane >= o) x += y; }
            GC[lane] = x; EG[lane] = __expf(x); BT[lane] = beta[(t0 + lane) * 4 + hd];
        }
        __syncthreads();
        {
            const int i = tid >> 3, jj = tid & 7;
            float kk[8], qk[8];
#pragma unroll
            for (int m = 0; m < 8; ++m) { kk[m] = 0.f; qk[m] = 0.f; }
            for (int dc = 0; dc < 16; ++dc) {
                const h16x8 qi = *(const h16x8*)(QS + i * 136 + dc * 8), ki = *(const h16x8*)(KS + i * 136 + dc * 8);
#pragma unroll
                for (int m = 0; m < 8; ++m) {
                    const h16x8 kj = *(const h16x8*)(KS + (jj + 8 * m) * 136 + dc * 8);
#pragma unroll
                    for (int q = 0; q < 8; ++q) { kk[m] += (float)ki[q] * (float)kj[q]; qk[m] += (float)qi[q] * (float)kj[q]; }
                }
            }
            const float gi = GC[i], bi = BT[i];
#pragma unroll
            for (int m = 0; m < 8; ++m) {
                const int j = jj + 8 * m;
                const float dec = (j <= i) ? __expf(gi - GC[j]) : 0.f;
                KKA[i * 68 + j] = (j < i) ? bi * kk[m] * dec : 0.f;
                QKA[i * 68 + j] = qk[m] * dec;
            }
        }
        __syncthreads();
        if (wave == 0) {
            float Tc[64];
            int zl = 0; asm volatile("" : "+v"(zl));
            const float* Arow = KKA + zl;
#pragma unroll
            for (int i = 0; i < 64; ++i) {
                float a = (i == lane) ? 1.f : 0.f;
#pragma unroll
                for (int j4 = 0; j4 < i; j4 += 4) {
                    const f32x4 av = *(const f32x4*)(Arow + i * 68 + j4);
#pragma unroll
                    for (int q = 0; q < 4; ++q) if (j4 + q < i) a -= av[q] * Tc[j4 + q];
                }
                Tc[i] = a;
                TMA[i * 68 + lane] = a;
            }
        }
        __syncthreads();
        {
            const int dp = tid & 63, ig = tid >> 6;
            float U0[8], U1[8], W0[8], W1[8];
#pragma unroll
            for (int r = 0; r < 8; ++r) { U0[r] = 0.f; U1[r] = 0.f; W0[r] = 0.f; W1[r] = 0.f; }
            for (int j = 0; j < 8 * ig + 8; ++j) {
                const h16x2 vj = *(const h16x2*)(VS + j * 136 + 2 * dp), kj = *(const h16x2*)(KS + j * 136 + 2 * dp);
                const float bj = BT[j], ej = EG[j];
                const float v0 = (float)vj[0] * bj, v1 = (float)vj[1] * bj, k0 = (float)kj[0] * bj * ej, k1 = (float)kj[1] * bj * ej;
#pragma unroll
                for (int r = 0; r < 8; ++r) { const float t = TMA[(8 * ig + r) * 68 + j]; U0[r] += t * v0; U1[r] += t * v1; W0[r] += t * k0; W1[r] += t * k1; }
            }
#pragma unroll
            for (int r = 0; r < 8; ++r) {
                h16x2 t2; t2[0] = (h16)U0[r]; t2[1] = (h16)U1[r]; *(h16x2*)(UL + (8 * ig + r) * 136 + 2 * dp) = t2;
                t2[0] = (h16)(-W0[r]); t2[1] = (h16)(-W1[r]); *(h16x2*)(WL + (8 * ig + r) * 136 + 2 * dp) = t2;
            }
        }
        __syncthreads();
        const float gclast = GC[63];
        for (int pc = tid; pc < 4608; pc += NTHREADS) {
            h16x8 o; int off;
            if (pc < 2048) {
                const int arr = pc >> 10, q = pc & 1023, fs = q >> 6, l = q & 63, mt = fs >> 3, s8 = fs & 7, r = l & 31, hh = l >> 5, c = 32 * mt + r;
                const h16* src = (arr == 0 ? WL : QS) + c * 136 + 16 * s8 + 4 * hh;
                const h16x4 lo = *(const h16x4*)src, hi = *(const h16x4*)(src + 8);
                const float sc = (arr == 0) ? 1.f : EG[c];
#pragma unroll
                for (int j = 0; j < 4; ++j) { o[j] = (h16)((float)lo[j] * sc); o[4 + j] = (h16)((float)hi[j] * sc); }
                off = (arr == 0 ? DN_NW : DN_QD) + q * 16;
            } else if (pc < 3072) {
                const int q = pc - 2048, fs = q >> 6, l = q & 63, kt = fs >> 2, s4 = fs & 3, r = l & 31, hh = l >> 5, dk = 32 * kt + r;
#pragma unroll
                for (int j = 0; j < 8; ++j) { const int c = 16 * s4 + 8 * (j >> 2) + 4 * hh + (j & 3); o[j] = (h16)((float)KS[c * 136 + dk] * __expf(gclast - GC[c])); }
                off = DN_KD + q * 16;
            } else if (pc < 3584) {
                const int q = pc - 3072, fs = q >> 6, l = q & 63, mt = fs >> 2, s4 = fs & 3, r = l & 31, hh = l >> 5, c = 32 * mt + r;
#pragma unroll
                for (int j = 0; j < 8; ++j) { const int c2 = 16 * s4 + 8 * (j >> 2) + 4 * hh + (j & 3); o[j] = (h16)QKA[c * 68 + c2]; }
                off = DN_IN + q * 16;
                if (fs == 2 && l == 0) { const float gl = __expf(gclast); const unsigned gb = __float_as_uint(gl); unsigned short lo16 = (unsigned short)(gb & 0xffffu), hi16 = (unsigned short)(gb >> 16);
                    o[0] = __builtin_bit_cast(h16, lo16); o[1] = __builtin_bit_cast(h16, hi16); }
            } else {
                const int q = pc - 3584, half8 = q & 1, l = (q >> 1) & 63, ms = q >> 7, mt = ms >> 2, sl = ms & 3, col = l & 31, hh = l >> 5;
#pragma unroll
                for (int j = 0; j < 8; ++j) { const int i = 8 * half8 + j; const int c = 32 * mt + (i & 3) + 8 * (i >> 2) + 4 * hh; o[j] = UL[c * 136 + 32 * sl + col]; }
                off = DN_U + q * 16;
            }
            *(h16x8*)(rec + off) = o;
        }
        __syncthreads();
    }
}

typedef float f32x16 __attribute__((ext_vector_type(16)));
typedef unsigned u32x4 __attribute__((ext_vector_type(4)));
__device__ __forceinline__ void cvt_frags(const f32x16& a, h16x8& f0, h16x8& f1) {
#pragma unroll
    for (int j = 0; j < 8; ++j) { f0[j] = (h16)a[j]; f1[j] = (h16)a[8 + j]; }
}
__device__ __forceinline__ void phase_scan_mfma(const Params& p, unsigned char* lds, int bh) {
    const int tid = otid(), lane = tid & 63, wave = __builtin_amdgcn_readfirstlane(tid >> 6);
    const unsigned char* recs = p.ws + WS_DNREC + (size_t)bh * 128 * DN_REC;
    constexpr int NCH = SEQ / 64;
    if (wave >= 4) {
        const int lt = tid - 256;
        u32x4 RA[18], RB[18];
#define DN_LOAD(R, n) do { const u32x4* s_ = (const u32x4*)(recs + (size_t)(n) * DN_REC) + lt; _Pragma("unroll") for (int k = 0; k < 18; ++k) R[k] = s_[k * 256]; } while (0)
#define DN_WRITE(R, n) do { u32x4* d_ = (u32x4*)(lds + ((n) & 1) * DN_REC) + lt; _Pragma("unroll") for (int k = 0; k < 18; ++k) d_[k * 256] = R[k]; } while (0)
        DN_LOAD(RA, 0); DN_WRITE(RA, 0); DN_LOAD(RB, 1);
        __syncthreads();
        for (int n = 0; n < NCH; n += 2) {
            if (n + 2 < NCH) DN_LOAD(RA, n + 2);
            DN_WRITE(RB, n + 1);
            __syncthreads();
            if (n + 3 < NCH) DN_LOAD(RB, n + 3);
            if (n + 2 < NCH) DN_WRITE(RA, n + 2);
            __syncthreads();
        }
#undef DN_LOAD
#undef DN_WRITE
    } else {
        const int b = bh >> 2, hd = bh & 3, sl = wave, col = lane & 31, hh = lane >> 5;
        float* o32 = (float*)(p.ws + WS_O32);
        f32x16 S[4];
        h16x8 S16[4][2];
#pragma unroll
        for (int kt = 0; kt < 4; ++kt) {
#pragma unroll
            for (int i = 0; i < 16; ++i) S[kt][i] = 0.f;
#pragma unroll
            for (int j = 0; j < 8; ++j) { S16[kt][0][j] = (h16)0.f; S16[kt][1][j] = (h16)0.f; }
        }
        __syncthreads();
        for (int n = 0; n < NCH; ++n) {
            const unsigned char* buf = lds + (n & 1) * DN_REC;
            const float gl = *(const float*)(buf + DN_GL);
            f32x16 VN[2], O[2];
#pragma unroll
            for (int mt = 0; mt < 2; ++mt) {
                const h16x8* up = (const h16x8*)(buf + DN_U + ((mt * 4 + sl) * 64 + lane) * 32);
                const h16x8 u0 = up[0], u1 = up[1];
#pragma unroll
                for (int j = 0; j < 8; ++j) { VN[mt][j] = (float)u0[j]; VN[mt][8 + j] = (float)u1[j]; }
#pragma unroll
                for (int s8 = 0; s8 < 8; ++s8) {
                    const h16x8 a = *(const h16x8*)(buf + DN_NW + (mt * 8 + s8) * 1024 + lane * 16);
                    VN[mt] = __builtin_amdgcn_mfma_f32_32x32x16_f16(a, S16[s8 >> 1][s8 & 1], VN[mt], 0, 0, 0);
                }
            }
            h16x8 VN16[2][2];
            cvt_frags(VN[0], VN16[0][0], VN16[0][1]); cvt_frags(VN[1], VN16[1][0], VN16[1][1]);
#pragma unroll
            for (int mt = 0; mt < 2; ++mt) {
#pragma unroll
                for (int i = 0; i < 16; ++i) O[mt][i] = 0.f;
#pragma unroll
                for (int s8 = 0; s8 < 8; ++s8) {
                    const h16x8 a = *(const h16x8*)(buf + DN_QD + (mt * 8 + s8) * 1024 + lane * 16);
                    O[mt] = __builtin_amdgcn_mfma_f32_32x32x16_f16(a, S16[s8 >> 1][s8 & 1], O[mt], 0, 0, 0);
                }
#pragma unroll
                for (int s4 = 0; s4 < 4; ++s4) {
                    if ((s4 >> 1) <= mt) {
                        const h16x8 a = *(const h16x8*)(buf + DN_IN + (mt * 4 + s4) * 1024 + lane * 16);
                        O[mt] = __builtin_amdgcn_mfma_f32_32x32x16_f16(a, VN16[s4 >> 1][s4 & 1], O[mt], 0, 0, 0);
                    }
                }
                const size_t t0 = (size_t)b * SEQ + n * 64 + 32 * mt + 4 * hh;
#pragma unroll
                for (int i = 0; i < 16; ++i) o32[(t0 + (i & 3) + 8 * (i >> 2)) * DW + hd * 128 + 32 * sl + col] = O[mt][i];
            }
#pragma unroll
            for (int kt = 0; kt < 4; ++kt) {
#pragma unroll
                for (int i = 0; i < 16; ++i) S[kt][i] *= gl;
#pragma unroll
                for (int s4 = 0; s4 < 4; ++s4) {
                    const h16x8 a = *(const h16x8*)(buf + DN_KD + (kt * 4 + s4) * 1024 + lane * 16);
                    S[kt] = __builtin_amdgcn_mfma_f32_32x32x16_f16(a, VN16[s4 >> 1][s4 & 1], S[kt], 0, 0, 0);
                }
                cvt_frags(S[kt], S16[kt][0], S16[kt][1]);
            }
            __syncthreads();
        }
    }
}

__device__ __forceinline__ void phase_attn_naive(const Params& p, int vblock, int nvblocks) {
    const h16* q16 = (const h16*)(p.ws + WS_Q16); const h16* k16 = (const h16*)(p.ws + WS_K16); const h16* v16 = (const h16*)(p.ws + WS_V16);
    h16* mix = (h16*)(p.ws + WS_MIX);
    const int tid_ = otid(); const int lane = tid_ & 63, wave = tid_ >> 6;
    const int gw = vblock * NWAVES + wave, NGW = nvblocks * NWAVES;
    for (int it = gw; it < T * AH; it += NGW) {
        const int row = it >> 3, hd = it & 7, tpos = row % SEQ;
        float q[64];
        {
            const h16x8* qp = (const h16x8*)(q16 + (size_t)row * AW + hd * 64);
#pragma unroll
            for (int i = 0; i < 8; ++i) { const h16x8 t8 = qp[i];
#pragma unroll
                for (int j = 0; j < 8; ++j) q[i * 8 + j] = (float)t8[j]; }
        }
        float s[7]; int tk[7];
        float m = -INFINITY;
#pragma unroll
        for (int e = 0; e < 7; ++e) {
            const int idx = e * 64 + lane;
            const int br = idx / 129, j = idx - br * 129;
            const int dil = (br == 0) ? 1 : ((br == 1) ? 4 : 16);
            const int tkk = tpos - j * dil;
            const bool valid = (idx < 387) && (tkk >= 0);
            tk[e] = valid ? (row - j * dil) : -1;
            float sc = -INFINITY;
            if (valid) {
                const h16x8* kp = (const h16x8*)(k16 + (size_t)(row - j * dil) * AW + hd * 64);
                float acc = 0.f;
#pragma unroll
                for (int i = 0; i < 8; ++i) { const h16x8 t8 = kp[i];
#pragma unroll
                    for (int jj = 0; jj < 8; ++jj) acc += q[i * 8 + jj] * (float)t8[jj]; }
                sc = acc * 0.125f;
            }
            s[e] = sc; m = fmaxf(m, sc);
        }
        m = wave_max(m);
        float l = 0.f;
#pragma unroll
        for (int e = 0; e < 7; ++e) { s[e] = (tk[e] >= 0) ? __expf(s[e] - m) : 0.f; l += s[e]; }
        l = wave_sum(l);
        float o = 0.f;
#pragma unroll
        for (int e = 0; e < 7; ++e) {
            const int nsrc = (e < 6) ? 64 : 3;
            for (int src = 0; src < nsrc; ++src) {
                const float pp = __shfl(s[e], src); const int tr = __shfl(tk[e], src);
                if (tr >= 0) o += pp * (float)v16[(size_t)tr * AW + hd * 64 + lane];
            }
        }
        mix[(size_t)row * D + hd * 64 + lane] = (h16)(o / l);
    }
}


constexpr int AT_KS_STRIDE = 72, AT_VT_STRIDE = 388, AT_VT_OFF = 384 * AT_KS_STRIDE * 2;
__device__ __forceinline__ void phase_attn_mfma(const Params& p, unsigned char* lds, int vblock, int nvblocks) {
    const h16* q16 = (const h16*)(p.ws + WS_Q16); const h16* k16 = (const h16*)(p.ws + WS_K16); const h16* v16 = (const h16*)(p.ws + WS_V16);
    h16* ao = (h16*)(p.ws + WS_AO); float* lse = (float*)(p.ws + WS_LSE);
    h16* Ks = (h16*)lds; h16* Vt = (h16*)(lds + AT_VT_OFF);
    const int tid = otid(), lane = tid & 63, w = tid >> 6, ql = lane & 31, hh = lane >> 5;
    for (int u = vblock; u < 3 * 1024; u += nvblocks) {
        const int g = u >> 10, rem = u & 1023, bh = rem >> 5, x = rem & 31, b = bh >> 3, hd = bh & 7;
        const int dil = (g == 0) ? 1 : ((g == 1) ? 4 : 16);
        const int r = x & (dil - 1), nb = x / dil, m0 = nb * 256;
        const size_t rowbase = (size_t)b * SEQ + r;
        const size_t qrow = rowbase + (size_t)(m0 + 32 * w + ql) * dil;
        h16x8 qf[4];
#pragma unroll
        for (int s4 = 0; s4 < 4; ++s4) qf[s4] = *(const h16x8*)(q16 + qrow * AW + hd * 64 + 16 * s4 + 8 * hh);
        __syncthreads();
        for (int idx = tid; idx < 384 * 8; idx += NTHREADS) {
            const int kk = idx >> 3, pc = idx & 7, m = m0 - 128 + kk;
            h16x8 kv, vv;
#pragma unroll
            for (int j = 0; j < 8; ++j) { kv[j] = (h16)0.f; vv[j] = (h16)0.f; }
            if (m >= 0) { const size_t go = (rowbase + (size_t)m * dil) * AW + hd * 64 + pc * 8; kv = *(const h16x8*)(k16 + go); vv = *(const h16x8*)(v16 + go); }
            *(h16x8*)(Ks + kk * AT_KS_STRIDE + pc * 8) = kv;
#pragma unroll
            for (int j = 0; j < 8; ++j) Vt[(pc * 8 + j) * AT_VT_STRIDE + kk] = vv[j];
        }
        __syncthreads();
        f32x16 St[5];
#pragma unroll
        for (int kt = 0; kt < 5; ++kt) {
#pragma unroll
            for (int i = 0; i < 16; ++i) St[kt][i] = 0.f;
#pragma unroll
            for (int s4 = 0; s4 < 4; ++s4) {
                const h16x8 a = *(const h16x8*)(Ks + (32 * (w + kt) + ql) * AT_KS_STRIDE + 16 * s4 + 8 * hh);
                St[kt] = __builtin_amdgcn_mfma_f32_32x32x16_f16(a, qf[s4], St[kt], 0, 0, 0);
            }
        }
        float mx = -INFINITY;
#pragma unroll
        for (int kt = 0; kt < 5; ++kt)
#pragma unroll
            for (int i = 0; i < 16; ++i) {
                const int row = (i & 3) + 8 * (i >> 2) + 4 * hh;
                bool ok = true;
                if (kt == 0) ok = row >= ql;
                if (kt == 4) ok = row <= ql;
                if (m0 == 0) ok = ok && (32 * (w + kt) + row >= 128);
                St[kt][i] = ok ? St[kt][i] : -INFINITY;
                mx = fmaxf(mx, St[kt][i]);
            }
        mx = fmaxf(mx, __shfl_xor(mx, 32));
        float l = 0.f;
#pragma unroll
        for (int kt = 0; kt < 5; ++kt)
#pragma unroll
            for (int i = 0; i < 16; ++i) { St[kt][i] = __expf(0.125f * (St[kt][i] - mx)); l += St[kt][i]; }
        l += __shfl_xor(l, 32);
        f32x16 Ot[2];
#pragma unroll
        for (int dt = 0; dt < 2; ++dt)
#pragma unroll
            for (int i = 0; i < 16; ++i) Ot[dt][i] = 0.f;
#pragma unroll
        for (int kt = 0; kt < 5; ++kt) {
            h16x8 pf[2];
            cvt_frags(St[kt], pf[0], pf[1]);
#pragma unroll
            for (int s2 = 0; s2 < 2; ++s2)
#pragma unroll
                for (int dt = 0; dt < 2; ++dt) {
                    const h16* vp = Vt + (32 * dt + ql) * AT_VT_STRIDE + 32 * (w + kt) + 16 * s2 + 4 * hh;
                    const h16x4 lo = *(const h16x4*)vp, hi = *(const h16x4*)(vp + 8);
                    h16x8 a;
#pragma unroll
                    for (int j = 0; j < 4; ++j) { a[j] = lo[j]; a[4 + j] = hi[j]; }
                    Ot[dt] = __builtin_amdgcn_mfma_f32_32x32x16_f16(a, pf[s2], Ot[dt], 0, 0, 0);
                }
        }
        const float inv = 1.f / l;
        h16* orow = ao + ((size_t)g * T + qrow) * AW + hd * 64;
#pragma unroll
        for (int dt = 0; dt < 2; ++dt)
#pragma unroll
            for (int i4 = 0; i4 < 4; ++i4) {
                h16x4 o;
#pragma unroll
                for (int j = 0; j < 4; ++j) o[j] = (h16)(Ot[dt][4 * i4 + j] * inv);
                *(h16x4*)(orow + 32 * dt + 8 * i4 + 4 * hh) = o;
            }
        if (hh == 0) lse[((size_t)g * T + qrow) * 8 + hd] = 0.125f * mx + __logf(l);
    }
}

__device__ __forceinline__ void phase_dnout(const Params& p) {
    const float* o32 = (const float*)(p.ws + WS_O32); const h16* z16 = (const h16*)(p.ws + WS_Z16); const float* nw = p.in[9];
    h16* mix = (h16*)(p.ws + WS_MIX);
    const int tid_ = otid(); const int lane = tid_ & 63, wave = tid_ >> 6;
    const int gw = blockIdx.x * NWAVES + wave, NGW = gridDim.x * NWAVES;
    {
        const h16* ao = (const h16*)(p.ws + WS_AO); const float* lse = (const float*)(p.ws + WS_LSE);
        for (int row = gw; row < T; row += NGW) {
            const int hd = lane >> 3;
            const float l0 = lse[((size_t)0 * T + row) * 8 + hd], l1 = lse[((size_t)1 * T + row) * 8 + hd], l2 = lse[((size_t)2 * T + row) * 8 + hd];
            const float m = fmaxf(l0, fmaxf(l1, l2));
            const float e0 = __expf(l0 - m), e1 = __expf(l1 - m), e2 = __expf(l2 - m), inv = 1.f / (e0 + e1 + e2);
            const h16x8 a0 = *(const h16x8*)(ao + ((size_t)0 * T + row) * AW + lane * 8), a1 = *(const h16x8*)(ao + ((size_t)1 * T + row) * AW + lane * 8),
                        a2 = *(const h16x8*)(ao + ((size_t)2 * T + row) * AW + lane * 8);
            h16x8 o;
#pragma unroll
            for (int j = 0; j < 8; ++j) o[j] = (h16)((e0 * (float)a0[j] + e1 * (float)a1[j] + e2 * (float)a2[j]) * inv);
            *(h16x8*)(mix + (size_t)row * D + lane * 8) = o;
        }
    }
    for (int it = gw; it < T * DH; it += NGW) {
        const int row = it >> 2, hd = it & 3;
        const f32x2 ov = *(const f32x2*)(o32 + (size_t)row * DW + hd * 128 + 2 * lane);
        const float rstd = rsqrtf(wave_sum(ov[0] * ov[0] + ov[1] * ov[1]) * (1.f / 128.f) + EPS);
        const h16x2 zv = *(const h16x2*)(z16 + (size_t)row * DW + hd * 128 + 2 * lane);
        const f32x2 w2 = *(const f32x2*)(nw + 2 * lane);
        h16x2 r; r[0] = (h16)(ov[0] * rstd * w2[0] * silu_f((float)zv[0])); r[1] = (h16)(ov[1] * rstd * w2[1] * silu_f((float)zv[1]));
        *(h16x2*)(mix + (size_t)row * D + 512 + hd * 128 + 2 * lane) = r;
    }
}

struct EpiOutProj {
    const float* x; const float* mod; float* x1; int row0, n0;
    __device__ __forceinline__ void st(int row, int c, const float* a) const {
        const int b = row / SEQ; const f32x4 gt = *(const f32x4*)(mod + b * 6144 + 2048 + c); const f32x4 xv = *(const f32x4*)(x + (size_t)row * D + c);
        f32x4 o; o[0] = xv[0] + gt[0] * a[0]; o[1] = xv[1] + gt[1] * a[1]; o[2] = xv[2] + gt[2] * a[2]; o[3] = xv[3] + gt[3] * a[3];
        *(f32x4*)(x1 + (size_t)row * D + c) = o;
    }
    __device__ __forceinline__ void operator()(int r, int n, const float* a) const { st(row0 + r, n0 + n, a); st(row0 + r, n0 + 64 + n, a + 4); }
};
__device__ __forceinline__ void phase_outproj(const Params& p, float* lds) {
    const h16* mix = (const h16*)(p.ws + WS_MIX);
    constexpr int NT = D / 128, MT = T / 128;
    for (int u = blockIdx.x; u < NT * MT; u += gridDim.x) {
        const int mt = u / NT, nt = u % NT;
        gemm_tile(lds, D, p.in[10], D, RowPlain{mix, mt * 128}, ColPlain{nt * 128},
                  EpiOutProj{p.in[0], (const float*)(p.ws + WS_MOD), (float*)(p.ws + WS_X1), mt * 128, nt * 128});
    }
}

__device__ __forceinline__ void phase_router(const Params& p) {
    const float* x1 = (const float*)(p.ws + WS_X1); const float* nw = p.in[11]; const float* wr = p.in[12]; const float* br = p.in[13];
    const float* mod = (const float*)(p.ws + WS_MOD);
    h16* hout = (h16*)(p.ws + WS_H16);
    int* cnt = (int*)(p.ws + WS_CTL); int* tok = (int*)(p.ws + WS_TOK);
    int* asg_e = (int*)(p.ws + WS_ASG_E); int* asg_p = (int*)(p.ws + WS_ASG_P); float* asg_g = (float*)(p.ws + WS_ASG_G);
    const int tid_ = otid(); const int lane = tid_ & 63, wave = tid_ >> 6;
    const int gw = blockIdx.x * NWAVES + wave, NGW = gridDim.x * NWAVES;
    for (int row = gw; row < T; row += NGW) {
        const int b = row / SEQ;
        const float* shift = mod + b * 6144 + 3072; const float* scale = shift + 1024;
        const f32x4* xr = (const f32x4*)(x1 + (size_t)row * D) + lane;
        float ss = 0.f;
#pragma unroll
        for (int j = 0; j < 4; ++j) { const f32x4 t4 = xr[64 * j]; ss += t4[0] * t4[0] + t4[1] * t4[1] + t4[2] * t4[2] + t4[3] * t4[3]; }
        const float rstd = rsqrtf(wave_sum(ss) * (1.f / D) + EPS);
        float lg[32];
#pragma unroll
        for (int e = 0; e < 32; ++e) lg[e] = 0.f;
#pragma unroll 1
        for (int j = 0; j < 4; ++j) {
            const int col = 256 * j + 4 * lane;
            const f32x4 vj = xr[64 * j];
            const f32x4 w4 = *(const f32x4*)(nw + col), sc = *(const f32x4*)(scale + col), sh = *(const f32x4*)(shift + col);
            f32x4 hv;
#pragma unroll
            for (int i = 0; i < 4; ++i) hv[i] = vj[i] * rstd * w4[i] * (1.f + sc[i]) + sh[i];
            h16x4 o; o[0] = (h16)hv[0]; o[1] = (h16)hv[1]; o[2] = (h16)hv[2]; o[3] = (h16)hv[3];
            *(h16x4*)(hout + (size_t)row * D + col) = o;
#pragma unroll
            for (int i = 0; i < 4; ++i) {
                const f32x4* wp = (const f32x4*)(wr + (size_t)(col + i) * NE);
#pragma unroll
                for (int e4 = 0; e4 < 8; ++e4) { const f32x4 wv = wp[e4];
#pragma unroll
                    for (int e = 0; e < 4; ++e) lg[e4 * 4 + e] += hv[i] * wv[e]; }
            }
        }
#pragma unroll
        for (int e = 0; e < 32; ++e) lg[e] = wave_sum(lg[e]) + br[e];
        unsigned used = 0u; float tv[4]; int te[4];
#pragma unroll
        for (int k = 0; k < 4; ++k) {
            float best = -INFINITY; int bi = 0;
#pragma unroll
            for (int e = 0; e < 32; ++e) { const bool ok = !((used >> e) & 1u) && (lg[e] > best); best = ok ? lg[e] : best; bi = ok ? e : bi; }
            used |= 1u << bi; tv[k] = best; te[k] = bi;
        }
        float ex[4]; float sum = 0.f;
#pragma unroll
        for (int k = 0; k < 4; ++k) { ex[k] = __expf(tv[k] - tv[0]); sum += ex[k]; }
        if (lane < 4) {
            const int e = (lane == 0) ? te[0] : (lane == 1) ? te[1] : (lane == 2) ? te[2] : te[3];
            const float gt = ((lane == 0) ? ex[0] : (lane == 1) ? ex[1] : (lane == 2) ? ex[2] : ex[3]) / sum;
            const int pos = atomicAdd(cnt + e, 1);
            tok[(size_t)e * T + pos] = row;
            asg_e[row * 4 + lane] = e; asg_p[row * 4 + lane] = pos; asg_g[row * 4 + lane] = gt;
        }
    }
}

struct RowGather { const h16* base; const int* list; int nvalid; __device__ __forceinline__ const h16* operator()(int r) const { return (r < nvalid) ? base + (size_t)list[r] * D : nullptr; } };
struct RowAct { const h16* base; int nvalid; __device__ __forceinline__ const h16* operator()(int r) const { return (r < nvalid) ? base + (size_t)r * FE : nullptr; } };
struct ColGateUp { int j0; __device__ __forceinline__ int operator()(int n) const { return (n < 64) ? (j0 + n) : (1024 + j0 + (n - 64)); } };
struct EpiSwiglu {
    h16* act; const float* b1; int nvalid, j0;
    __device__ __forceinline__ void operator()(int r, int n, const float* a) const {
        if (r >= nvalid) return;
        const f32x4 bg = *(const f32x4*)(b1 + j0 + n), bu = *(const f32x4*)(b1 + 1024 + j0 + n);
        h16x4 o;
#pragma unroll
        for (int i = 0; i < 4; ++i) {
            float gt = fminf(a[i] + bg[i], 7.f); float up = fminf(fmaxf(a[4 + i] + bu[i], -7.f), 7.f);
            o[i] = (h16)(gt * sigmoid_f(1.702f * gt) * (up + 1.f));
        }
        *(h16x4*)(act + (size_t)r * FE + j0 + n) = o;
    }
};
struct EpiDown {
    h16* y; const float* b2; int nvalid, n0;
    __device__ __forceinline__ void st(int r, int c, const float* a) const {
        const f32x4 bv = *(const f32x4*)(b2 + c);
        h16x4 o; o[0] = (h16)(a[0] + bv[0]); o[1] = (h16)(a[1] + bv[1]); o[2] = (h16)(a[2] + bv[2]); o[3] = (h16)(a[3] + bv[3]);
        *(h16x4*)(y + (size_t)r * D + c) = o;
    }
    __device__ __forceinline__ void operator()(int r, int n, const float* a) const { if (r >= nvalid) return; st(r, n0 + n, a); st(r, n0 + 64 + n, a + 4); }
};
__device__ __forceinline__ void moe_prefix(const Params& p, int* li) {
    const int* cnt = (const int*)(p.ws + WS_CTL);
    if (threadIdx.x == 0) {
        int b = 0, t = 0;
        for (int e = 0; e < NE; ++e) { li[e] = b; li[40 + e] = t; const int c = cnt[e]; b += c; t += (c + 127) / 128; }
        li[NE] = b; li[40 + NE] = t;
    }
    __syncthreads();
}
__device__ __forceinline__ void phase_moe1(const Params& p, float* lds) {
    int* li = (int*)(lds + 16 * 132 + 16 * 128);
    moe_prefix(p, li);
    const int* cnt = (const int*)(p.ws + WS_CTL); const int* tok = (const int*)(p.ws + WS_TOK);
    const h16* h = (const h16*)(p.ws + WS_H16); h16* act = (h16*)(p.ws + WS_ACT);
    const int ntile = li[40 + NE]; constexpr int NT = FE / 64;
    for (int u = blockIdx.x; u < ntile * NT; u += gridDim.x) {
        const int tl = u / NT, nt = u % NT;
        int e = 0;
        for (int q = 1; q < NE; ++q) if (li[40 + q] <= tl) e = q;
        const int rt = tl - li[40 + e], nvalid = min(128, cnt[e] - rt * 128);
        gemm_tile(lds, D, p.in[14] + (size_t)e * D * 2 * FE, 2 * FE, RowGather{h, tok + (size_t)e * T + rt * 128, nvalid}, ColGateUp{nt * 64},
                  EpiSwiglu{act + (size_t)(li[e] + rt * 128) * FE, p.in[15] + (size_t)e * 2 * FE, nvalid, nt * 64});
    }
}
__device__ __forceinline__ void phase_moe2(const Params& p, float* lds) {
    int* li = (int*)(lds + 16 * 132 + 16 * 128);
    moe_prefix(p, li);
    const int* cnt = (const int*)(p.ws + WS_CTL);
    const h16* act = (const h16*)(p.ws + WS_ACT); h16* y = (h16*)(p.ws + WS_Y16);
    const int ntile = li[40 + NE]; constexpr int NT = D / 128;
    for (int u = blockIdx.x; u < ntile * NT; u += gridDim.x) {
        const int tl = u / NT, nt = u % NT;
        int e = 0;
        for (int q = 1; q < NE; ++q) if (li[40 + q] <= tl) e = q;
        const int rt = tl - li[40 + e], nvalid = min(128, cnt[e] - rt * 128);
        const size_t slot0 = (size_t)(li[e] + rt * 128);
        gemm_tile(lds, FE, p.in[16] + (size_t)e * FE * D, D, RowAct{act + slot0 * FE, nvalid}, ColPlain{nt * 128},
                  EpiDown{y + slot0 * D, p.in[17] + (size_t)e * D, nvalid, nt * 128});
    }
}

__device__ __forceinline__ void phase_final(const Params& p, float* lds) {
    int* li = (int*)lds;
    { const int* cnt = (const int*)(p.ws + WS_CTL);
      if (otid() == 0) { int t = 0; for (int e = 0; e < NE; ++e) { li[e] = t * 256; t += (cnt[e] + 255) / 256; } }
      __syncthreads(); }
    const float* x1 = (const float*)(p.ws + WS_X1); const float* mod = (const float*)(p.ws + WS_MOD); const float* fw = p.in[18];
    const h16* y = (const h16*)(p.ws + WS_Y16);
    const int* asg_e = (const int*)(p.ws + WS_ASG_E); const int* asg_p = (const int*)(p.ws + WS_ASG_P); const float* asg_g = (const float*)(p.ws + WS_ASG_G);
    const int tid_ = otid(); const int lane = tid_ & 63, wave = tid_ >> 6;
    const int gw = blockIdx.x * NWAVES + wave, NGW = gridDim.x * NWAVES;
    for (int row = gw; row < T; row += NGW) {
        const int b = row / SEQ; const float* gate2 = mod + b * 6144 + 5120;
        size_t slot[4]; float gk[4];
#pragma unroll
        for (int k = 0; k < 4; ++k) { slot[k] = (size_t)(li[asg_e[row * 4 + k]] + asg_p[row * 4 + k]); gk[k] = asg_g[row * 4 + k]; }
        f32x4 v[4]; float ss = 0.f;
#pragma unroll
        for (int j = 0; j < 4; ++j) {
            const int col = 256 * j + 4 * lane;
            f32x4 acc = (f32x4){0.f, 0.f, 0.f, 0.f};
#pragma unroll
            for (int k = 0; k < 4; ++k) { const h16x4 yv = *(const h16x4*)(y + slot[k] * D + col);
#pragma unroll
                for (int i = 0; i < 4; ++i) acc[i] += gk[k] * (float)yv[i]; }
            const f32x4 xv = *(const f32x4*)(x1 + (size_t)row * D + col), g2 = *(const f32x4*)(gate2 + col);
#pragma unroll
            for (int i = 0; i < 4; ++i) { v[j][i] = xv[i] + g2[i] * acc[i]; ss += v[j][i] * v[j][i]; }
        }
        const float rstd = rsqrtf(wave_sum(ss) * (1.f / D) + EPS);
#pragma unroll
        for (int j = 0; j < 4; ++j) {
            const int col = 256 * j + 4 * lane; const f32x4 w4 = *(const f32x4*)(fw + col);
            f32x4 o; o[0] = v[j][0] * rstd * w4[0]; o[1] = v[j][1] * rstd * w4[1]; o[2] = v[j][2] * rstd * w4[2]; o[3] = v[j][3] * rstd * w4[3];
            *(f32x4*)(p.out + (size_t)row * D + col) = o;
        }
    }
}


__device__ __forceinline__ void cvt_item(const float* W, int K, int N, h16* WT, int dst_row0, int k0, int n0, float* scr, int lane) {
#pragma unroll 8
    for (int i = 0; i < 32; ++i) { const int kk = 2 * i + (lane >> 5); scr[kk * 33 + (lane & 31)] = W[(size_t)(k0 + kk) * N + n0 + (lane & 31)]; }
    asm volatile("s_waitcnt lgkmcnt(0)" ::: "memory");
    const int c = lane & 7;
#pragma unroll
    for (int j = 0; j < 4; ++j) { const int n = (lane >> 3) + 8 * j; const float* sp = scr + (8 * c) * 33 + n;
        h16x8 o;
#pragma unroll
        for (int q = 0; q < 8; ++q) o[q] = (h16)sp[q * 33];
        *(h16x8*)(WT + (size_t)(dst_row0 + n) * K + k0 + 8 * c) = o; }
    asm volatile("s_waitcnt lgkmcnt(0)" ::: "memory");
}
__device__ __forceinline__ void phase_cvt(const Params& p, float* lds) {
    const int tid_ = otid(); const int lane = tid_ & 63, wave = tid_ >> 6;
    float* scr = lds + wave * (64 * 33);
    const int gw = blockIdx.x * NWAVES + wave, NGW = gridDim.x * NWAVES;
    constexpr int I_IN = 16 * 112, I_OUT = 16 * 32, I_W1 = 32 * 16 * 64, I_W2 = 32 * 16 * 32;
    for (int it = gw; it < I_IN + I_OUT + I_W1 + I_W2; it += NGW) {
        int r = it;
        if (r < I_IN) { const int kb = r / 112, nb = r % 112; cvt_item(p.in[5], D, INC, (h16*)(p.ws + WS_WIN16), nb * 32, kb * 64, nb * 32, scr, lane); continue; } r -= I_IN;
        if (r < I_OUT) { const int kb = r / 32, nb = r % 32; cvt_item(p.in[10], D, D, (h16*)(p.ws + WS_WOUT16), nb * 32, kb * 64, nb * 32, scr, lane); continue; } r -= I_OUT;
        if (r < I_W1) { const int e = r / 1024, q = r % 1024, kb = q / 64, nb = q % 64, n0 = nb * 32, hh = n0 / 1024, j = n0 % 1024;
            cvt_item(p.in[14] + (size_t)e * D * 2 * FE, D, 2 * FE, (h16*)(p.ws + WS_W116) + (size_t)e * 2 * FE * D, (j / 128) * 256 + hh * 128 + (j % 128), kb * 64, n0, scr, lane); continue; } r -= I_W1;
        { const int e = r / 512, q = r % 512, kb = q / 32, nb = q % 32;
            cvt_item(p.in[16] + (size_t)e * FE * D, FE, D, (h16*)(p.ws + WS_W216) + (size_t)e * D * FE, nb * 32, kb * 64, nb * 32, scr, lane); }
    }
}

typedef pg8::Unit PUnit;
struct EpiInProjM {
    static constexpr bool PERM = true; unsigned char* ws;
    __device__ __forceinline__ void operator()(const f32x4 (&acc)[2][2][4][2], const PUnit& u, int wr, int wc, int fr, int fq) const {
        const int c0 = u.pn * 256; h16* dst; int ld, cc;
        if (c0 < 512) { dst = (h16*)(ws + WS_Q16); ld = 512; cc = c0; }
        else if (c0 < 1024) { dst = (h16*)(ws + WS_K16); ld = 512; cc = c0 - 512; }
        else if (c0 < 1536) { dst = (h16*)(ws + WS_V16); ld = 512; cc = c0 - 1024; }
        else if (c0 < 3072) { dst = (h16*)(ws + WS_DQKV); ld = 1536; cc = c0 - 1536; }
        else { dst = (h16*)(ws + WS_Z16); ld = 512; cc = c0 - 3072; }
        const int col0 = cc + wc * 32 + 8 * fq;
#pragma unroll
        for (int ai = 0; ai < 2; ++ai)
#pragma unroll
            for (int m = 0; m < 4; ++m) { const size_t row = (size_t)u.pm * 256 + ai * 128 + wr * 64 + m * 16 + fr;
#pragma unroll
                for (int bj = 0; bj < 2; ++bj) { h16x8 o;
#pragma unroll
                    for (int n = 0; n < 2; ++n)
#pragma unroll
                        for (int i = 0; i < 4; ++i) o[4 * n + i] = (h16)acc[ai][bj][m][n][i];
                    *(h16x8*)(dst + row * ld + col0 + bj * 128) = o; } }
    }
};
struct EpiOutProjM {
    static constexpr bool PERM = false; const float* x; const float* mod; float* x1;
    __device__ __forceinline__ void operator()(const f32x4 (&acc)[2][2][4][2], const PUnit& u, int wr, int wc, int fr, int fq) const {
        const int col0 = u.pn * 256 + wc * 32 + 4 * fq;
#pragma unroll
        for (int ai = 0; ai < 2; ++ai)
#pragma unroll
            for (int m = 0; m < 4; ++m) { const size_t row = (size_t)u.pm * 256 + ai * 128 + wr * 64 + m * 16 + fr; const int b = (int)(row / SEQ);
#pragma unroll
                for (int bj = 0; bj < 2; ++bj)
#pragma unroll
                    for (int n = 0; n < 2; ++n) { const int c = col0 + bj * 128 + n * 16;
                        const f32x4 gt = *(const f32x4*)(mod + b * 6144 + 2048 + c); const f32x4 xv = *(const f32x4*)(x + row * D + c);
                        *(f32x4*)(x1 + row * D + c) = xv + gt * acc[ai][bj][m][n]; } }
    }
};
struct EpiSwigluM {
    static constexpr bool PERM = true; h16* act; const float* b1;
    __device__ __forceinline__ void operator()(const f32x4 (&acc)[2][2][4][2], const PUnit& u, int wr, int wc, int fr, int fq) const {
        const float* bb = b1 + (size_t)u.e * 2 * FE; const int j0 = u.pn * 128 + wc * 32 + 8 * fq;
        f32x4 bg[2], bu[2];
#pragma unroll
        for (int n = 0; n < 2; ++n) { bg[n] = *(const f32x4*)(bb + j0 + 4 * n); bu[n] = *(const f32x4*)(bb + FE + j0 + 4 * n); }
#pragma unroll
        for (int ai = 0; ai < 2; ++ai)
#pragma unroll
            for (int m = 0; m < 4; ++m) { const size_t row = (size_t)u.pm * 256 + ai * 128 + wr * 64 + m * 16 + fr; h16x8 o;
#pragma unroll
                for (int n = 0; n < 2; ++n)
#pragma unroll
                    for (int i = 0; i < 4; ++i) { const float gt = fminf(acc[ai][0][m][n][i] + bg[n][i], 7.f); const float up = fminf(fmaxf(acc[ai][1][m][n][i] + bu[n][i], -7.f), 7.f);
                        o[4 * n + i] = (h16)(gt * sigmoid_f(1.702f * gt) * (up + 1.f)); }
                *(h16x8*)(act + row * FE + j0) = o; }
    }
};
struct EpiDownM {
    static constexpr bool PERM = true; h16* y; const float* b2;
    __device__ __forceinline__ void operator()(const f32x4 (&acc)[2][2][4][2], const PUnit& u, int wr, int wc, int fr, int fq) const {
        const float* bb = b2 + (size_t)u.e * D; const int col0 = u.pn * 256 + wc * 32 + 8 * fq;
#pragma unroll
        for (int bj = 0; bj < 2; ++bj) { f32x4 bv[2];
#pragma unroll
            for (int n = 0; n < 2; ++n) bv[n] = *(const f32x4*)(bb + col0 + bj * 128 + 4 * n);
#pragma unroll
            for (int ai = 0; ai < 2; ++ai)
#pragma unroll
                for (int m = 0; m < 4; ++m) { const size_t row = (size_t)u.pm * 256 + ai * 128 + wr * 64 + m * 16 + fr; h16x8 o;
#pragma unroll
                    for (int n = 0; n < 2; ++n)
#pragma unroll
                        for (int i = 0; i < 4; ++i) o[4 * n + i] = (h16)(acc[ai][bj][m][n][i] + bv[n][i]);
                    *(h16x8*)(y + row * D + col0 + bj * 128) = o; } }
    }
};
#define LAS3 __attribute__((address_space(3)))
__device__ __forceinline__ void phase_inproj_m(const Params& p, LAS3 unsigned char* lds) {
    pg8::Order S; S.init(T / 256, INC_MAIN / 256, gridDim.x, blockIdx.x, nullptr);
    pg8::gemm_phase<EpiInProjM, false>(lds, pg8::Gemm{(const h16*)(p.ws + WS_H16), (const h16*)(p.ws + WS_WIN16), INC_MAIN, D}, S, EpiInProjM{p.ws}, nullptr);
}
__device__ __forceinline__ void phase_outproj_m(const Params& p, LAS3 unsigned char* lds) {
    pg8::Order S; S.init(T / 256, D / 256, gridDim.x, blockIdx.x, nullptr);
    pg8::gemm_phase<EpiOutProjM, false>(lds, pg8::Gemm{(const h16*)(p.ws + WS_MIX), (const h16*)(p.ws + WS_WOUT16), D, D}, S,
                                         EpiOutProjM{p.in[0], (const float*)(p.ws + WS_MOD), (float*)(p.ws + WS_X1)}, nullptr);
}
__device__ __forceinline__ void moe_prefix_m(const Params& p, LAS3 int* tab) {
    const int* cnt = (const int*)(p.ws + WS_CTL);
    if (otid() == 0) { int t = 0; for (int e = 0; e < NE; ++e) { tab[e] = t; t += (cnt[e] + 255) / 256; } tab[NE] = t; }
    __syncthreads();
}
__device__ __forceinline__ void phase_moe1_m(const Params& p, LAS3 unsigned char* lds) {
    LAS3 int* tab = (LAS3 int*)(lds + LDS_TAB); LAS3 int* gtab = (LAS3 int*)(lds + LDS_GTAB);
    moe_prefix_m(p, tab);
    const int* cnt = (const int*)(p.ws + WS_CTL); const int* tok = (const int*)(p.ws + WS_TOK);
    pg8::Order S; S.init(tab[NE], 2 * FE / 256, gridDim.x, blockIdx.x, tab);
    const int tid = otid();
    for (int ui = 0; ui < GTAB_UNITS; ++ui) { PUnit u; if (!S.next(ui, u)) break;
        if (tid < 256) { const int c = cnt[u.e]; int li = (u.pm - tab[u.e]) * 256 + tid; li = li < c ? li : c - 1; gtab[ui * 256 + tid] = tok[(size_t)u.e * T + li]; } }
    __syncthreads();
    pg8::gemm_phase<EpiSwigluM, true>(lds, pg8::Gemm{(const h16*)(p.ws + WS_H16), (const h16*)(p.ws + WS_W116), 2 * FE, D}, S,
                                       EpiSwigluM{(h16*)(p.ws + WS_ACT), p.in[15]}, gtab);
}
__device__ __forceinline__ void phase_moe2_m(const Params& p, LAS3 unsigned char* lds) {
    LAS3 int* tab = (LAS3 int*)(lds + LDS_TAB);
    moe_prefix_m(p, tab);
    pg8::Order S; S.init(tab[NE], D / 256, gridDim.x, blockIdx.x, tab);
    pg8::gemm_phase<EpiDownM, false>(lds, pg8::Gemm{(const h16*)(p.ws + WS_ACT), (const h16*)(p.ws + WS_W216), D, FE}, S,
                                      EpiDownM{(h16*)(p.ws + WS_Y16), p.in[17]}, nullptr);
}

__global__ void __launch_bounds__(NTHREADS) fwd_megakernel(Params p) {
    extern __shared__ __attribute__((aligned(16))) unsigned char lds_raw[];
    float* lds = (float*)lds_raw;
    cg::grid_group grid = cg::this_grid();
    LAS3 unsigned char* l3 = (LAS3 unsigned char*)lds_raw;
    phase_mod(p, lds);
    phase_cvt(p, lds);
    grid.sync();
    phase_mod1(p);
    grid.sync();
    phase_inproj_m(p, l3);
    grid.sync();
    phase_dnprep(p);
    grid.sync();
    phase_dnchunk(p, lds_raw);
    grid.sync();
    {
        const int nscan = NB * DH;
        if (gridDim.x >= 2 * nscan) {
            if (blockIdx.x < nscan) phase_scan_mfma(p, lds_raw, blockIdx.x);
            else phase_attn_mfma(p, lds_raw, blockIdx.x - nscan, gridDim.x - nscan);
        } else {
            for (int bh = blockIdx.x; bh < nscan; bh += gridDim.x) phase_scan_mfma(p, lds_raw, bh);
            phase_attn_mfma(p, lds_raw, blockIdx.x, gridDim.x);
        }
    }
    grid.sync();
    phase_dnout(p);
    grid.sync();
    phase_outproj_m(p, l3);
    grid.sync();
    phase_router(p);
    grid.sync();
    phase_moe1_m(p, l3);
    grid.sync();
    phase_moe2_m(p, l3);
    grid.sync();
    phase_final(p, lds);
}

extern "C" void kernel_launch(void* const* d_in, const int* in_sizes, int n_in, void* d_out, int out_size, void* d_ws, size_t ws_size, hipStream_t stream) {
    static int grid_blocks = 0;
    if (grid_blocks == 0) {
        if (n_in != 19 || out_size != T * D || ws_size < WS_END) { fprintf(stderr, "kernel_launch: unexpected shapes (n_in %d out %d ws %zu)\n", n_in, out_size, ws_size); grid_blocks = -1; return; }
        int dev = 0, cus = 0, per_cu = 0;
        hipGetDevice(&dev);
        hipDeviceGetAttribute(&cus, hipDeviceAttributeMultiprocessorCount, dev);
        hipFuncSetAttribute((const void*)fwd_megakernel, hipFuncAttributeMaxDynamicSharedMemorySize, LDS_BYTES);
        hipOccupancyMaxActiveBlocksPerMultiprocessor(&per_cu, (const void*)fwd_megakernel, NTHREADS, LDS_BYTES);
        if (per_cu < 1) { fprintf(stderr, "kernel_launch: occupancy query says %d blocks/CU\n", per_cu); grid_blocks = -1; return; }
        grid_blocks = cus;
    }
    if (grid_blocks < 0) return;
    Params p{};
    for (int i = 0; i < 19; ++i) p.in[i] = (const float*)d_in[i];
    p.out = (float*)d_out; p.ws = (unsigned char*)d_ws;
    void* args[] = {&p};
    hipError_t e = hipLaunchCooperativeKernel((const void*)fwd_megakernel, dim3(grid_blocks), dim3(NTHREADS), args, LDS_BYTES, stream);
    if (e != hipSuccess) fprintf(stderr, "cooperative launch failed: %s (grid %d)\n", hipGetErrorString(e), grid_blocks);
}
```

```cpp
#define PROBE 0
#include <hip/hip_runtime.h>
#include <hip/hip_cooperative_groups.h>
#include <cstdio>
#include <cstdint>
namespace cg = cooperative_groups;

typedef _Float16 h16;
typedef _Float16 h16x2 __attribute__((ext_vector_type(2)));
typedef _Float16 h16x4 __attribute__((ext_vector_type(4)));
typedef _Float16 h16x8 __attribute__((ext_vector_type(8)));
typedef float f32x4 __attribute__((ext_vector_type(4)));
typedef float f32x2 __attribute__((ext_vector_type(2)));

constexpr int D = 1024, NB = 4, SEQ = 8192, T = NB * SEQ;
constexpr int AH = 8, AHD = 64, AW = 512;
constexpr int DH = 4, DKD = 128, DW = 512, DCONV = 1536;
constexpr int INC = 3592, INC_MAIN = 3584;
constexpr int NE = 32, TOPK = 4, FE = 1024;
constexpr int NASG = T * TOPK;
constexpr float EPS = 1e-6f;
constexpr int NTHREADS = 512, NWAVES = 8;

constexpr size_t MiB = (size_t)1 << 20;
constexpr size_t WS_CTL = 0;
constexpr int CW_BAR = 4096; constexpr size_t CTL_ZERO_BYTES = 65536;
constexpr size_t WS_MOD = 1 * MiB;
constexpr size_t WS_BA = 2 * MiB;
constexpr size_t WS_G = 3 * MiB;
constexpr size_t WS_ASG_E = 4 * MiB;
constexpr size_t WS_ASG_P = 4 * MiB + 512 * 1024;
constexpr size_t WS_ASG_G = 5 * MiB;
constexpr size_t WS_TOK = 6 * MiB;
constexpr size_t WS_WIN16 = 16 * MiB;
constexpr size_t WS_WOUT16 = 24 * MiB;
constexpr size_t WS_W116 = 32 * MiB;
constexpr size_t WS_W216 = 160 * MiB;
constexpr size_t WS_H16 = 224 * MiB;
constexpr size_t WS_X1 = 288 * MiB;
constexpr size_t WS_R = 416 * MiB;
constexpr size_t WS_Q16 = WS_R;
constexpr size_t WS_K16 = WS_R + 32 * MiB;
constexpr size_t WS_V16 = WS_R + 64 * MiB;
constexpr size_t WS_DQKV = WS_R + 96 * MiB;
constexpr size_t WS_Z16 = WS_R + 192 * MiB;
constexpr size_t WS_QN = WS_R + 224 * MiB;
constexpr size_t WS_KN = WS_R + 256 * MiB;
constexpr size_t WS_VV = WS_R + 288 * MiB;
constexpr size_t WS_O32 = WS_R + 320 * MiB;
constexpr size_t WS_MIX = WS_R + 384 * MiB;
constexpr size_t WS_ACT = WS_R;
constexpr size_t WS_Y16 = WS_R + 272 * MiB;
constexpr size_t WS_AO = WS_DQKV;
constexpr size_t WS_LSE = WS_QN;
constexpr size_t WS_DNREC = WS_R + 448 * MiB;
constexpr size_t WS_END = WS_R + 592 * MiB;

constexpr int LDS_STAGE = 131072, LDS_TAB = LDS_STAGE, LDS_GTAB = LDS_STAGE + 1024, GTAB_UNITS = 18;
constexpr int LDS_MISC = LDS_GTAB + GTAB_UNITS * 256 * 4;
constexpr int LDS_BYTES = LDS_MISC + 256;
struct Params { const float* in[19]; float* out; unsigned char* ws; };

__device__ __forceinline__ float wave_sum(float v) {
#pragma unroll
    for (int o = 1; o < 64; o <<= 1) v += __shfl_xor(v, o);
    return v;
}
__device__ __forceinline__ float wave_max(float v) {
#pragma unroll
    for (int o = 1; o < 64; o <<= 1) v = fmaxf(v, __shfl_xor(v, o));
    return v;
}
__device__ __forceinline__ int otid() { int t = threadIdx.x; asm volatile("" : "+v"(t)); return t; }
__device__ __forceinline__ float silu_f(float v) { return v / (1.f + __expf(-v)); }
__device__ __forceinline__ float sigmoid_f(float v) { return 1.f / (1.f + __expf(-v)); }

template <class RowPtr, class ColMap, class Epi>
__device__ __forceinline__ void gemm_tile(float* lds, int K, const float* __restrict__ B, int ldb, RowPtr rowptr, ColMap colmap, Epi epi) {
    float* As = lds;
    float* Bs = lds + 16 * 132;
    const int tid = otid(), ty = tid >> 4, tx = tid & 15;
    const int ar = tid >> 2, ak = (tid & 3) * 4;
    const h16* arow = rowptr(ar);
    const int bk = tid >> 5, bc = (tid & 31) * 4;
    const int bcol = colmap(bc);
    float acc[4][8];
#pragma unroll
    for (int i = 0; i < 4; ++i)
#pragma unroll
        for (int j = 0; j < 8; ++j) acc[i][j] = 0.f;
    for (int k0 = 0; k0 < K; k0 += 16) {
        h16x4 av = (h16x4){(h16)0, (h16)0, (h16)0, (h16)0};
        if (arow) av = *(const h16x4*)(arow + k0 + ak);
        const f32x4 bv = *(const f32x4*)(B + (size_t)(k0 + bk) * ldb + bcol);
        __syncthreads();
        As[(ak + 0) * 132 + ar] = (float)av[0];
        As[(ak + 1) * 132 + ar] = (float)av[1];
        As[(ak + 2) * 132 + ar] = (float)av[2];
        As[(ak + 3) * 132 + ar] = (float)av[3];
        *(f32x4*)(Bs + bk * 128 + bc) = bv;
        __syncthreads();
#pragma unroll
        for (int k = 0; k < 16; ++k) {
            const f32x4 a = *(const f32x4*)(As + k * 132 + ty * 4);
            const f32x4 b0 = *(const f32x4*)(Bs + k * 128 + tx * 4);
            const f32x4 b1 = *(const f32x4*)(Bs + k * 128 + 64 + tx * 4);
#pragma unroll
            for (int i = 0; i < 4; ++i)
#pragma unroll
                for (int j = 0; j < 4; ++j) { acc[i][j] += a[i] * b0[j]; acc[i][4 + j] += a[i] * b1[j]; }
        }
    }
#pragma unroll
    for (int i = 0; i < 4; ++i) epi(ty * 4 + i, tx * 4, acc[i]);
}


namespace pg8 {
#define PG8_LAS __attribute__((address_space(3)))
constexpr int BM = 256, BK = 64, HALF = 128, HTB = HALF * BK * 2, STAGE_BYTES = 8 * HTB, NXCD = 8, WGM = 8;
__device__ __forceinline__ int lds_byte(int r, int c) { const int st = (r >> 4) * 2 + (c >> 5), rr = r & 15, cc = c & 31, ob = rr * 64 + cc * 2; return st * 1024 + (ob ^ (((ob >> 9) & 1) << 5)); }
__device__ __forceinline__ void stage_rc(int b, int& R, int& C) { const int st = b / 1024, sb = b % 1024, swz = sb ^ (((sb >> 9) & 1) << 5); R = (st >> 1) * 16 + swz / 64; C = (st & 1) * 32 + (swz % 64) / 2; }
__device__ __forceinline__ int perm32(int rho) { const int n = rho >> 4, i = rho & 15; return 8 * (i >> 2) + 4 * n + (i & 3); }

struct Unit { int pm, pn, e; };
struct Gemm { const h16* A; const h16* Bt; int N, K; };

struct Order {
    int nM, nN, nwg, G, c; PG8_LAS const int* tstart;
    __device__ __forceinline__ void init(int nM_, int nN_, int G_, int c_, PG8_LAS const int* ts) { nM = nM_; nN = nN_; nwg = nM * nN; G = G_; c = c_; tstart = ts; }
    __device__ __forceinline__ bool next(int i, Unit& u) const {
        const long L = (long)i * G + c; if (L >= nwg) return false;
        int wgid = (int)L; { const int q = nwg / NXCD, r = nwg % NXCD, xcd = wgid % NXCD, off = wgid / NXCD; wgid = (xcd < r ? xcd * (q + 1) : r * (q + 1) + (xcd - r) * q) + off; }
        const int nig = WGM * nN, gid = wgid / nig, fm = gid * WGM, gsz = (nM - fm) < WGM ? (nM - fm) : WGM;
        u.pm = fm + ((wgid % nig) % gsz); u.pn = (wgid % nig) / gsz;
        int e = 0;
        if (tstart) { for (int q = 1; q < 32; ++q) if (tstart[q] <= u.pm) e = q; }
        u.e = e; return true;
    }
};

template <class Epi, bool GATHER>
__device__ __forceinline__ void gemm_phase(PG8_LAS unsigned char* lds, const Gemm g, const Order& S, const Epi& E, PG8_LAS const int* gtab) {
    const int tid = otid(), wid = __builtin_amdgcn_readfirstlane(tid >> 6), lane = tid & 63, wr = wid >> 2, wc = wid & 3, fr = lane & 15, fq = lane >> 4;
    const int K = g.K, nt = K / BK;
    unsigned voffB[2]; int RA[2]; unsigned CA2[2];
#pragma unroll
    for (int i = 0; i < 2; ++i) { int R, C; stage_rc(tid * 16 + i * 8192, R, C); const int Rb = Epi::PERM ? ((R & ~31) + perm32(R & 31)) : R;
        RA[i] = R; CA2[i] = (unsigned)C * 2u; voffB[i] = (unsigned)(Rb * K + C) * 2u; }
    const size_t kstep = (size_t)(BK * 2);
    const size_t hstep = (size_t)HALF * K * 2;
    const size_t tstep = 2 * hstep;
    const unsigned ldsw = (unsigned)wid * 1024u;
    const int aoff = lds_byte(wr * 64 + fr, fq * 8), boff = lds_byte(wc * 32 + fr, fq * 8);
#define PG8_SA(b, h) (((b) * 2 + (h)) * HTB)
#define PG8_SB(b, h) ((4 + (b) * 2 + (h)) * HTB)
#define PG8_STAGE(bufoff, gbase, voff) do { _Pragma("unroll") for (int _i = 0; _i < 2; ++_i) \
        __builtin_amdgcn_global_load_lds((const unsigned*)((const char*)(gbase) + (voff)[_i]), (PG8_LAS unsigned*)(lds + (bufoff) + ldsw + _i * 8192), 16, 0, 0); } while (0)
#define PG8_LDA(dst, b, h) do { _Pragma("unroll") for (int m = 0; m < 4; ++m) _Pragma("unroll") for (int k = 0; k < 2; ++k) dst[m][k] = *(const PG8_LAS h16x8*)(lds + PG8_SA(b, h) + aoff + m * 2048 + k * 1024); } while (0)
#define PG8_LDB(dst, b, h) do { _Pragma("unroll") for (int n = 0; n < 2; ++n) _Pragma("unroll") for (int k = 0; k < 2; ++k) dst[n][k] = *(const PG8_LAS h16x8*)(lds + PG8_SB(b, h) + boff + n * 2048 + k * 1024); } while (0)
#define PG8_MMA(ai, bj, At, Bt) do { __builtin_amdgcn_s_setprio(1); _Pragma("unroll") for (int m = 0; m < 4; ++m) _Pragma("unroll") for (int n = 0; n < 2; ++n) _Pragma("unroll") for (int k = 0; k < 2; ++k) \
        acc[ai][bj][m][n] = __builtin_amdgcn_mfma_f32_16x16x32_f16(Bt[n][k], At[m][k], acc[ai][bj][m][n], 0, 0, 0); __builtin_amdgcn_s_setprio(0); } while (0)
#define PG8_WAIT_V(n) asm volatile("s_waitcnt vmcnt(" #n ")" ::: "memory")
#define PG8_WAIT_L(n) asm volatile("s_waitcnt lgkmcnt(" #n ")" ::: "memory")
#define PG8_BAR __builtin_amdgcn_s_barrier()
#define PG8_SCHED __builtin_amdgcn_sched_barrier(0)
#define PG8_AOFF(o, u, uix) do { _Pragma("unroll") for (int _h = 0; _h < 2; ++_h) _Pragma("unroll") for (int _i = 0; _i < 2; ++_i) { \
        const int _r = _h * HALF + RA[_i]; const unsigned _src = GATHER ? (unsigned)gtab[(uix) * BM + _r] : (unsigned)((u).pm * BM + _r); \
        o[_h][_i] = _src * (unsigned)(K * 2) + CA2[_i]; } } while (0)
    Unit cur, nxt; int ui = 0;
    if (!S.next(0, cur)) return;
    f32x4 acc[2][2][4][2];
#pragma unroll
    for (int a = 0; a < 2; ++a)
#pragma unroll
        for (int b = 0; b < 2; ++b)
#pragma unroll
            for (int m = 0; m < 4; ++m)
#pragma unroll
                for (int n = 0; n < 2; ++n) acc[a][b][m][n] = (f32x4){0.f, 0.f, 0.f, 0.f};
    h16x8 At[4][2], B0[2][2], B1[2][2];
    unsigned oc[2][2], on[2][2];
    PG8_AOFF(oc, cur, 0);
    const char* const A0 = (const char*)g.A;
    const char* cB = (const char*)g.Bt + ((size_t)cur.e * g.N + (size_t)cur.pn * BM) * K * 2;
    PG8_STAGE(PG8_SB(0, 0), cB, voffB); PG8_STAGE(PG8_SB(0, 1), cB + hstep, voffB); PG8_STAGE(PG8_SA(0, 0), A0, oc[0]); PG8_STAGE(PG8_SA(0, 1), A0, oc[1]);
    if (wr == 1) PG8_BAR;
    PG8_WAIT_V(2); PG8_BAR;
    PG8_STAGE(PG8_SB(1, 0), cB + kstep, voffB); PG8_STAGE(PG8_SA(1, 0), A0 + kstep, oc[0]); PG8_STAGE(PG8_SB(1, 1), cB + hstep + kstep, voffB);
    PG8_WAIT_V(6); PG8_BAR;
    for (;;) {
        const bool has_next = S.next(ui + 1, nxt);
        const char* nB = cB;
        if (has_next) { nB = (const char*)g.Bt + ((size_t)nxt.e * g.N + (size_t)nxt.pn * BM) * K * 2; PG8_AOFF(on, nxt, ui + 1); }
        else {
#pragma unroll
            for (int h = 0; h < 2; ++h)
#pragma unroll
                for (int i = 0; i < 2; ++i) on[h][i] = oc[h][i];
        }
        for (int t = 0; t < nt; t += 2) {
            const bool last = (t == nt - 2);
            const char* a1 = A0 + (size_t)(t + 1) * kstep;
            const char* a2 = last ? A0 : A0 + (size_t)(t + 2) * kstep; const char* b2 = last ? nB : cB + (size_t)(t + 2) * kstep;
            const char* a3 = a2 + kstep; const char* b3 = b2 + kstep;
            unsigned o2[2][2];
#pragma unroll
            for (int h = 0; h < 2; ++h)
#pragma unroll
                for (int i = 0; i < 2; ++i) o2[h][i] = last ? on[h][i] : oc[h][i];
            PG8_LDB(B0, 0, 0); PG8_LDB(B1, 0, 1); PG8_SCHED; PG8_LDA(At, 0, 0); PG8_STAGE(PG8_SA(1, 1), a1, oc[1]);
            PG8_WAIT_V(8); PG8_WAIT_L(0); PG8_BAR; PG8_MMA(0, 0, At, B0); PG8_MMA(0, 1, At, B1); PG8_BAR; PG8_SCHED;
            PG8_LDA(At, 0, 1); PG8_STAGE(PG8_SB(0, 0), b2, voffB); PG8_STAGE(PG8_SB(0, 1), b2 + hstep, voffB); PG8_STAGE(PG8_SA(0, 0), a2, o2[0]);
            PG8_WAIT_V(8); PG8_WAIT_L(0); PG8_BAR; PG8_MMA(1, 0, At, B0); PG8_MMA(1, 1, At, B1); PG8_BAR; PG8_SCHED;
            PG8_LDB(B0, 1, 0); PG8_LDB(B1, 1, 1); PG8_SCHED; PG8_LDA(At, 1, 0); PG8_STAGE(PG8_SA(0, 1), a2, o2[1]);
            PG8_WAIT_V(8); PG8_WAIT_L(0); PG8_BAR; PG8_MMA(0, 0, At, B0); PG8_MMA(0, 1, At, B1); PG8_BAR; PG8_SCHED;
            PG8_LDA(At, 1, 1); PG8_STAGE(PG8_SB(1, 0), b3, voffB); PG8_STAGE(PG8_SB(1, 1), b3 + hstep, voffB); PG8_STAGE(PG8_SA(1, 0), a3, o2[0]);
            PG8_WAIT_V(8); PG8_WAIT_L(0); PG8_BAR; PG8_MMA(1, 0, At, B0); PG8_MMA(1, 1, At, B1); PG8_BAR; PG8_SCHED;
        }
        if (wr == 0) PG8_BAR;
        E(acc, cur, wr, wc, fr, fq);
        if (!has_next) break;
#pragma unroll
        for (int a = 0; a < 2; ++a)
#pragma unroll
            for (int b = 0; b < 2; ++b)
#pragma unroll
                for (int m = 0; m < 4; ++m)
#pragma unroll
                    for (int n = 0; n < 2; ++n) acc[a][b][m][n] = (f32x4){0.f, 0.f, 0.f, 0.f};
        cur = nxt; cB = nB; ++ui;
#pragma unroll
        for (int h = 0; h < 2; ++h)
#pragma unroll
            for (int i = 0; i < 2; ++i) oc[h][i] = on[h][i];
        if (wr == 1) PG8_BAR;
    }
    PG8_WAIT_V(0);
    PG8_BAR;
#undef PG8_SA
#undef PG8_SB
#undef PG8_STAGE
#undef PG8_LDA
#undef PG8_LDB
#undef PG8_MMA
#undef PG8_WAIT_V
#undef PG8_WAIT_L
#undef PG8_BAR
#undef PG8_SCHED
#undef PG8_AOFF
}
}

__device__ __forceinline__ void phase_mod(const Params& p, float* lds) {
    const float* c = p.in[1]; const float* w = p.in[2]; const float* bias = p.in[3];
    float* mod = (float*)(p.ws + WS_MOD);
    const int tid = otid();
    for (int i = tid; i < 4096; i += NTHREADS) lds[i] = silu_f(c[i]);
    __syncthreads();
    float* red = lds + 4096;
    for (int cb = blockIdx.x; cb < 192; cb += gridDim.x) {
        const int cc = tid & 31, col = cb * 32 + cc, ks = tid >> 5;
        float a0 = 0.f, a1 = 0.f, a2 = 0.f, a3 = 0.f;
        for (int k = ks * 64; k < ks * 64 + 64; ++k) {
            const float wv = w[(size_t)k * 6144 + col];
            a0 += lds[k] * wv; a1 += lds[1024 + k] * wv; a2 += lds[2048 + k] * wv; a3 += lds[3072 + k] * wv;
        }
        red[(ks * 4 + 0) * 32 + cc] = a0; red[(ks * 4 + 1) * 32 + cc] = a1; red[(ks * 4 + 2) * 32 + cc] = a2; red[(ks * 4 + 3) * 32 + cc] = a3;
        __syncthreads();
        if (tid < 128) {
            const int b = tid >> 5; float s = 0.f;
            for (int q = 0; q < 16; ++q) s += red[(q * 4 + b) * 32 + cc];
            mod[b * 6144 + col] = s + bias[col];
        }
        __syncthreads();
    }
    if (blockIdx.x == 0 && tid < 64) ((int*)(p.ws + WS_CTL))[tid] = 0;
}

__device__ __forceinline__ void phase_mod1(const Params& p) {
    const float* x = p.in[0]; const float* nw = p.in[4]; const float* w_in = p.in[5];
    const float* mod = (const float*)(p.ws + WS_MOD);
    h16* hout = (h16*)(p.ws + WS_H16); float* ba = (float*)(p.ws + WS_BA);
    const int tid_ = otid(); const int lane = tid_ & 63, wave = tid_ >> 6;
    const int gw = blockIdx.x * NWAVES + wave, NGW = gridDim.x * NWAVES;
    for (int row = gw; row < T; row += NGW) {
        const int b = row / SEQ;
        const float* shift = mod + b * 6144; const float* scale = shift + 1024;
        const f32x4* xr = (const f32x4*)(x + (size_t)row * D) + lane;
        f32x4 v[4]; float ss = 0.f;
#pragma unroll
        for (int j = 0; j < 4; ++j) { v[j] = xr[64 * j]; ss += v[j][0] * v[j][0] + v[j][1] * v[j][1] + v[j][2] * v[j][2] + v[j][3] * v[j][3]; }
        const float rstd = rsqrtf(wave_sum(ss) * (1.f / D) + EPS);
        float pb[8];
#pragma unroll
        for (int e = 0; e < 8; ++e) pb[e] = 0.f;
#pragma unroll
        for (int j = 0; j < 4; ++j) {
            const int col = 256 * j + 4 * lane;
            const f32x4 w4 = *(const f32x4*)(nw + col), sc = *(const f32x4*)(scale + col), sh = *(const f32x4*)(shift + col);
            f32x4 hv;
#pragma unroll
            for (int i = 0; i < 4; ++i) hv[i] = v[j][i] * rstd * w4[i] * (1.f + sc[i]) + sh[i];
            h16x4 o; o[0] = (h16)hv[0]; o[1] = (h16)hv[1]; o[2] = (h16)hv[2]; o[3] = (h16)hv[3];
            *(h16x4*)(hout + (size_t)row * D + col) = o;
#pragma unroll
            for (int i = 0; i < 4; ++i) {
                const f32x4 wa = *(const f32x4*)(w_in + (size_t)(col + i) * INC + INC_MAIN);
                const f32x4 wb = *(const f32x4*)(w_in + (size_t)(col + i) * INC + INC_MAIN + 4);
#pragma unroll
                for (int e = 0; e < 4; ++e) { pb[e] += hv[i] * wa[e]; pb[4 + e] += hv[i] * wb[e]; }
            }
        }
#pragma unroll
        for (int e = 0; e < 8; ++e) pb[e] = wave_sum(pb[e]);
        if (lane == 0) {
            *(f32x4*)(ba + (size_t)row * 8) = (f32x4){pb[0], pb[1], pb[2], pb[3]};
            *(f32x4*)(ba + (size_t)row * 8 + 4) = (f32x4){pb[4], pb[5], pb[6], pb[7]};
        }
    }
}

struct RowPlain { const h16* base; int row0; __device__ __forceinline__ const h16* operator()(int r) const { return base + (size_t)(row0 + r) * D; } };
struct ColPlain { int n0; __device__ __forceinline__ int operator()(int n) const { return n0 + n; } };
struct EpiInProj {
    unsigned char* ws; int row0, n0;
    __device__ __forceinline__ void st(int row, int c, const float* a) const {
        h16* dst; int ld, cc;
        if (c < 512) { dst = (h16*)(ws + WS_Q16); ld = 512; cc = c; }
        else if (c < 1024) { dst = (h16*)(ws + WS_K16); ld = 512; cc = c - 512; }
        else if (c < 1536) { dst = (h16*)(ws + WS_V16); ld = 512; cc = c - 1024; }
        else if (c < 3072) { dst = (h16*)(ws + WS_DQKV); ld = 1536; cc = c - 1536; }
        else { dst = (h16*)(ws + WS_Z16); ld = 512; cc = c - 3072; }
        h16x4 o; o[0] = (h16)a[0]; o[1] = (h16)a[1]; o[2] = (h16)a[2]; o[3] = (h16)a[3];
        *(h16x4*)(dst + (size_t)row * ld + cc) = o;
    }
    __device__ __forceinline__ void operator()(int r, int n, const float* a) const { st(row0 + r, n0 + n, a); st(row0 + r, n0 + 64 + n, a + 4); }
};
__device__ __forceinline__ void phase_inproj(const Params& p, float* lds) {
    const h16* h = (const h16*)(p.ws + WS_H16);
    constexpr int NT = INC_MAIN / 128, MT = T / 128;
    for (int u = blockIdx.x; u < NT * MT; u += gridDim.x) {
        const int mt = u / NT, nt = u % NT;
        gemm_tile(lds, D, p.in[5], INC, RowPlain{h, mt * 128}, ColPlain{nt * 128}, EpiInProj{p.ws, mt * 128, nt * 128});
    }
}

__device__ __forceinline__ void phase_dnprep(const Params& p) {
    const h16* dqkv = (const h16*)(p.ws + WS_DQKV);
    const float* cw = p.in[6]; const float* A_log = p.in[7]; const float* dt_bias = p.in[8];
    const float* ba = (const float*)(p.ws + WS_BA);
    h16* qn = (h16*)(p.ws + WS_QN); h16* kn = (h16*)(p.ws + WS_KN); h16* vv = (h16*)(p.ws + WS_VV);
    float* g = (float*)(p.ws + WS_G); float* beta = g + (size_t)T * 4;
    const int tid_ = otid(); const int lane = tid_ & 63, wave = tid_ >> 6;
    const int gw = blockIdx.x * NWAVES + wave, NGW = gridDim.x * NWAVES;
    for (int it = gw; it < T * DH; it += NGW) {
        const int row = it >> 2, hd = it & 3, tpos = row % SEQ;
        float y[3][2];
#pragma unroll
        for (int part = 0; part < 3; ++part) {
            const int ch = part * 512 + hd * 128 + 2 * lane;
            float a0 = 0.f, a1 = 0.f;
#pragma unroll
            for (int j = 0; j < 4; ++j) {
                const int tt = tpos - 3 + j;
                if (tt >= 0) {
                    const h16x2 xv = *(const h16x2*)(dqkv + (size_t)(row - 3 + j) * DCONV + ch);
                    const f32x2 wv = *(const f32x2*)(cw + j * DCONV + ch);
                    a0 += (float)xv[0] * wv[0]; a1 += (float)xv[1] * wv[1];
                }
            }
            y[part][0] = silu_f(a0); y[part][1] = silu_f(a1);
        }
        const float sq = wave_sum(y[0][0] * y[0][0] + y[0][1] * y[0][1]);
        const float sk = wave_sum(y[1][0] * y[1][0] + y[1][1] * y[1][1]);
        const float rq = rsqrtf(sq + EPS) * 0.08838834764831845f, rk = rsqrtf(sk + EPS);
        const size_t o = (size_t)row * DW + hd * 128 + 2 * lane;
        h16x2 t2;
        t2[0] = (h16)(y[0][0] * rq); t2[1] = (h16)(y[0][1] * rq); *(h16x2*)(qn + o) = t2;
        t2[0] = (h16)(y[1][0] * rk); t2[1] = (h16)(y[1][1] * rk); *(h16x2*)(kn + o) = t2;
        t2[0] = (h16)y[2][0]; t2[1] = (h16)y[2][1]; *(h16x2*)(vv + o) = t2;
        if (lane == 0) {
            const float dbv = ba[(size_t)row * 8 + hd], dav = ba[(size_t)row * 8 + 4 + hd];
            const float xsp = dav + dt_bias[hd];
            const float sp = (xsp > 20.f) ? xsp : log1pf(__expf(xsp));
            g[(size_t)row * 4 + hd] = -__expf(A_log[hd]) * sp;
            beta[(size_t)row * 4 + hd] = sigmoid_f(dbv);
        }
    }
}

__device__ __forceinline__ void phase_scan_naive(const Params& p, float* ldsf, int bh) {
    const h16* qn = (const h16*)(p.ws + WS_QN); const h16* kn = (const h16*)(p.ws + WS_KN); const h16* vv = (const h16*)(p.ws + WS_VV);
    const float* g = (const float*)(p.ws + WS_G); const float* beta = g + (size_t)T * 4;
    float* o32 = (float*)(p.ws + WS_O32);
    h16* qs = (h16*)ldsf; h16* ks = qs + 64 * 128; h16* vs = ks + 64 * 128; float* gs = (float*)(vs + 64 * 128); float* bs = gs + 64;
    const int tid = otid(), b = bh >> 2, hd = bh & 3;
    float S[64];
#pragma unroll
    for (int i = 0; i < 64; ++i) S[i] = 0.f;
    const int col = tid >> 1, hf = tid & 1;
    for (int chunk = 0; chunk < SEQ / 64; ++chunk) {
        const size_t t0 = (size_t)b * SEQ + chunk * 64;
        for (int i = tid; i < 1024; i += NTHREADS) {
            const int r = i >> 4, c = (i & 15) * 8; const size_t go = (t0 + r) * DW + hd * 128 + c;
            *(h16x8*)(qs + r * 128 + c) = *(const h16x8*)(qn + go);
            *(h16x8*)(ks + r * 128 + c) = *(const h16x8*)(kn + go);
            *(h16x8*)(vs + r * 128 + c) = *(const h16x8*)(vv + go);
        }
        if (tid < 64) { gs[tid] = g[(t0 + tid) * 4 + hd]; bs[tid] = beta[(t0 + tid) * 4 + hd]; }
        __syncthreads();
        if (tid < 256) {
            for (int s = 0; s < 64; ++s) {
                const float eg = __expf(gs[s]), bt = bs[s];
                float dot = 0.f;
#pragma unroll
                for (int i = 0; i < 64; i += 8) {
                    const h16x8 kk = *(const h16x8*)(ks + s * 128 + hf * 64 + i);
#pragma unroll
                    for (int j = 0; j < 8; ++j) dot += (float)kk[j] * S[i + j];
                }
                dot += __shfl_xor(dot, 1);
                const float vn = bt * ((float)vs[s * 128 + col] - eg * dot);
                float o = 0.f;
#pragma unroll
                for (int i = 0; i < 64; i += 8) {
                    const h16x8 kk = *(const h16x8*)(ks + s * 128 + hf * 64 + i);
                    const h16x8 qq = *(const h16x8*)(qs + s * 128 + hf * 64 + i);
#pragma unroll
                    for (int j = 0; j < 8; ++j) { S[i + j] = eg * S[i + j] + (float)kk[j] * vn; o += (float)qq[j] * S[i + j]; }
                }
                o += __shfl_xor(o, 1);
                if (hf == 0) o32[(t0 + s) * DW + hd * 128 + col] = o;
            }
        }
        __syncthreads();
    }
}


constexpr int DN_REC = 73728, DN_NW = 0, DN_QD = 16384, DN_KD = 32768, DN_IN = 49152, DN_U = 57344, DN_GL = 51200;
__device__ __forceinline__ void phase_dnchunk(const Params& p, unsigned char* lds) {
    const h16* qn = (const h16*)(p.ws + WS_QN); const h16* kn = (const h16*)(p.ws + WS_KN); const h16* vv = (const h16*)(p.ws + WS_VV);
    const float* g = (const float*)(p.ws + WS_G); const float* beta = g + (size_t)T * 4;
    h16* QS = (h16*)lds; h16* KS = (h16*)(lds + 17408); h16* VS = (h16*)(lds + 34816);
    float* KKA = (float*)(lds + 52224); float* QKA = (float*)(lds + 69632); float* TMA = (float*)(lds + 87040);
    h16* UL = (h16*)(lds + 104448); h16* WL = (h16*)(lds + 121856);
    float* GC = (float*)(lds + 139264); float* BT = GC + 64; float* EG = GC + 128;
    const int tid = otid(), lane = tid & 63, wave = tid >> 6;
    for (int item = blockIdx.x; item < NB * DH * (SEQ / 64); item += gridDim.x) {
        const int bh = item >> 7, n = item & 127, b = bh >> 2, hd = bh & 3;
        const size_t t0 = (size_t)b * SEQ + n * 64;
        unsigned char* rec = p.ws + WS_DNREC + (size_t)item * DN_REC;
        for (int i = tid; i < 1024; i += NTHREADS) {
            const int r = i >> 4, c = (i & 15) * 8; const size_t go = (t0 + r) * DW + hd * 128 + c;
            *(h16x8*)(QS + r * 136 + c) = *(const h16x8*)(qn + go);
            *(h16x8*)(KS + r * 136 + c) = *(const h16x8*)(kn + go);
            *(h16x8*)(VS + r * 136 + c) = *(const h16x8*)(vv + go);
        }
        if (wave == 0) {
            float x = g[(t0 + lane) * 4 + hd];
#pragma unroll
            for (int o = 1; o < 64; o <<= 1) { const float y = __shfl_up(x, o); if (lane >= o) x += y; }
            GC[lane] = x; EG[lane] = __expf(x); BT[lane] = beta[(t0 + lane) * 4 + hd];
        }
        __syncthreads();
        {
            const int i = tid >> 3, jj = tid & 7;
            float kk[8], qk[8];
#pragma unroll
            for (int m = 0; m < 8; ++m) { kk[m] = 0.f; qk[m] = 0.f; }
            for (int dc = 0; dc < 16; ++dc) {
                const h16x8 qi = *(const h16x8*)(QS + i * 136 + dc * 8), ki = *(const h16x8*)(KS + i * 136 + dc * 8);
#pragma unroll
                for (int m = 0; m < 8; ++m) {
                    const h16x8 kj = *(const h16x8*)(KS + (jj + 8 * m) * 136 + dc * 8);
#pragma unroll
                    for (int q = 0; q < 8; ++q) { kk[m] += (float)ki[q] * (float)kj[q]; qk[m] += (float)qi[q] * (float)kj[q]; }
                }
            }
            const float gi = GC[i], bi = BT[i];
#pragma unroll
            for (int m = 0; m < 8; ++m) {
                const int j = jj + 8 * m;
                const float dec = (j <= i) ? __expf(gi - GC[j]) : 0.f;
                KKA[i * 68 + j] = (j < i) ? bi * kk[m] * dec : 0.f;
                QKA[i * 68 + j] = qk[m] * dec;
            }
        }
        __syncthreads();
        if (wave == 0) {
            float Tc[64];
            int zl = 0; asm volatile("" : "+v"(zl));
            const float* Arow = KKA + zl;
#pragma unroll
            for (int i = 0; i < 64; ++i) {
                float a = (i == lane) ? 1.f : 0.f;
#pragma unroll
                for (int j4 = 0; j4 < i; j4 += 4) {
                    const f32x4 av = *(const f32x4*)(Arow + i * 68 + j4);
#pragma unroll
                    for (int q = 0; q < 4; ++q) if (j4 + q < i) a -= av[q] * Tc[j4 + q];
                }
                Tc[i] = a;
                TMA[i * 68 + lane] = a;
            }
        }
        __syncthreads();
        {
            const int dp = tid & 63, ig = tid >> 6;
            float U0[8], U1[8], W0[8], W1[8];
#pragma unroll
            for (int r = 0; r < 8; ++r) { U0[r] = 0.f; U1[r] = 0.f; W0[r] = 0.f; W1[r] = 0.f; }
            for (int j = 0; j < 8 * ig + 8; ++j) {
                const h16x2 vj = *(const h16x2*)(VS + j * 136 + 2 * dp), kj = *(const h16x2*)(KS + j * 136 + 2 * dp);
                const float bj = BT[j], ej = EG[j];
                const float v0 = (float)vj[0] * bj, v1 = (float)vj[1] * bj, k0 = (float)kj[0] * bj * ej, k1 = (float)kj[1] * bj * ej;
#pragma unroll
                for (int r = 0; r < 8; ++r) { const float t = TMA[(8 * ig + r) * 68 + j]; U0[r] += t * v0; U1[r] += t * v1; W0[r] += t * k0; W1[r] += t * k1; }
            }
#pragma unroll
            for (int r = 0; r < 8; ++r) {
                h16x2 t2; t2[0] = (h16)U0[r]; t2[1] = (h16)U1[r]; *(h16x2*)(UL + (8 * ig + r) * 136 + 2 * dp) = t2;
                t2[0] = (h16)(-W0[r]); t2[1] = (h16)(-W1[r]); *(h16x2*)(WL + (8 * ig + r) * 136 + 2 * dp) = t2;
            }
        }
        __syncthreads();
        const float gclast = GC[63];
        for (int pc = tid; pc < 4608; pc += NTHREADS) {
            h16x8 o; int off;
            if (pc < 2048) {
                const int arr = pc >> 10, q = pc & 1023, fs = q >> 6, l = q & 63, mt = fs >> 3, s8 = fs & 7, r = l & 31, hh = l >> 5, c = 32 * mt + r;
                const h16* src = (arr == 0 ? WL : QS) + c * 136 + 16 * s8 + 4 * hh;
                const h16x4 lo = *(const h16x4*)src, hi = *(const h16x4*)(src + 8);
                const float sc = (arr == 0) ? 1.f : EG[c];
#pragma unroll
                for (int j = 0; j < 4; ++j) { o[j] = (h16)((float)lo[j] * sc); o[4 + j] = (h16)((float)hi[j] * sc); }
                off = (arr == 0 ? DN_NW : DN_QD) + q * 16;
            } else if (pc < 3072) {
                const int q = pc - 2048, fs = q >> 6, l = q & 63, kt = fs >> 2, s4 = fs & 3, r = l & 31, hh = l >> 5, dk = 32 * kt + r;
#pragma unroll
                for (int j = 0; j < 8; ++j) { const int c = 16 * s4 + 8 * (j >> 2) + 4 * hh + (j & 3); o[j] = (h16)((float)KS[c * 136 + dk] * __expf(gclast - GC[c])); }
                off = DN_KD + q * 16;
            } else if (pc < 3584) {
                const int q = pc - 3072, fs = q >> 6, l = q & 63, mt = fs >> 2, s4 = fs & 3, r = l & 31, hh = l >> 5, c = 32 * mt + r;
#pragma unroll
                for (int j = 0; j < 8; ++j) { const int c2 = 16 * s4 + 8 * (j >> 2) + 4 * hh + (j & 3); o[j] = (h16)QKA[c * 68 + c2]; }
                off = DN_IN + q * 16;
                if (fs == 2 && l == 0) { const float gl = __expf(gclast); const unsigned gb = __float_as_uint(gl); unsigned short lo16 = (unsigned short)(gb & 0xffffu), hi16 = (unsigned short)(gb >> 16);
                    o[0] = __builtin_bit_cast(h16, lo16); o[1] = __builtin_bit_cast(h16, hi16); }
            } else {
                const int q = pc - 3584, half8 = q & 1, l = (q >> 1) & 63, ms = q >> 7, mt = ms >> 2, sl = ms & 3, col = l & 31, hh = l >> 5;
#pragma unroll
                for (int j = 0; j < 8; ++j) { const int i = 8 * half8 + j; const int c = 32 * mt + (i & 3) + 8 * (i >> 2) + 4 * hh; o[j] = UL[c * 136 + 32 * sl + col]; }
                off = DN_U + q * 16;
            }
            *(h16x8*)(rec + off) = o;
        }
        __syncthreads();
    }
}

typedef float f32x16 __attribute__((ext_vector_type(16)));
typedef unsigned u32x4 __attribute__((ext_vector_type(4)));
__device__ __forceinline__ void cvt_frags(const f32x16& a, h16x8& f0, h16x8& f1) {
#pragma unroll
    for (int j = 0; j < 8; ++j) { f0[j] = (h16)a[j]; f1[j] = (h16)a[8 + j]; }
}
__device__ __forceinline__ void phase_scan_mfma(const Params& p, unsigned char* lds, int bh) {
    const int tid = otid(), lane = tid & 63, wave = __builtin_amdgcn_readfirstlane(tid >> 6);
    const unsigned char* recs = p.ws + WS_DNREC + (size_t)bh * 128 * DN_REC;
    constexpr int NCH = SEQ / 64;
    if (wave >= 4) {
        const int lt = tid - 256;
        u32x4 RA[18], RB[18];
#define DN_LOAD(R, n) do { const u32x4* s_ = (const u32x4*)(recs + (size_t)(n) * DN_REC) + lt; _Pragma("unroll") for (int k = 0; k < 18; ++k) R[k] = s_[k * 256]; } while (0)
#define DN_WRITE(R, n) do { u32x4* d_ = (u32x4*)(lds + ((n) & 1) * DN_REC) + lt; _Pragma("unroll") for (int k = 0; k < 18; ++k) d_[k * 256] = R[k]; } while (0)
        DN_LOAD(RA, 0); DN_WRITE(RA, 0); DN_LOAD(RB, 1);
        __syncthreads();
        for (int n = 0; n < NCH; n += 2) {
            if (n + 2 < NCH) DN_LOAD(RA, n + 2);
            DN_WRITE(RB, n + 1);
            __syncthreads();
            if (n + 3 < NCH) DN_LOAD(RB, n + 3);
            if (n + 2 < NCH) DN_WRITE(RA, n + 2);
            __syncthreads();
        }
#undef DN_LOAD
#undef DN_WRITE
    } else {
        const int b = bh >> 2, hd = bh & 3, sl = wave, col = lane & 31, hh = lane >> 5;
        float* o32 = (float*)(p.ws + WS_O32);
        f32x16 S[4];
        h16x8 S16[4][2];
#pragma unroll
        for (int kt = 0; kt < 4; ++kt) {
#pragma unroll
            for (int i = 0; i < 16; ++i) S[kt][i] = 0.f;
#pragma unroll
            for (int j = 0; j < 8; ++j) { S16[kt][0][j] = (h16)0.f; S16[kt][1][j] = (h16)0.f; }
        }
        __syncthreads();
        for (int n = 0; n < NCH; ++n) {
            const unsigned char* buf = lds + (n & 1) * DN_REC;
            const float gl = *(const float*)(buf + DN_GL);
            f32x16 VN[2], O[2];
#pragma unroll
            for (int mt = 0; mt < 2; ++mt) {
                const h16x8* up = (const h16x8*)(buf + DN_U + ((mt * 4 + sl) * 64 + lane) * 32);
                const h16x8 u0 = up[0], u1 = up[1];
#pragma unroll
                for (int j = 0; j < 8; ++j) { VN[mt][j] = (float)u0[j]; VN[mt][8 + j] = (float)u1[j]; }
#pragma unroll
                for (int s8 = 0; s8 < 8; ++s8) {
                    const h16x8 a = *(const h16x8*)(buf + DN_NW + (mt * 8 + s8) * 1024 + lane * 16);
                    VN[mt] = __builtin_amdgcn_mfma_f32_32x32x16_f16(a, S16[s8 >> 1][s8 & 1], VN[mt], 0, 0, 0);
                }
            }
            h16x8 VN16[2][2];
            cvt_frags(VN[0], VN16[0][0], VN16[0][1]); cvt_frags(VN[1], VN16[1][0], VN16[1][1]);
#pragma unroll
            for (int mt = 0; mt < 2; ++mt) {
#pragma unroll
                for (int i = 0; i < 16; ++i) O[mt][i] = 0.f;
#pragma unroll
                for (int s8 = 0; s8 < 8; ++s8) {
                    const h16x8 a = *(const h16x8*)(buf + DN_QD + (mt * 8 + s8) * 1024 + lane * 16);
                    O[mt] = __builtin_amdgcn_mfma_f32_32x32x16_f16(a, S16[s8 >> 1][s8 & 1], O[mt], 0, 0, 0);
                }
#pragma unroll
                for (int s4 = 0; s4 < 4; ++s4) {
                    if ((s4 >> 1) <= mt) {
                        const h16x8 a = *(const h16x8*)(buf + DN_IN + (mt * 4 + s4) * 1024 + lane * 16);
                        O[mt] = __builtin_amdgcn_mfma_f32_32x32x16_f16(a, VN16[s4 >> 1][s4 & 1], O[mt], 0, 0, 0);
                    }
                }
                const size_t t0 = (size_t)b * SEQ + n * 64 + 32 * mt + 4 * hh;
#pragma unroll
                for (int i = 0; i < 16; ++i) o32[(t0 + (i & 3) + 8 * (i >> 2)) * DW + hd * 128 + 32 * sl + col] = O[mt][i];
            }
#pragma unroll
            for (int kt = 0; kt < 4; ++kt) {
#pragma unroll
                for (int i = 0; i < 16; ++i) S[kt][i] *= gl;
#pragma unroll
                for (int s4 = 0; s4 < 4; ++s4) {
                    const h16x8 a = *(const h16x8*)(buf + DN_KD + (kt * 4 + s4) * 1024 + lane * 16);
                    S[kt] = __builtin_amdgcn_mfma_f32_32x32x16_f16(a, VN16[s4 >> 1][s4 & 1], S[kt], 0, 0, 0);
                }
                cvt_frags(S[kt], S16[kt][0], S16[kt][1]);
            }
            __syncthreads();
        }
    }
}

__device__ __forceinline__ void phase_attn_naive(const Params& p, int vblock, int nvblocks) {
    const h16* q16 = (const h16*)(p.ws + WS_Q16); const h16* k16 = (const h16*)(p.ws + WS_K16); const h16* v16 = (const h16*)(p.ws + WS_V16);
    h16* mix = (h16*)(p.ws + WS_MIX);
    const int tid_ = otid(); const int lane = tid_ & 63, wave = tid_ >> 6;
    const int gw = vblock * NWAVES + wave, NGW = nvblocks * NWAVES;
    for (int it = gw; it < T * AH; it += NGW) {
        const int row = it >> 3, hd = it & 7, tpos = row % SEQ;
        float q[64];
        {
            const h16x8* qp = (const h16x8*)(q16 + (size_t)row * AW + hd * 64);
#pragma unroll
            for (int i = 0; i < 8; ++i) { const h16x8 t8 = qp[i];
#pragma unroll
                for (int j = 0; j < 8; ++j) q[i * 8 + j] = (float)t8[j]; }
        }
        float s[7]; int tk[7];
        float m = -INFINITY;
#pragma unroll
        for (int e = 0; e < 7; ++e) {
            const int idx = e * 64 + lane;
            const int br = idx / 129, j = idx - br * 129;
            const int dil = (br == 0) ? 1 : ((br == 1) ? 4 : 16);
            const int tkk = tpos - j * dil;
            const bool valid = (idx < 387) && (tkk >= 0);
            tk[e] = valid ? (row - j * dil) : -1;
            float sc = -INFINITY;
            if (valid) {
                const h16x8* kp = (const h16x8*)(k16 + (size_t)(row - j * dil) * AW + hd * 64);
                float acc = 0.f;
#pragma unroll
                for (int i = 0; i < 8; ++i) { const h16x8 t8 = kp[i];
#pragma unroll
                    for (int jj = 0; jj < 8; ++jj) acc += q[i * 8 + jj] * (float)t8[jj]; }
                sc = acc * 0.125f;
            }
            s[e] = sc; m = fmaxf(m, sc);
        }
        m = wave_max(m);
        float l = 0.f;
#pragma unroll
        for (int e = 0; e < 7; ++e) { s[e] = (tk[e] >= 0) ? __expf(s[e] - m) : 0.f; l += s[e]; }
        l = wave_sum(l);
        float o = 0.f;
#pragma unroll
        for (int e = 0; e < 7; ++e) {
            const int nsrc = (e < 6) ? 64 : 3;
            for (int src = 0; src < nsrc; ++src) {
                const float pp = __shfl(s[e], src); const int tr = __shfl(tk[e], src);
                if (tr >= 0) o += pp * (float)v16[(size_t)tr * AW + hd * 64 + lane];
            }
        }
        mix[(size_t)row * D + hd * 64 + lane] = (h16)(o / l);
    }
}


constexpr int AT_KS_STRIDE = 72, AT_VT_STRIDE = 388, AT_VT_OFF = 384 * AT_KS_STRIDE * 2;
__device__ __forceinline__ void phase_attn_mfma(const Params& p, unsigned char* lds, int vblock, int nvblocks) {
    const h16* q16 = (const h16*)(p.ws + WS_Q16); const h16* k16 = (const h16*)(p.ws + WS_K16); const h16* v16 = (const h16*)(p.ws + WS_V16);
    h16* ao = (h16*)(p.ws + WS_AO); float* lse = (float*)(p.ws + WS_LSE);
    h16* Ks = (h16*)lds; h16* Vt = (h16*)(lds + AT_VT_OFF);
    const int tid = otid(), lane = tid & 63, w = tid >> 6, ql = lane & 31, hh = lane >> 5;
    for (int u = vblock; u < 3 * 1024; u += nvblocks) {
        const int g = u >> 10, rem = u & 1023, bh = rem >> 5, x = rem & 31, b = bh >> 3, hd = bh & 7;
        const int dil = (g == 0) ? 1 : ((g == 1) ? 4 : 16);
        const int r = x & (dil - 1), nb = x / dil, m0 = nb * 256;
        const size_t rowbase = (size_t)b * SEQ + r;
        const size_t qrow = rowbase + (size_t)(m0 + 32 * w + ql) * dil;
        h16x8 qf[4];
#pragma unroll
        for (int s4 = 0; s4 < 4; ++s4) qf[s4] = *(const h16x8*)(q16 + qrow * AW + hd * 64 + 16 * s4 + 8 * hh);
        __syncthreads();
        for (int idx = tid; idx < 384 * 8; idx += NTHREADS) {
            const int kk = idx >> 3, pc = idx & 7, m = m0 - 128 + kk;
            h16x8 kv, vv;
#pragma unroll
            for (int j = 0; j < 8; ++j) { kv[j] = (h16)0.f; vv[j] = (h16)0.f; }
            if (m >= 0) { const size_t go = (rowbase + (size_t)m * dil) * AW + hd * 64 + pc * 8; kv = *(const h16x8*)(k16 + go); vv = *(const h16x8*)(v16 + go); }
            *(h16x8*)(Ks + kk * AT_KS_STRIDE + pc * 8) = kv;
#pragma unroll
            for (int j = 0; j < 8; ++j) Vt[(pc * 8 + j) * AT_VT_STRIDE + kk] = vv[j];
        }
        __syncthreads();
        f32x16 St[5];
#pragma unroll
        for (int kt = 0; kt < 5; ++kt) {
#pragma unroll
            for (int i = 0; i < 16; ++i) St[kt][i] = 0.f;
#pragma unroll
            for (int s4 = 0; s4 < 4; ++s4) {
                const h16x8 a = *(const h16x8*)(Ks + (32 * (w + kt) + ql) * AT_KS_STRIDE + 16 * s4 + 8 * hh);
                St[kt] = __builtin_amdgcn_mfma_f32_32x32x16_f16(a, qf[s4], St[kt], 0, 0, 0);
            }
        }
        float mx = -INFINITY;
#pragma unroll
        for (int kt = 0; kt < 5; ++kt)
#pragma unroll
            for (int i = 0; i < 16; ++i) {
                const int row = (i & 3) + 8 * (i >> 2) + 4 * hh;
                bool ok = true;
                if (kt == 0) ok = row >= ql;
                if (kt == 4) ok = row <= ql;
                if (m0 == 0) ok = ok && (32 * (w + kt) + row >= 128);
                St[kt][i] = ok ? St[kt][i] : -INFINITY;
                mx = fmaxf(mx, St[kt][i]);
            }
        mx = fmaxf(mx, __shfl_xor(mx, 32));
        float l = 0.f;
#pragma unroll
        for (int kt = 0; kt < 5; ++kt)
#pragma unroll
            for (int i = 0; i < 16; ++i) { St[kt][i] = __expf(0.125f * (St[kt][i] - mx)); l += St[kt][i]; }
        l += __shfl_xor(l, 32);
        f32x16 Ot[2];
#pragma unroll
        for (int dt = 0; dt < 2; ++dt)
#pragma unroll
            for (int i = 0; i < 16; ++i) Ot[dt][i] = 0.f;
#pragma unroll
        for (int kt = 0; kt < 5; ++kt) {
            h16x8 pf[2];
            cvt_frags(St[kt], pf[0], pf[1]);
#pragma unroll
            for (int s2 = 0; s2 < 2; ++s2)
#pragma unroll
                for (int dt = 0; dt < 2; ++dt) {
                    const h16* vp = Vt + (32 * dt + ql) * AT_VT_STRIDE + 32 * (w + kt) + 16 * s2 + 4 * hh;
                    const h16x4 lo = *(const h16x4*)vp, hi = *(const h16x4*)(vp + 8);
                    h16x8 a;
#pragma unroll
                    for (int j = 0; j < 4; ++j) { a[j] = lo[j]; a[4 + j] = hi[j]; }
                    Ot[dt] = __builtin_amdgcn_mfma_f32_32x32x16_f16(a, pf[s2], Ot[dt], 0, 0, 0);
                }
        }
        const float inv = 1.f / l;
        h16* orow = ao + ((size_t)g * T + qrow) * AW + hd * 64;
#pragma unroll
        for (int dt = 0; dt < 2; ++dt)
#pragma unroll
            for (int i4 = 0; i4 < 4; ++i4) {
                h16x4 o;
#pragma unroll
                for (int j = 0; j < 4; ++j) o[j] = (h16)(Ot[dt][4 * i4 + j] * inv);
                *(h16x4*)(orow + 32 * dt + 8 * i4 + 4 * hh) = o;
            }
        if (hh == 0) lse[((size_t)g * T + qrow) * 8 + hd] = 0.125f * mx + __logf(l);
    }
}

__device__ __forceinline__ void phase_dnout(const Params& p) {
    const float* o32 = (const float*)(p.ws + WS_O32); const h16* z16 = (const h16*)(p.ws + WS_Z16); const float* nw = p.in[9];
    h16* mix = (h16*)(p.ws + WS_MIX);
    const int tid_ = otid(); const int lane = tid_ & 63, wave = tid_ >> 6;
    const int gw = blockIdx.x * NWAVES + wave, NGW = gridDim.x * NWAVES;
    {
        const h16* ao = (const h16*)(p.ws + WS_AO); const float* lse = (const float*)(p.ws + WS_LSE);
        for (int row = gw; row < T; row += NGW) {
            const int hd = lane >> 3;
            const float l0 = lse[((size_t)0 * T + row) * 8 + hd], l1 = lse[((size_t)1 * T + row) * 8 + hd], l2 = lse[((size_t)2 * T + row) * 8 + hd];
            const float m = fmaxf(l0, fmaxf(l1, l2));
            const float e0 = __expf(l0 - m), e1 = __expf(l1 - m), e2 = __expf(l2 - m), inv = 1.f / (e0 + e1 + e2);
            const h16x8 a0 = *(const h16x8*)(ao + ((size_t)0 * T + row) * AW + lane * 8), a1 = *(const h16x8*)(ao + ((size_t)1 * T + row) * AW + lane * 8),
                        a2 = *(const h16x8*)(ao + ((size_t)2 * T + row) * AW + lane * 8);
            h16x8 o;
#pragma unroll
            for (int j = 0; j < 8; ++j) o[j] = (h16)((e0 * (float)a0[j] + e1 * (float)a1[j] + e2 * (float)a2[j]) * inv);
            *(h16x8*)(mix + (size_t)row * D + lane * 8) = o;
        }
    }
    for (int it = gw; it < T * DH; it += NGW) {
        const int row = it >> 2, hd = it & 3;
        const f32x2 ov = *(const f32x2*)(o32 + (size_t)row * DW + hd * 128 + 2 * lane);
        const float rstd = rsqrtf(wave_sum(ov[0] * ov[0] + ov[1] * ov[1]) * (1.f / 128.f) + EPS);
        const h16x2 zv = *(const h16x2*)(z16 + (size_t)row * DW + hd * 128 + 2 * lane);
        const f32x2 w2 = *(const f32x2*)(nw + 2 * lane);
        h16x2 r; r[0] = (h16)(ov[0] * rstd * w2[0] * silu_f((float)zv[0])); r[1] = (h16)(ov[1] * rstd * w2[1] * silu_f((float)zv[1]));
        *(h16x2*)(mix + (size_t)row * D + 512 + hd * 128 + 2 * lane) = r;
    }
}

struct EpiOutProj {
    const float* x; const float* mod; float* x1; int row0, n0;
    __device__ __forceinline__ void st(int row, int c, const float* a) const {
        const int b = row / SEQ; const f32x4 gt = *(const f32x4*)(mod + b * 6144 + 2048 + c); const f32x4 xv = *(const f32x4*)(x + (size_t)row * D + c);
        f32x4 o; o[0] = xv[0] + gt[0] * a[0]; o[1] = xv[1] + gt[1] * a[1]; o[2] = xv[2] + gt[2] * a[2]; o[3] = xv[3] + gt[3] * a[3];
        *(f32x4*)(x1 + (size_t)row * D + c) = o;
    }
    __device__ __forceinline__ void operator()(int r, int n, const float* a) const { st(row0 + r, n0 + n, a); st(row0 + r, n0 + 64 + n, a + 4); }
};
__device__ __forceinline__ void phase_outproj(const Params& p, float* lds) {
    const h16* mix = (const h16*)(p.ws + WS_MIX);
    constexpr int NT = D / 128, MT = T / 128;
    for (int u = blockIdx.x; u < NT * MT; u += gridDim.x) {
        const int mt = u / NT, nt = u % NT;
        gemm_tile(lds, D, p.in[10], D, RowPlain{mix, mt * 128}, ColPlain{nt * 128},
                  EpiOutProj{p.in[0], (const float*)(p.ws + WS_MOD), (float*)(p.ws + WS_X1), mt * 128, nt * 128});
    }
}

__device__ __forceinline__ void phase_router(const Params& p) {
    const float* x1 = (const float*)(p.ws + WS_X1); const float* nw = p.in[11]; const float* wr = p.in[12]; const float* br = p.in[13];
    const float* mod = (const float*)(p.ws + WS_MOD);
    h16* hout = (h16*)(p.ws + WS_H16);
    int* cnt = (int*)(p.ws + WS_CTL); int* tok = (int*)(p.ws + WS_TOK);
    int* asg_e = (int*)(p.ws + WS_ASG_E); int* asg_p = (int*)(p.ws + WS_ASG_P); float* asg_g = (float*)(p.ws + WS_ASG_G);
    const int tid_ = otid(); const int lane = tid_ & 63, wave = tid_ >> 6;
    const int gw = blockIdx.x * NWAVES + wave, NGW = gridDim.x * NWAVES;
    for (int row = gw; row < T; row += NGW) {
        const int b = row / SEQ;
        const float* shift = mod + b * 6144 + 3072; const float* scale = shift + 1024;
        const f32x4* xr = (const f32x4*)(x1 + (size_t)row * D) + lane;
        float ss = 0.f;
#pragma unroll
        for (int j = 0; j < 4; ++j) { const f32x4 t4 = xr[64 * j]; ss += t4[0] * t4[0] + t4[1] * t4[1] + t4[2] * t4[2] + t4[3] * t4[3]; }
        const float rstd = rsqrtf(wave_sum(ss) * (1.f / D) + EPS);
        float lg[32];
#pragma unroll
        for (int e = 0; e < 32; ++e) lg[e] = 0.f;
#pragma unroll 1
        for (int j = 0; j < 4; ++j) {
            const int col = 256 * j + 4 * lane;
            const f32x4 vj = xr[64 * j];
            const f32x4 w4 = *(const f32x4*)(nw + col), sc = *(const f32x4*)(scale + col), sh = *(const f32x4*)(shift + col);
            f32x4 hv;
#pragma unroll
            for (int i = 0; i < 4; ++i) hv[i] = vj[i] * rstd * w4[i] * (1.f + sc[i]) + sh[i];
            h16x4 o; o[0] = (h16)hv[0]; o[1] = (h16)hv[1]; o[2] = (h16)hv[2]; o[3] = (h16)hv[3];
            *(h16x4*)(hout + (size_t)row * D + col) = o;
#pragma unroll
            for (int i = 0; i < 4; ++i) {
                const f32x4* wp = (const f32x4*)(wr + (size_t)(col + i) * NE);
#pragma unroll
                for (int e4 = 0; e4 < 8; ++e4) { const f32x4 wv = wp[e4];
#pragma unroll
                    for (int e = 0; e < 4; ++e) lg[e4 * 4 + e] += hv[i] * wv[e]; }
            }
        }
#pragma unroll
        for (int e = 0; e < 32; ++e) lg[e] = wave_sum(lg[e]) + br[e];
        unsigned used = 0u; float tv[4]; int te[4];
#pragma unroll
        for (int k = 0; k < 4; ++k) {
            float best = -INFINITY; int bi = 0;
#pragma unroll
            for (int e = 0; e < 32; ++e) { const bool ok = !((used >> e) & 1u) && (lg[e] > best); best = ok ? lg[e] : best; bi = ok ? e : bi; }
            used |= 1u << bi; tv[k] = best; te[k] = bi;
        }
        float ex[4]; float sum = 0.f;
#pragma unroll
        for (int k = 0; k < 4; ++k) { ex[k] = __expf(tv[k] - tv[0]); sum += ex[k]; }
        if (lane < 4) {
            const int e = (lane == 0) ? te[0] : (lane == 1) ? te[1] : (lane == 2) ? te[2] : te[3];
            const float gt = ((lane == 0) ? ex[0] : (lane == 1) ? ex[1] : (lane == 2) ? ex[2] : ex[3]) / sum;
            const int pos = atomicAdd(cnt + e, 1);
            tok[(size_t)e * T + pos] = row;
            asg_e[row * 4 + lane] = e; asg_p[row * 4 + lane] = pos; asg_g[row * 4 + lane] = gt;
        }
    }
}

struct RowGather { const h16* base; const int* list; int nvalid; __device__ __forceinline__ const h16* operator()(int r) const { return (r < nvalid) ? base + (size_t)list[r] * D : nullptr; } };
struct RowAct { const h16* base; int nvalid; __device__ __forceinline__ const h16* operator()(int r) const { return (r < nvalid) ? base + (size_t)r * FE : nullptr; } };
struct ColGateUp { int j0; __device__ __forceinline__ int operator()(int n) const { return (n < 64) ? (j0 + n) : (1024 + j0 + (n - 64)); } };
struct EpiSwiglu {
    h16* act; const float* b1; int nvalid, j0;
    __device__ __forceinline__ void operator()(int r, int n, const float* a) const {
        if (r >= nvalid) return;
        const f32x4 bg = *(const f32x4*)(b1 + j0 + n), bu = *(const f32x4*)(b1 + 1024 + j0 + n);
        h16x4 o;
#pragma unroll
        for (int i = 0; i < 4; ++i) {
            float gt = fminf(a[i] + bg[i], 7.f); float up = fminf(fmaxf(a[4 + i] + bu[i], -7.f), 7.f);
            o[i] = (h16)(gt * sigmoid_f(1.702f * gt) * (up + 1.f));
        }
        *(h16x4*)(act + (size_t)r * FE + j0 + n) = o;
    }
};
struct EpiDown {
    h16* y; const float* b2; int nvalid, n0;
    __device__ __forceinline__ void st(int r, int c, const float* a) const {
        const f32x4 bv = *(const f32x4*)(b2 + c);
        h16x4 o; o[0] = (h16)(a[0] + bv[0]); o[1] = (h16)(a[1] + bv[1]); o[2] = (h16)(a[2] + bv[2]); o[3] = (h16)(a[3] + bv[3]);
        *(h16x4*)(y + (size_t)r * D + c) = o;
    }
    __device__ __forceinline__ void operator()(int r, int n, const float* a) const { if (r >= nvalid) return; st(r, n0 + n, a); st(r, n0 + 64 + n, a + 4); }
};
__device__ __forceinline__ void moe_prefix(const Params& p, int* li) {
    const int* cnt = (const int*)(p.ws + WS_CTL);
    if (threadIdx.x == 0) {
        int b = 0, t = 0;
        for (int e = 0; e < NE; ++e) { li[e] = b; li[40 + e] = t; const int c = cnt[e]; b += c; t += (c + 127) / 128; }
        li[NE] = b; li[40 + NE] = t;
    }
    __syncthreads();
}
__device__ __forceinline__ void phase_moe1(const Params& p, float* lds) {
    int* li = (int*)(lds + 16 * 132 + 16 * 128);
    moe_prefix(p, li);
    const int* cnt = (const int*)(p.ws + WS_CTL); const int* tok = (const int*)(p.ws + WS_TOK);
    const h16* h = (const h16*)(p.ws + WS_H16); h16* act = (h16*)(p.ws + WS_ACT);
    const int ntile = li[40 + NE]; constexpr int NT = FE / 64;
    for (int u = blockIdx.x; u < ntile * NT; u += gridDim.x) {
        const int tl = u / NT, nt = u % NT;
        int e = 0;
        for (int q = 1; q < NE; ++q) if (li[40 + q] <= tl) e = q;
        const int rt = tl - li[40 + e], nvalid = min(128, cnt[e] - rt * 128);
        gemm_tile(lds, D, p.in[14] + (size_t)e * D * 2 * FE, 2 * FE, RowGather{h, tok + (size_t)e * T + rt * 128, nvalid}, ColGateUp{nt * 64},
                  EpiSwiglu{act + (size_t)(li[e] + rt * 128) * FE, p.in[15] + (size_t)e * 2 * FE, nvalid, nt * 64});
    }
}
__device__ __forceinline__ void phase_moe2(const Params& p, float* lds) {
    int* li = (int*)(lds + 16 * 132 + 16 * 128);
    moe_prefix(p, li);
    const int* cnt = (const int*)(p.ws + WS_CTL);
    const h16* act = (const h16*)(p.ws + WS_ACT); h16* y = (h16*)(p.ws + WS_Y16);
    const int ntile = li[40 + NE]; constexpr int NT = D / 128;
    for (int u = blockIdx.x; u < ntile * NT; u += gridDim.x) {
        const int tl = u / NT, nt = u % NT;
        int e = 0;
        for (int q = 1; q < NE; ++q) if (li[40 + q] <= tl) e = q;
        const int rt = tl - li[40 + e], nvalid = min(128, cnt[e] - rt * 128);
        const size_t slot0 = (size_t)(li[e] + rt * 128);
        gemm_tile(lds, FE, p.in[16] + (size_t)e * FE * D, D, RowAct{act + slot0 * FE, nvalid}, ColPlain{nt * 128},
                  EpiDown{y + slot0 * D, p.in[17] + (size_t)e * D, nvalid, nt * 128});
    }
}

__device__ __forceinline__ void phase_final(const Params& p, float* lds) {
    int* li = (int*)lds;
    { const int* cnt = (const int*)(p.ws + WS_CTL);
      if (otid() == 0) { int t = 0; for (int e = 0; e < NE; ++e) { li[e] = t * 256; t += (cnt[e] + 255) / 256; } }
      __syncthreads(); }
    const float* x1 = (const float*)(p.ws + WS_X1); const float* mod = (const float*)(p.ws + WS_MOD); const float* fw = p.in[18];
    const h16* y = (const h16*)(p.ws + WS_Y16);
    const int* asg_e = (const int*)(p.ws + WS_ASG_E); const int* asg_p = (const int*)(p.ws + WS_ASG_P); const float* asg_g = (const float*)(p.ws + WS_ASG_G);
    const int tid_ = otid(); const int lane = tid_ & 63, wave = tid_ >> 6;
    const int gw = blockIdx.x * NWAVES + wave, NGW = gridDim.x * NWAVES;
    for (int row = gw; row < T; row += NGW) {
        const int b = row / SEQ; const float* gate2 = mod + b * 6144 + 5120;
        size_t slot[4]; float gk[4];
#pragma unroll
        for (int k = 0; k < 4; ++k) { slot[k] = (size_t)(li[asg_e[row * 4 + k]] + asg_p[row * 4 + k]); gk[k] = asg_g[row * 4 + k]; }
        f32x4 v[4]; float ss = 0.f;
#pragma unroll
        for (int j = 0; j < 4; ++j) {
            const int col = 256 * j + 4 * lane;
            f32x4 acc = (f32x4){0.f, 0.f, 0.f, 0.f};
#pragma unroll
            for (int k = 0; k < 4; ++k) { const h16x4 yv = *(const h16x4*)(y + slot[k] * D + col);
#pragma unroll
                for (int i = 0; i < 4; ++i) acc[i] += gk[k] * (float)yv[i]; }
            const f32x4 xv = *(const f32x4*)(x1 + (size_t)row * D + col), g2 = *(const f32x4*)(gate2 + col);
#pragma unroll
            for (int i = 0; i < 4; ++i) { v[j][i] = xv[i] + g2[i] * acc[i]; ss += v[j][i] * v[j][i]; }
        }
        const float rstd = rsqrtf(wave_sum(ss) * (1.f / D) + EPS);
#pragma unroll
        for (int j = 0; j < 4; ++j) {
            const int col = 256 * j + 4 * lane; const f32x4 w4 = *(const f32x4*)(fw + col);
            f32x4 o; o[0] = v[j][0] * rstd * w4[0]; o[1] = v[j][1] * rstd * w4[1]; o[2] = v[j][2] * rstd * w4[2]; o[3] = v[j][3] * rstd * w4[3];
            *(f32x4*)(p.out + (size_t)row * D + col) = o;
        }
    }
}


__device__ __forceinline__ void cvt_item(const float* W, int K, int N, h16* WT, int dst_row0, int k0, int n0, float* scr, int lane) {
#pragma unroll 8
    for (int i = 0; i < 32; ++i) { const int kk = 2 * i + (lane >> 5); scr[kk * 33 + (lane & 31)] = W[(size_t)(k0 + kk) * N + n0 + (lane & 31)]; }
    asm volatile("s_waitcnt lgkmcnt(0)" ::: "memory");
    const int c = lane & 7;
#pragma unroll
    for (int j = 0; j < 4; ++j) { const int n = (lane >> 3) + 8 * j; const float* sp = scr + (8 * c) * 33 + n;
        h16x8 o;
#pragma unroll
        for (int q = 0; q < 8; ++q) o[q] = (h16)sp[q * 33];
        *(h16x8*)(WT + (size_t)(dst_row0 + n) * K + k0 + 8 * c) = o; }
    asm volatile("s_waitcnt lgkmcnt(0)" ::: "memory");
}
__device__ __forceinline__ void phase_cvt(const Params& p, float* lds) {
    const int tid_ = otid(); const int lane = tid_ & 63, wave = tid_ >> 6;
    float* scr = lds + wave * (64 * 33);
    const int gw = blockIdx.x * NWAVES + wave, NGW = gridDim.x * NWAVES;
    constexpr int I_IN = 16 * 112, I_OUT = 16 * 32, I_W1 = 32 * 16 * 64, I_W2 = 32 * 16 * 32;
    for (int it = gw; it < I_IN + I_OUT + I_W1 + I_W2; it += NGW) {
        int r = it;
        if (r < I_IN) { const int kb = r / 112, nb = r % 112; cvt_item(p.in[5], D, INC, (h16*)(p.ws + WS_WIN16), nb * 32, kb * 64, nb * 32, scr, lane); continue; } r -= I_IN;
        if (r < I_OUT) { const int kb = r / 32, nb = r % 32; cvt_item(p.in[10], D, D, (h16*)(p.ws + WS_WOUT16), nb * 32, kb * 64, nb * 32, scr, lane); continue; } r -= I_OUT;
        if (r < I_W1) { const int e = r / 1024, q = r % 1024, kb = q / 64, nb = q % 64, n0 = nb * 32, hh = n0 / 1024, j = n0 % 1024;
            cvt_item(p.in[14] + (size_t)e * D * 2 * FE, D, 2 * FE, (h16*)(p.ws + WS_W116) + (size_t)e * 2 * FE * D, (j / 128) * 256 + hh * 128 + (j % 128), kb * 64, n0, scr, lane); continue; } r -= I_W1;
        { const int e = r / 512, q = r % 512, kb = q / 32, nb = q % 32;
            cvt_item(p.in[16] + (size_t)e * FE * D, FE, D, (h16*)(p.ws + WS_W216) + (size_t)e * D * FE, nb * 32, kb * 64, nb * 32, scr, lane); }
    }
}

typedef pg8::Unit PUnit;
struct EpiInProjM {
    static constexpr bool PERM = true; unsigned char* ws;
    __device__ __forceinline__ void operator()(const f32x4 (&acc)[2][2][4][2], const PUnit& u, int wr, int wc, int fr, int fq) const {
        const int c0 = u.pn * 256; h16* dst; int ld, cc;
        if (c0 < 512) { dst = (h16*)(ws + WS_Q16); ld = 512; cc = c0; }
        else if (c0 < 1024) { dst = (h16*)(ws + WS_K16); ld = 512; cc = c0 - 512; }
        else if (c0 < 1536) { dst = (h16*)(ws + WS_V16); ld = 512; cc = c0 - 1024; }
        else if (c0 < 3072) { dst = (h16*)(ws + WS_DQKV); ld = 1536; cc = c0 - 1536; }
        else { dst = (h16*)(ws + WS_Z16); ld = 512; cc = c0 - 3072; }
        const int col0 = cc + wc * 32 + 8 * fq;
#pragma unroll
        for (int ai = 0; ai < 2; ++ai)
#pragma unroll
            for (int m = 0; m < 4; ++m) { const size_t row = (size_t)u.pm * 256 + ai * 128 + wr * 64 + m * 16 + fr;
#pragma unroll
                for (int bj = 0; bj < 2; ++bj) { h16x8 o;
#pragma unroll
                    for (int n = 0; n < 2; ++n)
#pragma unroll
                        for (int i = 0; i < 4; ++i) o[4 * n + i] = (h16)acc[ai][bj][m][n][i];
                    *(h16x8*)(dst + row * ld + col0 + bj * 128) = o; } }
    }
};
struct EpiOutProjM {
    static constexpr bool PERM = false; const float* x; const float* mod; float* x1;
    __device__ __forceinline__ void operator()(const f32x4 (&acc)[2][2][4][2], const PUnit& u, int wr, int wc, int fr, int fq) const {
        const int col0 = u.pn * 256 + wc * 32 + 4 * fq;
#pragma unroll
        for (int ai = 0; ai < 2; ++ai)
#pragma unroll
            for (int m = 0; m < 4; ++m) { const size_t row = (size_t)u.pm * 256 + ai * 128 + wr * 64 + m * 16 + fr; const int b = (int)(row / SEQ);
#pragma unroll
                for (int bj = 0; bj < 2; ++bj)
#pragma unroll
                    for (int n = 0; n < 2; ++n) { const int c = col0 + bj * 128 + n * 16;
                        const f32x4 gt = *(const f32x4*)(mod + b * 6144 + 2048 + c); const f32x4 xv = *(const f32x4*)(x + row * D + c);
                        *(f32x4*)(x1 + row * D + c) = xv + gt * acc[ai][bj][m][n]; } }
    }
};
struct EpiSwigluM {
    static constexpr bool PERM = true; h16* act; const float* b1;
    __device__ __forceinline__ void operator()(const f32x4 (&acc)[2][2][4][2], const PUnit& u, int wr, int wc, int fr, int fq) const {
        const float* bb = b1 + (size_t)u.e * 2 * FE; const int j0 = u.pn * 128 + wc * 32 + 8 * fq;
        f32x4 bg[2], bu[2];
#pragma unroll
        for (int n = 0; n < 2; ++n) { bg[n] = *(const f32x4*)(bb + j0 + 4 * n); bu[n] = *(const f32x4*)(bb + FE + j0 + 4 * n); }
#pragma unroll
        for (int ai = 0; ai < 2; ++ai)
#pragma unroll
            for (int m = 0; m < 4; ++m) { const size_t row = (size_t)u.pm * 256 + ai * 128 + wr * 64 + m * 16 + fr; h16x8 o;
#pragma unroll
                for (int n = 0; n < 2; ++n)
#pragma unroll
                    for (int i = 0; i < 4; ++i) { const float gt = fminf(acc[ai][0][m][n][i] + bg[n][i], 7.f); const float up = fminf(fmaxf(acc[ai][1][m][n][i] + bu[n][i], -7.f), 7.f);
                        o[4 * n + i] = (h16)(gt * sigmoid_f(1.702f * gt) * (up + 1.f)); }
                *(h16x8*)(act + row * FE + j0) = o; }
    }
};
struct EpiDownM {
    static constexpr bool PERM = true; h16* y; const float* b2;
    __device__ __forceinline__ void operator()(const f32x4 (&acc)[2][2][4][2], const PUnit& u, int wr, int wc, int fr, int fq) const {
        const float* bb = b2 + (size_t)u.e * D; const int col0 = u.pn * 256 + wc * 32 + 8 * fq;
#pragma unroll
        for (int bj = 0; bj < 2; ++bj) { f32x4 bv[2];
#pragma unroll
            for (int n = 0; n < 2; ++n) bv[n] = *(const f32x4*)(bb + col0 + bj * 128 + 4 * n);
#pragma unroll
            for (int ai = 0; ai < 2; ++ai)
#pragma unroll
                for (int m = 0; m < 4; ++m) { const size_t row = (size_t)u.pm * 256 + ai * 128 + wr * 64 + m * 16 + fr; h16x8 o;
#pragma unroll
                    for (int n = 0; n < 2; ++n)
#pragma unroll
                        for (int i = 0; i < 4; ++i) o[4 * n + i] = (h16)(acc[ai][bj][m][n][i] + bv[n][i]);
                    *(h16x8*)(y + row * D + col0 + bj * 128) = o; } }
    }
};
#define LAS3 __attribute__((address_space(3)))
__device__ __forceinline__ void phase_inproj_m(const Params& p, LAS3 unsigned char* lds) {
    pg8::Order S; S.init(T / 256, INC_MAIN / 256, gridDim.x, blockIdx.x, nullptr);
    pg8::gemm_phase<EpiInProjM, false>(lds, pg8::Gemm{(const h16*)(p.ws + WS_H16), (const h16*)(p.ws + WS_WIN16), INC_MAIN, D}, S, EpiInProjM{p.ws}, nullptr);
}
__device__ __forceinline__ void phase_outproj_m(const Params& p, LAS3 unsigned char* lds) {
    pg8::Order S; S.init(T / 256, D / 256, gridDim.x, blockIdx.x, nullptr);
    pg8::gemm_phase<EpiOutProjM, false>(lds, pg8::Gemm{(const h16*)(p.ws + WS_MIX), (const h16*)(p.ws + WS_WOUT16), D, D}, S,
                                         EpiOutProjM{p.in[0], (const float*)(p.ws + WS_MOD), (float*)(p.ws + WS_X1)}, nullptr);
}
__device__ __forceinline__ void moe_prefix_m(const Params& p, LAS3 int* tab) {
    const int* cnt = (const int*)(p.ws + WS_CTL);
    if (otid() == 0) { int t = 0; for (int e = 0; e < NE; ++e) { tab[e] = t; t += (cnt[e] + 255) / 256; } tab[NE] = t; }
    __syncthreads();
}
__device__ __forceinline__ void phase_moe1_m(const Params& p, LAS3 unsigned char* lds) {
    LAS3 int* tab = (LAS3 int*)(lds + LDS_TAB); LAS3 int* gtab = (LAS3 int*)(lds + LDS_GTAB);
    moe_prefix_m(p, tab);
    const int* cnt = (const int*)(p.ws + WS_CTL); const int* tok = (const int*)(p.ws + WS_TOK);
    pg8::Order S; S.init(tab[NE], 2 * FE / 256, gridDim.x, blockIdx.x, tab);
    const int tid = otid();
    for (int ui = 0; ui < GTAB_UNITS; ++ui) { PUnit u; if (!S.next(ui, u)) break;
        if (tid < 256) { const int c = cnt[u.e]; int li = (u.pm - tab[u.e]) * 256 + tid; li = li < c ? li : c - 1; gtab[ui * 256 + tid] = tok[(size_t)u.e * T + li]; } }
    __syncthreads();
    pg8::gemm_phase<EpiSwigluM, true>(lds, pg8::Gemm{(const h16*)(p.ws + WS_H16), (const h16*)(p.ws + WS_W116), 2 * FE, D}, S,
                                       EpiSwigluM{(h16*)(p.ws + WS_ACT), p.in[15]}, gtab);
}
__device__ __forceinline__ void phase_moe2_m(const Params& p, LAS3 unsigned char* lds) {
    LAS3 int* tab = (LAS3 int*)(lds + LDS_TAB);
    moe_prefix_m(p, tab);
    pg8::Order S; S.init(tab[NE], D / 256, gridDim.x, blockIdx.x, tab);
    pg8::gemm_phase<EpiDownM, false>(lds, pg8::Gemm{(const h16*)(p.ws + WS_ACT), (const h16*)(p.ws + WS_W216), D, FE}, S,
                                      EpiDownM{(h16*)(p.ws + WS_Y16), p.in[17]}, nullptr);
}


typedef float f32x4_t __attribute__((ext_vector_type(4)));
template <int MODE>
__device__ __forceinline__ void phase_rowproj(const Params& p, unsigned char* lds) {
    constexpr int NET = (MODE == 0) ? 1 : 2, RS = 1032;
    const float* xin = (MODE == 0) ? p.in[0] : (const float*)(p.ws + WS_X1);
    const float* nw = (MODE == 0) ? p.in[4] : p.in[11];
    const float* mod = (const float*)(p.ws + WS_MOD);
    h16* hout = (h16*)(p.ws + WS_H16);
    h16* HI = (h16*)lds; h16* LO = (h16*)(lds + 33024); float* PART = (float*)(lds + 66048); float* LOGIT = (float*)(lds + 82432);
    int* LCNT = (int*)(lds + 84544); int* GB = (int*)(lds + 84672); int* LIST = (int*)(lds + 84800);
    const int tid = otid(), lane = tid & 63, w = tid >> 6, fr = lane & 15, fq = lane >> 4;
    int nit = 0;
    if (MODE == 1 && tid < 32) LCNT[tid] = 0;
    h16x8 Whi[NET][4], Wlo[NET][4];
#pragma unroll
    for (int et = 0; et < NET; ++et)
#pragma unroll
        for (int s4 = 0; s4 < 4; ++s4)
#pragma unroll
            for (int j = 0; j < 8; ++j) {
                const int k = 128 * w + 32 * s4 + 8 * fq + j, e = 16 * et + fr;
                float wv;
                if (MODE == 0) wv = (e < 8) ? p.in[5][(size_t)k * INC + INC_MAIN + e] : 0.f;
                else wv = p.in[12][(size_t)k * NE + e];
                wv *= 256.f;
                const h16 hi = (h16)wv; Whi[et][s4][j] = hi; Wlo[et][s4][j] = (h16)(wv - (float)hi);
            }
    for (int tile = blockIdx.x; tile < T / 16; tile += gridDim.x) {
        f32x4 v[2][4]; float ss[2];
#pragma unroll
        for (int rr = 0; rr < 2; ++rr) {
            const int row = tile * 16 + 2 * w + rr;
            const f32x4* xr = (const f32x4*)(xin + (size_t)row * D) + lane;
#pragma unroll
            for (int j = 0; j < 4; ++j) v[rr][j] = xr[64 * j];
        }
#pragma unroll
        for (int rr = 0; rr < 2; ++rr) {
            float a = 0.f;
#pragma unroll
            for (int j = 0; j < 4; ++j) a += v[rr][j][0] * v[rr][j][0] + v[rr][j][1] * v[rr][j][1] + v[rr][j][2] * v[rr][j][2] + v[rr][j][3] * v[rr][j][3];
            ss[rr] = rsqrtf(wave_sum(a) * (1.f / D) + EPS);
        }
        {
            const int b = (tile * 16) / SEQ;
            const float* shift = mod + b * 6144 + (MODE == 0 ? 0 : 3072); const float* scale = shift + 1024;
#pragma unroll
            for (int j = 0; j < 4; ++j) {
                const int col = 256 * j + 4 * lane;
                const f32x4 w4 = *(const f32x4*)(nw + col), sc = *(const f32x4*)(scale + col), sh = *(const f32x4*)(shift + col);
#pragma unroll
                for (int rr = 0; rr < 2; ++rr) {
                    const int rl = 2 * w + rr;
                    h16x4 hi4, lo4;
#pragma unroll
                    for (int i = 0; i < 4; ++i) { const float hv = v[rr][j][i] * ss[rr] * w4[i] * (1.f + sc[i]) + sh[i]; const h16 hi = (h16)hv; hi4[i] = hi; lo4[i] = (h16)(hv - (float)hi); }
                    *(h16x4*)(hout + (size_t)(tile * 16 + rl) * D + col) = hi4;
                    *(h16x4*)(HI + rl * RS + col) = hi4;
                    *(h16x4*)(LO + rl * RS + col) = lo4;
                }
            }
        }
        __syncthreads();
        {
            f32x4 acc[NET];
#pragma unroll
            for (int et = 0; et < NET; ++et) acc[et] = (f32x4){0.f, 0.f, 0.f, 0.f};
#pragma unroll
            for (int s4 = 0; s4 < 4; ++s4) {
                const h16x8 bh = *(const h16x8*)(HI + fr * RS + 128 * w + 32 * s4 + 8 * fq);
                const h16x8 bl = *(const h16x8*)(LO + fr * RS + 128 * w + 32 * s4 + 8 * fq);
#pragma unroll
                for (int et = 0; et < NET; ++et) {
                    acc[et] = __builtin_amdgcn_mfma_f32_16x16x32_f16(Whi[et][s4], bh, acc[et], 0, 0, 0);
                    acc[et] = __builtin_amdgcn_mfma_f32_16x16x32_f16(Wlo[et][s4], bh, acc[et], 0, 0, 0);
                    acc[et] = __builtin_amdgcn_mfma_f32_16x16x32_f16(Whi[et][s4], bl, acc[et], 0, 0, 0);
                }
            }
#pragma unroll
            for (int et = 0; et < NET; ++et)
#pragma unroll
                for (int i = 0; i < 4; ++i) PART[(w * 32 + 16 * et + 4 * fq + i) * 16 + fr] = acc[et][i];
        }
        __syncthreads();
        if (tid < 16 * 16 * NET) {
            const int e = tid >> 4, rl = tid & 15; float a = 0.f;
#pragma unroll
            for (int q = 0; q < 8; ++q) a += PART[(q * 32 + e) * 16 + rl];
            a *= (1.f / 256.f);
            if (MODE == 0) { if (e < 8) ((float*)(p.ws + WS_BA))[(size_t)(tile * 16 + rl) * 8 + e] = a; }
            else LOGIT[rl * 33 + e] = a + p.in[13][e];
        }
        if (MODE == 1) {
            __syncthreads();
            {
                const int rl = 2 * w + (lane >> 5), e = lane & 31, row = tile * 16 + rl;
                float v = LOGIT[rl * 33 + e];
                float tv[4]; int te[4];
#pragma unroll
                for (int k = 0; k < 4; ++k) {
                    float bv = v; int bi = e;
#pragma unroll
                    for (int o = 1; o < 32; o <<= 1) { const float ov = __shfl_xor(bv, o); const int oi = __shfl_xor(bi, o); const bool take = (ov > bv) || (ov == bv && oi < bi); bv = take ? ov : bv; bi = take ? oi : bi; }
                    tv[k] = bv; te[k] = bi; if (e == bi) v = -INFINITY;
                }
                float ex[4]; float sum = 0.f;
#pragma unroll
                for (int k = 0; k < 4; ++k) { ex[k] = __expf(tv[k] - tv[0]); sum += ex[k]; }
                if (e < 4) {
                    const int ek = (e == 0) ? te[0] : (e == 1) ? te[1] : (e == 2) ? te[2] : te[3];
                    const float gk = ((e == 0) ? ex[0] : (e == 1) ? ex[1] : (e == 2) ? ex[2] : ex[3]) / sum;
                    const int lpos = atomicAdd(LCNT + ek, 1);
                    LIST[nit * 64 + rl * 4 + e] = (ek << 16) | lpos;
                    ((int*)(p.ws + WS_ASG_E))[row * 4 + e] = ek; ((float*)(p.ws + WS_ASG_G))[row * 4 + e] = gk;
                }
            }
        }
        ++nit;
    }
    if (MODE == 1) {
        __syncthreads();
        if (tid < 32) GB[tid] = atomicAdd((int*)(p.ws + WS_CTL) + tid, LCNT[tid]);
        __syncthreads();
        int* tok = (int*)(p.ws + WS_TOK); int* asg_p = (int*)(p.ws + WS_ASG_P);
        for (int idx = tid; idx < nit * 64; idx += NTHREADS) {
            const int pk = LIST[idx], e = pk >> 16, pos = GB[e] + (pk & 0xffff);
            const int row = (blockIdx.x + (idx >> 6) * gridDim.x) * 16 + ((idx & 63) >> 2);
            asg_p[row * 4 + (idx & 3)] = pos; tok[(size_t)e * T + pos] = row;
        }
    }
}

#define XB_TMO      128
#define XB_XCNT(j)  (256  + 64 * (j))
#define XB_XSUB(j)  (1280 + 64 * (j))
#define XB_XGEN(j)  (2304 + 64 * (j))
#define XB_TOP      3328
#define XB_TOPGEN   3392
#define XCD_BAR_WORDS 3456
#define XB_SPIN_CAP (1u << 22)
__device__ __forceinline__ unsigned xb_ld(unsigned* p)              { return __hip_atomic_load(p, __ATOMIC_RELAXED, __HIP_MEMORY_SCOPE_AGENT); }
__device__ __forceinline__ unsigned xb_add(unsigned* p, unsigned v) { return __hip_atomic_fetch_add(p, v, __ATOMIC_RELAXED, __HIP_MEMORY_SCOPE_AGENT); }
__device__ __forceinline__ unsigned xb_xcc_id() { return (unsigned)__builtin_amdgcn_s_getreg((3 << 11) | 20) & 0xFu; }
#define XB_SPIN(cond, bar) do { unsigned _sp = 0; while (cond) { __builtin_amdgcn_s_sleep(1); \
    if ((++_sp & 255u) == 0u) { if (xb_ld(&(bar)[XB_TMO])) break; if (_sp > XB_SPIN_CAP) { atomicAdd(&(bar)[XB_TMO], 1u); break; } } } } while (0)
struct XcdBarrier { unsigned* bar; unsigned x; volatile __attribute__((address_space(3))) unsigned* st; };
__device__ __forceinline__ XcdBarrier xcd_barrier_post(unsigned* bar, volatile __attribute__((address_space(3))) unsigned* st) {
    XcdBarrier b; b.bar = bar; b.x = xb_xcc_id(); b.st = st;
    if (threadIdx.x == 0) (void)xb_add(&bar[XB_XCNT(b.x)], 1u);
    return b;
}
__device__ __forceinline__ void xcd_barrier_complete(unsigned* bar, unsigned x, unsigned& nloc, unsigned& nx) {
    const unsigned G = gridDim.x * gridDim.y * gridDim.z;
    unsigned sum, cnt, mine, sp = 0u;
    for (;;) {
        sum = 0u; cnt = 0u; mine = 0u;
#pragma unroll
        for (unsigned j = 0; j < 16; ++j) { const unsigned c = xb_ld(&bar[XB_XCNT(j)]); sum += c; cnt += (c > 0u) ? 1u : 0u; mine = (j == x) ? c : mine; }
        if (sum == G) break;
        __builtin_amdgcn_s_sleep(1);
        if ((++sp & 255u) == 0u) { if (xb_ld(&bar[XB_TMO])) break; if (sp > XB_SPIN_CAP) { atomicAdd(&bar[XB_TMO], 1u); break; } }
    }
    nloc = mine > 0u ? mine : 1u; nx = cnt > 0u ? cnt : 1u;
}
__device__ __forceinline__ void xcd_barrier(const XcdBarrier& b) {
    asm volatile("s_waitcnt vmcnt(0)" ::: "memory");
    __syncthreads();
    if (threadIdx.x == 0) {
        unsigned* bar = b.bar;
        __builtin_amdgcn_s_waitcnt(0);
        unsigned nloc = b.st[0], nx = b.st[1];
        if (nloc == 0u) { xcd_barrier_complete(bar, b.x, nloc, nx); b.st[0] = nloc; b.st[1] = nx; }
        const unsigned old = xb_add(&bar[XB_XSUB(b.x)], 1u);
        const unsigned gen = old / nloc;
        if (old + 1u == (gen + 1u) * nloc) {
            __builtin_amdgcn_fence(__ATOMIC_RELEASE, "agent");
            asm volatile("s_waitcnt vmcnt(0)" ::: "memory");
            const unsigned og = xb_add(&bar[XB_TOP], 1u);
            const unsigned tg = og / nx;
            if (og + 1u == (tg + 1u) * nx) xb_add(&bar[XB_TOPGEN], 1u);
            else XB_SPIN(xb_ld(&bar[XB_TOPGEN]) == tg, bar);
            __builtin_amdgcn_fence(__ATOMIC_ACQUIRE, "agent");
            xb_add(&bar[XB_XGEN(b.x)], 1u);
            asm volatile("s_waitcnt vmcnt(0)" ::: "memory");
        } else {
            XB_SPIN(xb_ld(&bar[XB_XGEN(b.x)]) == gen, bar);
            __builtin_amdgcn_fence(__ATOMIC_ACQUIRE, "agent");
            asm volatile("s_waitcnt vmcnt(0)" ::: "memory");
        }
    }
    __syncthreads();
}

__global__ void __launch_bounds__(NTHREADS) fwd_megakernel(Params p) {
    extern __shared__ __attribute__((aligned(16))) unsigned char lds_raw[];
    float* lds = (float*)lds_raw;
    volatile LAS3 unsigned* misc = (volatile LAS3 unsigned*)((LAS3 unsigned char*)lds_raw + LDS_MISC);
    if (threadIdx.x < 2) misc[threadIdx.x] = 0u;
    __syncthreads();
    const XcdBarrier gbar = xcd_barrier_post((unsigned*)(p.ws + WS_CTL) + CW_BAR, misc);
#define GSYNC() xcd_barrier(gbar)
    LAS3 unsigned char* l3 = (LAS3 unsigned char*)lds_raw;
#define REPS(k) for (int rep_ = 0; rep_ < ((PROBE == (k)) ? 2 : 1); ++rep_)
    REPS(1) { phase_mod(p, lds); phase_cvt(p, lds); GSYNC(); }
    REPS(2) { phase_rowproj<0>(p, lds_raw); GSYNC(); }
    REPS(3) { phase_inproj_m(p, l3); GSYNC(); }
    REPS(4) { phase_dnprep(p); GSYNC(); }
    REPS(5) { phase_dnchunk(p, lds_raw); GSYNC(); }
    REPS(6) {
        const int nscan = NB * DH;
        if (gridDim.x >= 2 * nscan) {
            if (blockIdx.x < nscan) phase_scan_mfma(p, lds_raw, blockIdx.x);
            else phase_attn_mfma(p, lds_raw, blockIdx.x - nscan, gridDim.x - nscan);
        } else {
            for (int bh = blockIdx.x; bh < nscan; bh += gridDim.x) phase_scan_mfma(p, lds_raw, bh);
            phase_attn_mfma(p, lds_raw, blockIdx.x, gridDim.x);
        }
        GSYNC();
    }
    REPS(7) { phase_dnout(p); GSYNC(); }
    REPS(8) { phase_outproj_m(p, l3); GSYNC(); }
    REPS(9) {
        if (rep_) { if (blockIdx.x == 0 && threadIdx.x < 64) ((int*)(p.ws + WS_CTL))[threadIdx.x] = 0; GSYNC(); }
        phase_rowproj<1>(p, lds_raw); GSYNC();
    }
    REPS(10) { phase_moe1_m(p, l3); GSYNC(); }
    REPS(11) { phase_moe2_m(p, l3); GSYNC(); }
    REPS(12) { phase_final(p, lds); if (PROBE == 12) GSYNC(); }
}

extern "C" void kernel_launch(void* const* d_in, const int* in_sizes, int n_in, void* d_out, int out_size, void* d_ws, size_t ws_size, hipStream_t stream) {
    static int grid_blocks = 0;
    if (grid_blocks == 0) {
        if (n_in != 19 || out_size != T * D || ws_size < WS_END) { fprintf(stderr, "kernel_launch: unexpected shapes (n_in %d out %d ws %zu)\n", n_in, out_size, ws_size); grid_blocks = -1; return; }
        int dev = 0, cus = 0, per_cu = 0;
        hipGetDevice(&dev);
        hipDeviceGetAttribute(&cus, hipDeviceAttributeMultiprocessorCount, dev);
        hipFuncSetAttribute((const void*)fwd_megakernel, hipFuncAttributeMaxDynamicSharedMemorySize, LDS_BYTES);
        hipOccupancyMaxActiveBlocksPerMultiprocessor(&per_cu, (const void*)fwd_megakernel, NTHREADS, LDS_BYTES);
        if (per_cu < 1) { fprintf(stderr, "kernel_launch: occupancy query says %d blocks/CU\n", per_cu); grid_blocks = -1; return; }
        grid_blocks = cus;
    }
    if (grid_blocks < 0) return;
    Params p{};
    for (int i = 0; i < 19; ++i) p.in[i] = (const float*)d_in[i];
    p.out = (float*)d_out; p.ws = (unsigned char*)d_ws;
    if (hipMemsetAsync((char*)d_ws + WS_CTL, 0, CTL_ZERO_BYTES, stream) != hipSuccess) { fprintf(stderr, "kernel_launch: memset failed\n"); return; }
    hipLaunchKernelGGL(fwd_megakernel, dim3(grid_blocks), dim3(NTHREADS), LDS_BYTES, stream, p);
    const hipError_t e = hipPeekAtLastError();
    if (e != hipSuccess) fprintf(stderr, "launch failed: %s (grid %d)\n", hipGetErrorString(e), grid_blocks);
}
```

```cpp
#define PROBE 0
#include <hip/hip_runtime.h>
#include <hip/hip_cooperative_groups.h>
#include <cstdio>
#include <cstdint>
namespace cg = cooperative_groups;

typedef _Float16 h16;
typedef _Float16 h16x2 __attribute__((ext_vector_type(2)));
typedef _Float16 h16x4 __attribute__((ext_vector_type(4)));
typedef _Float16 h16x8 __attribute__((ext_vector_type(8)));
typedef float f32x4 __attribute__((ext_vector_type(4)));
typedef float f32x2 __attribute__((ext_vector_type(2)));
typedef float f32x16 __attribute__((ext_vector_type(16)));
typedef unsigned u32x4 __attribute__((ext_vector_type(4)));
typedef unsigned u32x2_t __attribute__((ext_vector_type(2)));

constexpr int D = 1024, NB = 4, SEQ = 8192, T = NB * SEQ;
constexpr int AH = 8, AHD = 64, AW = 512;
constexpr int DH = 4, DKD = 128, DW = 512, DCONV = 1536;
constexpr int INC = 3592, INC_MAIN = 3584;
constexpr int NE = 32, TOPK = 4, FE = 1024;
constexpr int NASG = T * TOPK;
constexpr float EPS = 1e-6f;
constexpr int NTHREADS = 512, NWAVES = 8;

constexpr size_t MiB = (size_t)1 << 20;
constexpr size_t WS_CTL = 0;
constexpr int CW_BAR = 4096; constexpr size_t CTL_ZERO_BYTES = 65536;
constexpr size_t WS_MOD = 1 * MiB;
constexpr size_t WS_BA = 2 * MiB;
constexpr size_t WS_G = 3 * MiB;
constexpr size_t WS_ASG_E = 4 * MiB;
constexpr size_t WS_ASG_P = 4 * MiB + 512 * 1024;
constexpr size_t WS_ASG_G = 5 * MiB;
constexpr size_t WS_TOK = 6 * MiB;
constexpr size_t WS_WIN16 = 16 * MiB;
constexpr size_t WS_WOUT16 = 24 * MiB;
constexpr size_t WS_W116 = 32 * MiB;
constexpr size_t WS_W216 = 160 * MiB;
constexpr size_t WS_H16 = 224 * MiB;
constexpr size_t WS_X1 = 288 * MiB;
constexpr size_t WS_R = 416 * MiB;
constexpr size_t WS_Q16 = WS_R;
constexpr size_t WS_K16 = WS_R + 32 * MiB;
constexpr size_t WS_V16 = WS_R + 64 * MiB;
constexpr size_t WS_DQKV = WS_R + 96 * MiB;
constexpr size_t WS_Z16 = WS_R + 192 * MiB;
constexpr size_t WS_QN = WS_R + 224 * MiB;
constexpr size_t WS_KN = WS_R + 256 * MiB;
constexpr size_t WS_VV = WS_R + 288 * MiB;
constexpr size_t WS_O32 = WS_R + 320 * MiB;
constexpr size_t WS_MIX = WS_R + 384 * MiB;
constexpr size_t WS_ACT = WS_R;
constexpr size_t WS_Y16 = WS_R + 272 * MiB;
constexpr size_t WS_AO = WS_DQKV;
constexpr size_t WS_LSE = WS_QN;
constexpr size_t WS_DNREC = WS_R + 448 * MiB;
constexpr size_t WS_END = WS_R + 592 * MiB;

constexpr int LDS_STAGE = 131072, LDS_TAB = LDS_STAGE, LDS_GTAB = LDS_STAGE + 1024, GTAB_UNITS = 18;
constexpr int LDS_MISC = LDS_GTAB + GTAB_UNITS * 256 * 4;
constexpr int LDS_BYTES = LDS_MISC + 256;
struct Params { const float* in[19]; float* out; unsigned char* ws; };

__device__ __forceinline__ float wave_sum(float v) {
#pragma unroll
    for (int o = 1; o < 64; o <<= 1) v += __shfl_xor(v, o);
    return v;
}
__device__ __forceinline__ float wave_max(float v) {
#pragma unroll
    for (int o = 1; o < 64; o <<= 1) v = fmaxf(v, __shfl_xor(v, o));
    return v;
}
__device__ __forceinline__ int otid() { int t = threadIdx.x; asm volatile("" : "+v"(t)); return t; }
__device__ __forceinline__ unsigned pk_bf16(float lo, float hi) { unsigned r; asm("v_cvt_pk_bf16_f32 %0, %1, %2" : "=v"(r) : "v"(lo), "v"(hi)); return r; }
__device__ __forceinline__ float silu_f(float v) { return v * __builtin_amdgcn_rcpf(1.f + __expf(-v)); }
__device__ __forceinline__ float sigmoid_f(float v) { return __builtin_amdgcn_rcpf(1.f + __expf(-v)); }


namespace pg8 {
#define PG8_LAS __attribute__((address_space(3)))
constexpr int BM = 256, BK = 64, HALF = 128, HTB = HALF * BK * 2, STAGE_BYTES = 8 * HTB, NXCD = 8, WGM = 4;
__device__ __forceinline__ int lds_byte(int r, int c) { const int st = (r >> 4) * 2 + (c >> 5), rr = r & 15, cc = c & 31, ob = rr * 64 + cc * 2; return st * 1024 + (ob ^ (((ob >> 9) & 1) << 5)); }
__device__ __forceinline__ void stage_rc(int b, int& R, int& C) { const int st = b / 1024, sb = b % 1024, swz = sb ^ (((sb >> 9) & 1) << 5); R = (st >> 1) * 16 + swz / 64; C = (st & 1) * 32 + (swz % 64) / 2; }
__device__ __forceinline__ int perm32(int rho) { const int n = rho >> 4, i = rho & 15; return 8 * (i >> 2) + 4 * n + (i & 3); }

struct Unit { int pm, pn, e; };
struct Gemm { const h16* A; const h16* Bt; int N, K; };

struct Order {
    int nM, nN, nwg, G, c; PG8_LAS const int* tstart;
    __device__ __forceinline__ void init(int nM_, int nN_, int G_, int c_, PG8_LAS const int* ts) { nM = nM_; nN = nN_; nwg = nM * nN; G = G_; c = c_; tstart = ts; }
    __device__ __forceinline__ bool next(int i, Unit& u) const {
        const long L = (long)i * G + c; if (L >= nwg) return false;
        int wgid = (int)L; { const int q = nwg / NXCD, r = nwg % NXCD, xcd = wgid % NXCD, off = wgid / NXCD; wgid = (xcd < r ? xcd * (q + 1) : r * (q + 1) + (xcd - r) * q) + off; }
        const int nig = WGM * nN, gid = wgid / nig, fm = gid * WGM, gsz = (nM - fm) < WGM ? (nM - fm) : WGM;
        u.pm = fm + ((wgid % nig) % gsz); u.pn = (wgid % nig) / gsz;
        int e = 0;
        if (tstart) { for (int q = 1; q < 32; ++q) if (tstart[q] <= u.pm) e = q; }
        u.e = e; return true;
    }
};

typedef __bf16 bf16x8_t __attribute__((ext_vector_type(8)));
typedef long l64x2_t __attribute__((ext_vector_type(2)));
typedef int v8i32 __attribute__((ext_vector_type(8)));
typedef int v4i32 __attribute__((ext_vector_type(4)));
#define PG8_CAT8(a, b) __builtin_shufflevector(__builtin_bit_cast(v4i32, a), __builtin_bit_cast(v4i32, b), 0, 1, 2, 3, 4, 5, 6, 7)
template <class Epi, bool GATHER, int EM = 0>
__device__ __forceinline__ void gemm_phase(PG8_LAS unsigned char* lds, const Gemm g, const Order& S, const Epi& E, PG8_LAS const int* gtab) {
    const int tid = otid(), wid = __builtin_amdgcn_readfirstlane(tid >> 6), lane = tid & 63, wr = wid >> 2, wc = wid & 3, fr = lane & 15, fq = lane >> 4;
    constexpr bool BF16 = (EM == 1); constexpr int ES = (EM >= 2) ? 1 : 2;
    const int K = g.K, nt = (K * ES) / (BK * 2);
    unsigned voffB[2]; int RA[2]; unsigned CA2[2];
#pragma unroll
    for (int i = 0; i < 2; ++i) { int R, C; stage_rc(tid * 16 + i * 8192, R, C); const int Rb = Epi::PERM ? ((R & ~31) + perm32(R & 31)) : R;
        RA[i] = R; CA2[i] = (unsigned)C * 2u; voffB[i] = (unsigned)(Rb * K) * (unsigned)ES + (unsigned)C * 2u; }
    const size_t kstep = (size_t)(BK * 2);
    const size_t hstep = (size_t)HALF * K * ES;
    const size_t tstep = 2 * hstep;
    const unsigned ldsw = (unsigned)wid * 1024u;
    const int aoff = lds_byte(wr * 64 + fr, fq * 8), boff = lds_byte(wc * 32 + fr, fq * 8);
#define PG8_SA(b, h) (((b) * 2 + (h)) * HTB)
#define PG8_SB(b, h) ((4 + (b) * 2 + (h)) * HTB)
#define PG8_STAGE(bufoff, gbase, voff) do { _Pragma("unroll") for (int _i = 0; _i < 2; ++_i) \
        __builtin_amdgcn_global_load_lds((const unsigned*)((const char*)(gbase) + (voff)[_i]), (PG8_LAS unsigned*)(lds + (bufoff) + ldsw + _i * 8192), 16, 0, 0); } while (0)
#define PG8_LDA(dst, b, h) do { _Pragma("unroll") for (int m = 0; m < 4; ++m) _Pragma("unroll") for (int k = 0; k < 2; ++k) dst[m][k] = *(const PG8_LAS h16x8*)(lds + PG8_SA(b, h) + aoff + m * 2048 + k * 1024); } while (0)
#define PG8_LDB(dst, b, h) do { _Pragma("unroll") for (int n = 0; n < 2; ++n) _Pragma("unroll") for (int k = 0; k < 2; ++k) dst[n][k] = *(const PG8_LAS h16x8*)(lds + PG8_SB(b, h) + boff + n * 2048 + k * 1024); } while (0)
#define PG8_MMA(ai, bj, At, Bt) do { __builtin_amdgcn_s_setprio(1); _Pragma("unroll") for (int m = 0; m < 4; ++m) _Pragma("unroll") for (int n = 0; n < 2; ++n) { if constexpr (EM == 3) { \
        { const v8i32 a8_ = PG8_CAT8(Bt[n][0], Bt[n][1]), b8_ = PG8_CAT8(At[m][0], At[m][1]); asm volatile("v_mfma_scale_f32_16x16x128_f8f6f4 %0, %1, %2, %0, %3, %3 op_sel_hi:[0,0,0]" : "+v"(acc[ai][bj][m][n]) : "v"(a8_), "v"(b8_), "v"(sc1)); } } else \
        _Pragma("unroll") for (int k = 0; k < 2; ++k) \
        { if constexpr (EM == 2) { const l64x2_t a_ = __builtin_bit_cast(l64x2_t, Bt[n][k]), b_ = __builtin_bit_cast(l64x2_t, At[m][k]); \
              acc[ai][bj][m][n] = __builtin_amdgcn_mfma_f32_16x16x32_fp8_fp8(a_[0], b_[0], acc[ai][bj][m][n], 0, 0, 0); acc[ai][bj][m][n] = __builtin_amdgcn_mfma_f32_16x16x32_fp8_fp8(a_[1], b_[1], acc[ai][bj][m][n], 0, 0, 0); } \
          else if constexpr (BF16) acc[ai][bj][m][n] = __builtin_amdgcn_mfma_f32_16x16x32_bf16(__builtin_bit_cast(bf16x8_t, Bt[n][k]), __builtin_bit_cast(bf16x8_t, At[m][k]), acc[ai][bj][m][n], 0, 0, 0); \
          else acc[ai][bj][m][n] = __builtin_amdgcn_mfma_f32_16x16x32_f16(Bt[n][k], At[m][k], acc[ai][bj][m][n], 0, 0, 0); } } __builtin_amdgcn_s_setprio(0); } while (0)
#define PG8_WAIT_V(n) asm volatile("s_waitcnt vmcnt(" #n ")" ::: "memory")
#define PG8_WAIT_L(n) asm volatile("s_waitcnt lgkmcnt(" #n ")" ::: "memory")
#define PG8_BAR __builtin_amdgcn_s_barrier()
#define PG8_SCHED __builtin_amdgcn_sched_barrier(0)
#define PG8_AOFF(o, u, uix) do { _Pragma("unroll") for (int _h = 0; _h < 2; ++_h) _Pragma("unroll") for (int _i = 0; _i < 2; ++_i) { \
        const int _r = _h * HALF + RA[_i]; const unsigned _src = GATHER ? (unsigned)gtab[(uix) * BM + _r] : (unsigned)((u).pm * BM + _r); \
        o[_h][_i] = _src * (unsigned)(K * ES) + CA2[_i]; } } while (0)
    Unit cur, nxt; int ui = 0;
    if (!S.next(0, cur)) return;
    int sc1 = 0x7F7F7F7F; asm volatile("" : "+v"(sc1));
    f32x4 acc[2][2][4][2];
#pragma unroll
    for (int a = 0; a < 2; ++a)
#pragma unroll
        for (int b = 0; b < 2; ++b)
#pragma unroll
            for (int m = 0; m < 4; ++m)
#pragma unroll
                for (int n = 0; n < 2; ++n) acc[a][b][m][n] = (f32x4){0.f, 0.f, 0.f, 0.f};
    h16x8 At[4][2], B0[2][2], B1[2][2];
    unsigned oc[2][2], on[2][2];
    PG8_AOFF(oc, cur, 0);
    const char* const A0 = (const char*)g.A;
    const char* cB = (const char*)g.Bt + ((size_t)cur.e * g.N + (size_t)cur.pn * BM) * K * ES;
    PG8_STAGE(PG8_SB(0, 0), cB, voffB); PG8_STAGE(PG8_SB(0, 1), cB + hstep, voffB); PG8_STAGE(PG8_SA(0, 0), A0, oc[0]); PG8_STAGE(PG8_SA(0, 1), A0, oc[1]);
    if (wr == 1) PG8_BAR;
    PG8_WAIT_V(2); PG8_BAR;
    PG8_STAGE(PG8_SB(1, 0), cB + kstep, voffB); PG8_STAGE(PG8_SA(1, 0), A0 + kstep, oc[0]); PG8_STAGE(PG8_SB(1, 1), cB + hstep + kstep, voffB);
    PG8_WAIT_V(6); PG8_BAR;
    for (;;) {
        const bool has_next = S.next(ui + 1, nxt);
        const char* nB = cB;
        if (has_next) { nB = (const char*)g.Bt + ((size_t)nxt.e * g.N + (size_t)nxt.pn * BM) * K * ES; PG8_AOFF(on, nxt, ui + 1); }
        else {
#pragma unroll
            for (int h = 0; h < 2; ++h)
#pragma unroll
                for (int i = 0; i < 2; ++i) on[h][i] = oc[h][i];
        }
#pragma unroll 1
        for (int t = 0; t < nt; t += 2) {
            const bool last = (t == nt - 2);
            const char* a1 = A0 + (size_t)(t + 1) * kstep;
            const char* a2 = last ? A0 : A0 + (size_t)(t + 2) * kstep; const char* b2 = last ? nB : cB + (size_t)(t + 2) * kstep;
            const char* a3 = a2 + kstep; const char* b3 = b2 + kstep;
            unsigned o2[2][2];
#pragma unroll
            for (int h = 0; h < 2; ++h)
#pragma unroll
                for (int i = 0; i < 2; ++i) o2[h][i] = last ? on[h][i] : oc[h][i];
            PG8_LDB(B0, 0, 0); PG8_LDB(B1, 0, 1); PG8_SCHED; PG8_LDA(At, 0, 0); PG8_STAGE(PG8_SA(1, 1), a1, oc[1]);
            PG8_WAIT_V(8); PG8_WAIT_L(0); PG8_BAR; PG8_MMA(0, 0, At, B0); PG8_MMA(0, 1, At, B1); PG8_BAR; PG8_SCHED;
            PG8_LDA(At, 0, 1); PG8_STAGE(PG8_SB(0, 0), b2, voffB); PG8_STAGE(PG8_SB(0, 1), b2 + hstep, voffB); PG8_STAGE(PG8_SA(0, 0), a2, o2[0]);
            PG8_WAIT_V(8); PG8_WAIT_L(0); PG8_BAR; PG8_MMA(1, 0, At, B0); PG8_MMA(1, 1, At, B1); PG8_BAR; PG8_SCHED;
            PG8_LDB(B0, 1, 0); PG8_LDB(B1, 1, 1); PG8_SCHED; PG8_LDA(At, 1, 0); PG8_STAGE(PG8_SA(0, 1), a2, o2[1]);
            PG8_WAIT_V(8); PG8_WAIT_L(0); PG8_BAR; PG8_MMA(0, 0, At, B0); PG8_MMA(0, 1, At, B1); PG8_BAR; PG8_SCHED;
            PG8_LDA(At, 1, 1); PG8_STAGE(PG8_SB(1, 0), b3, voffB); PG8_STAGE(PG8_SB(1, 1), b3 + hstep, voffB); PG8_STAGE(PG8_SA(1, 0), a3, o2[0]);
            PG8_WAIT_V(8); PG8_WAIT_L(0); PG8_BAR; PG8_MMA(1, 0, At, B0); PG8_MMA(1, 1, At, B1); PG8_BAR; PG8_SCHED;
        }
        if (wr == 0) PG8_BAR;
        if constexpr (EM == 3) asm volatile("s_nop 15\n\ts_nop 15" ::: "memory");
        E(acc, cur, wr, wc, fr, fq);
        if (!has_next) break;
#pragma unroll
        for (int a = 0; a < 2; ++a)
#pragma unroll
            for (int b = 0; b < 2; ++b)
#pragma unroll
                for (int m = 0; m < 4; ++m)
#pragma unroll
                    for (int n = 0; n < 2; ++n) acc[a][b][m][n] = (f32x4){0.f, 0.f, 0.f, 0.f};
        cur = nxt; cB = nB; ++ui;
#pragma unroll
        for (int h = 0; h < 2; ++h)
#pragma unroll
            for (int i = 0; i < 2; ++i) oc[h][i] = on[h][i];
        if (wr == 1) PG8_BAR;
    }
    PG8_WAIT_V(0);
    PG8_BAR;
#undef PG8_SA
#undef PG8_SB
#undef PG8_STAGE
#undef PG8_LDA
#undef PG8_LDB
#undef PG8_MMA
#undef PG8_WAIT_V
#undef PG8_WAIT_L
#undef PG8_BAR
#undef PG8_SCHED
#undef PG8_AOFF
}
}

__device__ __forceinline__ void phase_mod(const Params& p, float* lds) {
    const float* c = p.in[1]; const float* w = p.in[2]; const float* bias = p.in[3];
    float* mod = (float*)(p.ws + WS_MOD);
    const int tid = otid();
    for (int i = tid; i < 4096; i += NTHREADS) lds[i] = silu_f(c[i]);
    __syncthreads();
    float* red = lds + 4096;
    for (int cb = blockIdx.x; cb < 192; cb += gridDim.x) {
        const int cc = tid & 31, col = cb * 32 + cc, ks = tid >> 5;
        float a0 = 0.f, a1 = 0.f, a2 = 0.f, a3 = 0.f;
#pragma unroll 16
        for (int k = ks * 64; k < ks * 64 + 64; ++k) {
            const float wv = w[(size_t)k * 6144 + col];
            a0 += lds[k] * wv; a1 += lds[1024 + k] * wv; a2 += lds[2048 + k] * wv; a3 += lds[3072 + k] * wv;
        }
        red[(ks * 4 + 0) * 32 + cc] = a0; red[(ks * 4 + 1) * 32 + cc] = a1; red[(ks * 4 + 2) * 32 + cc] = a2; red[(ks * 4 + 3) * 32 + cc] = a3;
        __syncthreads();
        if (tid < 128) {
            const int b = tid >> 5; float s = 0.f;
            for (int q = 0; q < 16; ++q) s += red[(q * 4 + b) * 32 + cc];
            mod[b * 6144 + col] = s + bias[col];
        }
        __syncthreads();
    }
    if (blockIdx.x == 0 && tid < 64) ((int*)(p.ws + WS_CTL))[tid] = 0;
}

constexpr int DN_REC = 73728, DN_NW = 0, DN_QD = 16384, DN_KD = 32768, DN_IN = 49152, DN_U = 57344, DN_GL = 51200;
template <int NS, int PLO, int PHI>
__device__ __forceinline__ void dn_conv_rows(const h16* dqkv, const float* cw, size_t t0, int n, int hd, int r, int c8, h16* QS, h16* KS, h16* VS) {
#pragma unroll 1
    for (int part = PLO; part < PHI; ++part) {
        h16x8 xr[NS][4][2];
#pragma unroll
        for (int q = 0; q < NS; ++q)
#pragma unroll
            for (int j = 0; j < 4; ++j) {
                const int rr = r + 32 * q; const bool ok = (n * 64 + rr - 3 + j >= 0);
                const h16* rowp = dqkv + (t0 + rr - (ok ? 3 - j : 0)) * DCONV + part * 512 + hd * 128 + c8 * 16;
                const h16x8 x0 = *(const h16x8*)rowp, x1 = *(const h16x8*)(rowp + 8);
#pragma unroll
                for (int i = 0; i < 8; ++i) { xr[q][j][0][i] = ok ? x0[i] : (h16)0.f; xr[q][j][1][i] = ok ? x1[i] : (h16)0.f; }
            }
#pragma unroll
        for (int q = 0; q < NS; ++q) {
            float acc[16];
#pragma unroll
            for (int i = 0; i < 16; ++i) acc[i] = 0.f;
#pragma unroll
            for (int j = 0; j < 4; ++j) {
                const float* wp = cw + hd * 1536 + j * 384 + part * 128 + c8 * 16;
#pragma unroll
                for (int i4 = 0; i4 < 2; ++i4) { const f32x4 wa = *(const f32x4*)(wp + 4 * i4), wb = *(const f32x4*)(wp + 8 + 4 * i4);
#pragma unroll
                    for (int i = 0; i < 4; ++i) { acc[4 * i4 + i] += (float)xr[q][j][0][4 * i4 + i] * wa[i]; acc[8 + 4 * i4 + i] += (float)xr[q][j][1][4 * i4 + i] * wb[i]; } }
            }
            float ssq = 0.f;
#pragma unroll
            for (int i = 0; i < 16; ++i) { acc[i] = silu_f(acc[i]); ssq += acc[i] * acc[i]; }
            float sc = 1.f;
            if (part < 2) { ssq += __shfl_xor(ssq, 1); ssq += __shfl_xor(ssq, 2); ssq += __shfl_xor(ssq, 4); sc = rsqrtf(ssq + EPS) * (part == 0 ? 0.08838834764831845f : 1.f); }
            h16x8 o0, o1;
#pragma unroll
            for (int i = 0; i < 8; ++i) { o0[i] = (h16)(acc[i] * sc); o1[i] = (h16)(acc[8 + i] * sc); }
            h16* dst = (part == 0 ? QS : (part == 1 ? KS : VS)) + (r + 32 * q) * 136 + c8 * 16;
            *(h16x8*)dst = o0; *(h16x8*)(dst + 8) = o1;
        }
    }
}
__device__ __forceinline__ void dn_gates(const float* ba, const float* A_log, const float* dt_bias, size_t t0, int hd, int lane, float* GC, float* EG, float* BT) {
    const float dbv = ba[(t0 + lane) * 8 + hd], dav = ba[(t0 + lane) * 8 + 4 + hd];
    const float xsp = dav + dt_bias[hd];
    const float sp = (xsp > 20.f) ? xsp : log1pf(__expf(xsp));
    float x = -__expf(A_log[hd]) * sp;
#pragma unroll
    for (int o = 1; o < 64; o <<= 1) { const float y = __shfl_up(x, o); if (lane >= o) x += y; }
    GC[lane] = x; EG[lane] = __expf(x); BT[lane] = sigmoid_f(dbv);
    GC[192 + lane] = __expf(__shfl(x, 63) - x);
}
__device__ __forceinline__ void phase_dnchunk2(const Params& p, unsigned char* lds) {
    const h16* dqkv = (const h16*)(p.ws + WS_DQKV); const float* ba = (const float*)(p.ws + WS_BA);
    const float* A_log = p.in[7]; const float* dt_bias = p.in[8];
    h16* QS = (h16*)lds; h16* KS = (h16*)(lds + 17408); h16* VS = (h16*)(lds + 34816);
    float* KKA = (float*)(lds + 52224); float* QKA = (float*)(lds + 69632);
    h16* UL = (h16*)(lds + 87040); h16* WL = (h16*)(lds + 104448);
    float* GC = (float*)(lds + 121856); float* BT = GC + 64; float* EG = GC + 128;
    const int tid0 = otid(), wave = __builtin_amdgcn_readfirstlane(tid0 >> 6);
    constexpr int NITEM = NB * DH * (SEQ / 64);
    float* CWS = (float*)(lds + 122880);
    { const float* cwg = p.in[6];
      for (int i = tid0; i < 4 * 1536; i += NTHREADS) { const int hq = i / 1536, q = i % 1536, j = q / 384, c = q % 384; CWS[i] = cwg[j * DCONV + (c >> 7) * 512 + hq * 128 + (c & 127)]; }
      __syncthreads(); }
    const float* cw = CWS;
    if ((int)blockIdx.x < NITEM) {
        const int item = blockIdx.x, bh = item >> 7, n = item & 127; const size_t t0 = (size_t)(bh >> 2) * SEQ + n * 64;
        dn_conv_rows<1, 0, 3>(dqkv, cw, t0, n, bh & 3, tid0 >> 3, tid0 & 7, QS, KS, VS);
        if (wave == 0) dn_gates(ba, A_log, dt_bias, t0, bh & 3, tid0 & 63, GC, EG, BT);
    }
    __syncthreads();
    for (int item = blockIdx.x; item < NITEM; item += gridDim.x) {
        int tid = tid0; asm volatile("" : "+v"(tid));
        const int lane = tid & 63;
        unsigned char* rec = p.ws + WS_DNREC + (size_t)item * DN_REC;
        if (wave < 6) {
            const int kind = wave / 3, tl = wave - 3 * kind, I = (tl >= 1) ? 1 : 0, J = (tl == 2) ? 1 : 0, r32 = lane & 31, hh = lane >> 5;
            const h16* Ar = (kind == 0 ? KS : QS) + (32 * I + r32) * 136 + 8 * hh; const h16* Br = KS + (32 * J + r32) * 136 + 8 * hh;
            f32x16 acc;
#pragma unroll
            for (int i = 0; i < 16; ++i) acc[i] = 0.f;
#pragma unroll
            for (int s8 = 0; s8 < 8; ++s8) acc = __builtin_amdgcn_mfma_f32_32x32x16_f16(*(const h16x8*)(Ar + 16 * s8), *(const h16x8*)(Br + 16 * s8), acc, 0, 0, 0);
            const int j = 32 * J + r32; const float gj = GC[j];
            if (kind == 0) {
#pragma unroll
                for (int g4 = 0; g4 < 4; ++g4) {
                    f32x4 o;
#pragma unroll
                    for (int q = 0; q < 4; ++q) { const int i = 32 * I + 8 * g4 + 4 * hh + q; o[q] = (j < i) ? acc[4 * g4 + q] * __expf(GC[i] - gj) * BT[i] : 0.f; }
                    *(f32x4*)(KKA + j * 68 + 32 * I + 8 * g4 + 4 * hh) = o;
                }
            } else {
#pragma unroll
                for (int reg = 0; reg < 16; ++reg) {
                    const int i = 32 * I + (reg & 3) + 8 * (reg >> 2) + 4 * hh;
                    QKA[i * 68 + j] = (j <= i) ? acc[reg] * __expf(GC[i] - gj) : 0.f;
                }
            }
        } else if (wave == 6) {
            for (int idx = lane; idx < 1024; idx += 64) KKA[(32 + (idx >> 5)) * 68 + (idx & 31)] = 0.f;
        } else {
            for (int idx = lane; idx < 1024; idx += 64) QKA[(idx >> 5) * 68 + 32 + (idx & 31)] = 0.f;
        }
        __syncthreads();
        const float gclast = GC[63];
        for (int pc = tid; pc < 2560; pc += NTHREADS) {
            h16x8 o; int off;
            if (pc < 1024) {
                const int fs = pc >> 6, l = pc & 63, mt = fs >> 3, s8 = fs & 7, r = l & 31, hh = l >> 5, c = 32 * mt + r;
                const h16* sp = QS + c * 136 + 16 * s8 + 4 * hh;
                const h16x4 lo = *(const h16x4*)sp, hi = *(const h16x4*)(sp + 8);
                const float sc = EG[c];
#pragma unroll
                for (int j = 0; j < 4; ++j) { o[j] = (h16)((float)lo[j] * sc); o[4 + j] = (h16)((float)hi[j] * sc); }
                off = DN_QD + pc * 16;
            } else if (pc < 2048) {
                const int q = pc - 1024, fs = q >> 6, l = q & 63, kt = fs >> 2, s4 = fs & 3, r = l & 31, hh = l >> 5, dk = 32 * kt + r;
#pragma unroll
                for (int j = 0; j < 8; ++j) { const int c = 16 * s4 + 8 * (j >> 2) + 4 * hh + (j & 3); o[j] = (h16)((float)KS[c * 136 + dk] * GC[192 + c]); }
                off = DN_KD + q * 16;
            } else {
                const int q = pc - 2048, fs = q >> 6, l = q & 63, mt = fs >> 2, s4 = fs & 3, r = l & 31, hh = l >> 5, c = 32 * mt + r;
#pragma unroll
                for (int j = 0; j < 8; ++j) { const int c2 = 16 * s4 + 8 * (j >> 2) + 4 * hh + (j & 3); o[j] = (h16)QKA[c * 68 + c2]; }
                off = DN_IN + q * 16;
                if (fs == 2 && l == 0) { const unsigned gb = __float_as_uint(__expf(gclast)); const unsigned short lo16 = (unsigned short)(gb & 0xffffu), hi16 = (unsigned short)(gb >> 16);
                    o[0] = __builtin_bit_cast(h16, lo16); o[1] = __builtin_bit_cast(h16, hi16); }
            }
            *(h16x8*)(rec + off) = o;
        }
        for (int idx = tid; idx < 4096; idx += NTHREADS) {
            const int i = idx >> 6, c4 = (idx & 63) * 4; const bool wpart = c4 >= 128; const int dd = c4 & 127;
            const h16x4 sv = *(const h16x4*)((wpart ? KS : VS) + i * 136 + dd);
            const float sc = wpart ? BT[i] * EG[i] : BT[i];
            h16x4 o; o[0] = (h16)((float)sv[0] * sc); o[1] = (h16)((float)sv[1] * sc); o[2] = (h16)((float)sv[2] * sc); o[3] = (h16)((float)sv[3] * sc);
            *(h16x4*)((wpart ? WL : UL) + i * 136 + dd) = o;
        }
        __syncthreads();
        if (wave < 2) {
            const int d = tid & 127;
            h16* dU = UL + d; h16* dW = WL + d;
            int zl = 0; asm volatile("" : "+v"(zl));
            const float* Ab = KKA + zl;
            f32x2 XU[32], XW[32];
#pragma unroll
            for (int m = 0; m < 32; ++m) { XU[m][0] = (float)dU[(2 * m) * 136]; XU[m][1] = (float)dU[(2 * m + 1) * 136]; XW[m][0] = (float)dW[(2 * m) * 136]; XW[m][1] = (float)dW[(2 * m + 1) * 136]; }
#pragma unroll
            for (int j = 0; j < 64; ++j) {
                const float xu = XU[j / 2][j & 1], xw = XW[j / 2][j & 1];
                dU[j * 136] = (h16)xu; dW[j * 136] = (h16)(-xw);
                const f32x2 xu2 = (f32x2){xu, xu}, xw2 = (f32x2){xw, xw};
#pragma unroll
                for (int i4 = ((j + 1) & ~3); i4 < 64; i4 += 4) {
                    const f32x4 av = *(const f32x4*)(Ab + j * 68 + i4);
                    const f32x2 a01 = (f32x2){av[0], av[1]}, a23 = (f32x2){av[2], av[3]};
                    XU[i4 / 2] -= a01 * xu2; XU[i4 / 2 + 1] -= a23 * xu2;
                    XW[i4 / 2] -= a01 * xw2; XW[i4 / 2 + 1] -= a23 * xw2;
                }
                if ((j & 7) == 7) asm volatile("" ::: "memory");
            }
        } else if (wave != 5 && item + (int)gridDim.x < NITEM) {
            const int nitem = item + gridDim.x, bh = nitem >> 7, n = nitem & 127; const size_t t0 = (size_t)(bh >> 2) * SEQ + n * 64;
            if (wave == 4) dn_gates(ba, A_log, dt_bias, t0, bh & 3, lane, GC, EG, BT);
            else { const int lt = (wave < 4) ? tid - 128 : tid - 256;
                   dn_conv_rows<2, 0, 3>(dqkv, cw, t0, n, bh & 3, lt >> 3, lt & 7, QS, KS, VS); }
        }
        __syncthreads();
        for (int pc = tid; pc < 2048; pc += NTHREADS) {
            h16x8 o; int off;
            if (pc < 1024) {
                const int fs = pc >> 6, l = pc & 63, mt = fs >> 3, s8 = fs & 7, r = l & 31, hh = l >> 5, c = 32 * mt + r;
                const h16* sp = WL + c * 136 + 16 * s8 + 4 * hh;
                const h16x4 lo = *(const h16x4*)sp, hi = *(const h16x4*)(sp + 8);
#pragma unroll
                for (int j = 0; j < 4; ++j) { o[j] = lo[j]; o[4 + j] = hi[j]; }
                off = DN_NW + pc * 16;
            } else {
                const int q = pc - 1024, half8 = q & 1, l = (q >> 1) & 63, ms = q >> 7, mt = ms >> 2, sl = ms & 3, col = l & 31, hh = l >> 5;
#pragma unroll
                for (int j = 0; j < 8; ++j) { const int i = 8 * half8 + j; const int c = 32 * mt + (i & 3) + 8 * (i >> 2) + 4 * hh; o[j] = UL[c * 136 + 32 * sl + col]; }
                off = DN_U + q * 16;
            }
            *(h16x8*)(rec + off) = o;
        }
    }
}

__device__ __forceinline__ void cvt_frags(const f32x16& a, h16x8& f0, h16x8& f1) {
#pragma unroll
    for (int j = 0; j < 8; ++j) { f0[j] = (h16)a[j]; f1[j] = (h16)a[8 + j]; }
}
__device__ __forceinline__ void phase_scan_mfma(const Params& p, unsigned char* lds, int bh, int half) {
    const int tid = otid(), lane = tid & 63, wave = __builtin_amdgcn_readfirstlane(tid >> 6);
    const unsigned char* recs = p.ws + WS_DNREC + (size_t)bh * 128 * DN_REC;
    constexpr int NCH = SEQ / 64;
    if (wave >= 2) {
        const int lt = tid - 128;
        u32x4 R0[12], R1[12], R2[12];
#define DN_LOAD(R, n) do { const u32x4* s_ = (const u32x4*)(recs + (size_t)(n) * DN_REC) + lt; _Pragma("unroll") for (int k = 0; k < 12; ++k) R[k] = s_[k * 384]; } while (0)
#define DN_WRITE(R, n) do { u32x4* d_ = (u32x4*)(lds + ((n) & 1) * DN_REC) + lt; _Pragma("unroll") for (int k = 0; k < 12; ++k) d_[k * 384] = R[k]; } while (0)
        DN_LOAD(R0, 0); DN_WRITE(R0, 0); DN_LOAD(R1, 1); DN_LOAD(R2, 2);
        __syncthreads();
        for (int n = 0; n < NCH - 2; n += 3) {
            DN_LOAD(R0, min(n + 3, NCH - 1)); DN_WRITE(R1, n + 1); __syncthreads();
            DN_LOAD(R1, min(n + 4, NCH - 1)); DN_WRITE(R2, n + 2); __syncthreads();
            DN_LOAD(R2, min(n + 5, NCH - 1)); DN_WRITE(R0, n + 3); __syncthreads();
        }
        DN_WRITE(R1, NCH - 1); __syncthreads();
        __syncthreads();
        static_assert((NCH - 2) % 3 == 0 && (NCH - 1) % 3 == 1, "loader schedule assumes NCH = 3k + 2");
#undef DN_LOAD
#undef DN_WRITE
    } else {
        const int sl = 2 * half + wave, hh = lane >> 5;
        h16x2* o16 = (h16x2*)(p.ws + WS_O32);
        f32x16 S[4];
        h16x8 S16[4][2];
#pragma unroll
        for (int kt = 0; kt < 4; ++kt) {
#pragma unroll
            for (int i = 0; i < 16; ++i) S[kt][i] = 0.f;
#pragma unroll
            for (int j = 0; j < 8; ++j) { S16[kt][0][j] = (h16)0.f; S16[kt][1][j] = (h16)0.f; }
        }
        (void)hh;
        __syncthreads();
#define SB() __builtin_amdgcn_sched_barrier(0)
#define LD4(F, o0, o1, o2, o3) do { F[0] = *(const h16x8*)(fb + (o0)); F[1] = *(const h16x8*)(fb + (o1)); F[2] = *(const h16x8*)(fb + (o2)); F[3] = *(const h16x8*)(fb + (o3)); } while (0)
#define LDSEQ(F, base) LD4(F, (base), (base) + 1024, (base) + 2048, (base) + 3072)
#define MM(ACC, A, B) ACC = __builtin_amdgcn_mfma_f32_32x32x16_f16(A, B, ACC, 0, 0, 0)
        unsigned long long tacc_ = 0ull;
        for (int n = 0; n < NCH; ++n) {
            unsigned long long ts0_ = 0ull; if (PROBE == 70) ts0_ = __builtin_amdgcn_s_memtime();
            const unsigned char* buf = lds + (n & 1) * DN_REC;
            const unsigned char* fb = buf + lane * 16;
            h16x8 F0[4], F1[4], F2[4];
            f32x16 VN[2], O[2];
            h16x8 VN16[2][2];
            LDSEQ(F0, DN_NW + 0 * 1024); LDSEQ(F1, DN_NW + 4 * 1024);
            const float gl = *(const float*)(buf + DN_GL);
            h16x8 ur[2][2];
#pragma unroll
            for (int mt = 0; mt < 2; ++mt) { const h16x8* up = (const h16x8*)(buf + DN_U + ((mt * 4 + sl) * 64 + lane) * 32); ur[mt][0] = up[0]; ur[mt][1] = up[1]; }
            const f32x16 Z16 = {0.f, 0.f, 0.f, 0.f, 0.f, 0.f, 0.f, 0.f, 0.f, 0.f, 0.f, 0.f, 0.f, 0.f, 0.f, 0.f};
            SB();
            LDSEQ(F2, DN_NW + 8 * 1024);
            VN[0] = __builtin_amdgcn_mfma_f32_32x32x16_f16(F0[0], S16[0][0], Z16, 0, 0, 0); MM(VN[0], F0[1], S16[0][1]); MM(VN[0], F0[2], S16[1][0]); MM(VN[0], F0[3], S16[1][1]);
            SB();
            LDSEQ(F0, DN_NW + 12 * 1024);
            MM(VN[0], F1[0], S16[2][0]); MM(VN[0], F1[1], S16[2][1]); MM(VN[0], F1[2], S16[3][0]); MM(VN[0], F1[3], S16[3][1]);
            SB();
            LDSEQ(F1, DN_QD + 0 * 1024);
            VN[1] = __builtin_amdgcn_mfma_f32_32x32x16_f16(F2[0], S16[0][0], Z16, 0, 0, 0); MM(VN[1], F2[1], S16[0][1]); MM(VN[1], F2[2], S16[1][0]); MM(VN[1], F2[3], S16[1][1]);
            SB();
            LDSEQ(F2, DN_QD + 4 * 1024);
            MM(VN[1], F0[0], S16[2][0]); MM(VN[1], F0[1], S16[2][1]); MM(VN[1], F0[2], S16[3][0]); MM(VN[1], F0[3], S16[3][1]);
            SB();
            LDSEQ(F0, DN_QD + 8 * 1024);
            O[0] = __builtin_amdgcn_mfma_f32_32x32x16_f16(F1[0], S16[0][0], Z16, 0, 0, 0); MM(O[0], F1[1], S16[0][1]); MM(O[0], F1[2], S16[1][0]); MM(O[0], F1[3], S16[1][1]);
#pragma unroll
            for (int i = 0; i < 16; ++i) { S[0][i] *= gl; S[1][i] *= gl; }
#pragma unroll
            for (int j = 0; j < 8; ++j) { VN[0][j] += (float)ur[0][0][j]; VN[0][8 + j] += (float)ur[0][1][j]; }
            SB();
            LDSEQ(F1, DN_QD + 12 * 1024);
            MM(O[0], F2[0], S16[2][0]); MM(O[0], F2[1], S16[2][1]); MM(O[0], F2[2], S16[3][0]); MM(O[0], F2[3], S16[3][1]);
#pragma unroll
            for (int i = 0; i < 16; ++i) { S[2][i] *= gl; S[3][i] *= gl; }
#pragma unroll
            for (int j = 0; j < 8; ++j) { VN[1][j] += (float)ur[1][0][j]; VN[1][8 + j] += (float)ur[1][1][j]; }
            SB();
            LD4(F2, DN_IN + 0 * 1024, DN_IN + 1 * 1024, DN_IN + 4 * 1024, DN_IN + 5 * 1024);
            O[1] = __builtin_amdgcn_mfma_f32_32x32x16_f16(F0[0], S16[0][0], Z16, 0, 0, 0); MM(O[1], F0[1], S16[0][1]); MM(O[1], F0[2], S16[1][0]); MM(O[1], F0[3], S16[1][1]);
            cvt_frags(VN[0], VN16[0][0], VN16[0][1]);
            SB();
            F0[0] = *(const h16x8*)(fb + DN_IN + 6 * 1024); F0[1] = *(const h16x8*)(fb + DN_IN + 7 * 1024);
            MM(O[1], F1[0], S16[2][0]); MM(O[1], F1[1], S16[2][1]); MM(O[1], F1[2], S16[3][0]); MM(O[1], F1[3], S16[3][1]);
            cvt_frags(VN[1], VN16[1][0], VN16[1][1]);
            SB();
            LDSEQ(F1, DN_KD + 0 * 1024);
            MM(O[0], F2[0], VN16[0][0]); MM(O[0], F2[1], VN16[0][1]); MM(O[1], F2[2], VN16[0][0]); MM(O[1], F2[3], VN16[0][1]);
            SB();
            LDSEQ(F2, DN_KD + 4 * 1024);
            MM(O[1], F0[0], VN16[1][0]); MM(O[1], F0[1], VN16[1][1]);
            SB();
            h16x2* ob = o16 + ((size_t)((bh * NCH + n) * 2) * 4 + sl) * 512 + lane;
            LDSEQ(F0, DN_KD + 8 * 1024);
            MM(S[0], F1[0], VN16[0][0]); MM(S[0], F1[1], VN16[0][1]); MM(S[0], F1[2], VN16[1][0]); MM(S[0], F1[3], VN16[1][1]);
#pragma unroll
            for (int i = 0; i < 8; ++i) { h16x2 t2; t2[0] = (h16)O[0][2 * i]; t2[1] = (h16)O[0][2 * i + 1]; ob[i * 64] = t2; }
            SB();
            LDSEQ(F1, DN_KD + 12 * 1024);
            MM(S[1], F2[0], VN16[0][0]); MM(S[1], F2[1], VN16[0][1]); MM(S[1], F2[2], VN16[1][0]); MM(S[1], F2[3], VN16[1][1]);
#pragma unroll
            for (int i = 0; i < 8; ++i) { h16x2 t2; t2[0] = (h16)O[1][2 * i]; t2[1] = (h16)O[1][2 * i + 1]; ob[2048 + i * 64] = t2; }
            SB();
            MM(S[2], F0[0], VN16[0][0]); MM(S[2], F0[1], VN16[0][1]); MM(S[2], F0[2], VN16[1][0]); MM(S[2], F0[3], VN16[1][1]);
            cvt_frags(S[0], S16[0][0], S16[0][1]);
            SB();
            MM(S[3], F1[0], VN16[0][0]); MM(S[3], F1[1], VN16[0][1]); MM(S[3], F1[2], VN16[1][0]); MM(S[3], F1[3], VN16[1][1]);
            cvt_frags(S[1], S16[1][0], S16[1][1]);
            SB();
            cvt_frags(S[2], S16[2][0], S16[2][1]); cvt_frags(S[3], S16[3][0], S16[3][1]);
            if (PROBE == 70) { asm volatile("s_nop 0" :: "v"(S16[3][1])); tacc_ += __builtin_amdgcn_s_memtime() - ts0_; }
            if (PROBE == 71) ts0_ = __builtin_amdgcn_s_memtime();
            __syncthreads();
            if (PROBE == 71) tacc_ += __builtin_amdgcn_s_memtime() - ts0_;
        }
        if ((PROBE == 70 || PROBE == 71) && bh == 0 && tid == 0) *(float*)(p.ws + WS_CTL + 32768) = 0.02f * floorf((float)tacc_ / (float)NCH / 250.f);
#undef SB
#undef LD4
#undef LDSEQ
#undef MM
    }
}

constexpr int AT_KS_STRIDE = 72, AT_VT_STRIDE = 388, AT_VT_OFF = 384 * AT_KS_STRIDE * 2;
struct AttnUnit { int g, b, hd, dil, r, m0; size_t rowbase; };
__device__ __forceinline__ AttnUnit attn_unit(int u) {
    AttnUnit a; a.g = u >> 10; const int rem = u & 1023, x = (rem >> 3) & 31; a.b = rem >> 8; a.hd = rem & 7;
    a.dil = (a.g == 0) ? 1 : ((a.g == 1) ? 4 : 16); a.r = x & (a.dil - 1); a.m0 = (x / a.dil) * 256; a.rowbase = (size_t)a.b * SEQ + a.r; return a;
}
__device__ __forceinline__ void phase_attn_mfma(const Params& p, unsigned char* lds, int vblock, int nvblocks) {
    const h16* q16 = (const h16*)(p.ws + WS_Q16); const h16* k16 = (const h16*)(p.ws + WS_K16); const h16* v16 = (const h16*)(p.ws + WS_V16);
    h16* ao = (h16*)(p.ws + WS_AO); float* lse = (float*)(p.ws + WS_LSE);
    h16* Ks = (h16*)lds; h16* Vt = (h16*)(lds + AT_VT_OFF);
    const int tid = otid(), lane = tid & 63, w = tid >> 6, ql = lane & 31, hh = lane >> 5;
    h16x8 kr[6], vr[6], qf[4];
#define AT_PREFETCH(U) do { const AttnUnit a_ = attn_unit(U); \
        _Pragma("unroll") for (int k_ = 0; k_ < 6; ++k_) { const int idx_ = tid + 512 * k_, pc_ = idx_ & 7, kk_ = idx_ >> 3, m_ = a_.m0 - 128 + kk_; \
            const size_t go_ = (a_.rowbase + (size_t)(m_ < 0 ? 0 : m_) * a_.dil) * AW + a_.hd * 64 + pc_ * 8; \
            kr[k_] = *(const h16x8*)(k16 + go_); vr[k_] = *(const h16x8*)(v16 + go_); } \
        const size_t qrow_ = a_.rowbase + (size_t)(a_.m0 + 32 * w + ql) * a_.dil; \
        _Pragma("unroll") for (int s_ = 0; s_ < 4; ++s_) qf[s_] = *(const h16x8*)(q16 + qrow_ * AW + a_.hd * 64 + 16 * s_ + 8 * hh); } while (0)
    float bnd0[16], bnd4[16];
#pragma unroll
    for (int i = 0; i < 16; ++i) { const int row = (i & 3) + 8 * (i >> 2) + 4 * hh; bnd0[i] = (row >= ql) ? INFINITY : -INFINITY; bnd4[i] = (row <= ql) ? INFINITY : -INFINITY; }
    int u = vblock;
    if (u < 3 * 1024) AT_PREFETCH(u);
    for (; u < 3 * 1024; u += nvblocks) {
        const AttnUnit au = attn_unit(u);
        const int m0 = au.m0;
        const size_t qrow = au.rowbase + (size_t)(m0 + 32 * w + ql) * au.dil;
        __syncthreads();
#pragma unroll
        for (int k = 0; k < 6; ++k) {
            const int idx = tid + 512 * k, pc = idx & 7, kk = idx >> 3;
            const h16x8 kv = kr[k], vv = vr[k];
            *(h16x8*)(Ks + kk * AT_KS_STRIDE + pc * 8) = kv;
#pragma unroll
            for (int j = 0; j < 8; ++j) Vt[(pc * 8 + j) * AT_VT_STRIDE + kk] = vv[j];
        }
        h16x8 qc[4];
#pragma unroll
        for (int s4 = 0; s4 < 4; ++s4) qc[s4] = qf[s4];
        __syncthreads();
        if (u + nvblocks < 3 * 1024) AT_PREFETCH(u + nvblocks);
        f32x16 St[5];
#pragma unroll
        for (int kt = 0; kt < 5; ++kt) {
#pragma unroll
            for (int i = 0; i < 16; ++i) St[kt][i] = 0.f;
#pragma unroll
            for (int s4 = 0; s4 < 4; ++s4) {
                const h16x8 a = *(const h16x8*)(Ks + (32 * (w + kt) + ql) * AT_KS_STRIDE + 16 * s4 + 8 * hh);
                St[kt] = __builtin_amdgcn_mfma_f32_32x32x16_f16(a, qc[s4], St[kt], 0, 0, 0);
            }
        }
#pragma unroll
        for (int i = 0; i < 16; ++i) { St[0][i] = fminf(St[0][i], bnd0[i]); St[4][i] = fminf(St[4][i], bnd4[i]); }
        if (m0 == 0) {
#pragma unroll
            for (int kt = 0; kt < 4; ++kt)
                if (w + kt < 4) {
#pragma unroll
                    for (int i = 0; i < 16; ++i) St[kt][i] = -INFINITY;
                }
        }
        float mx = -INFINITY;
#pragma unroll
        for (int kt = 0; kt < 5; ++kt)
#pragma unroll
            for (int i = 0; i < 16; ++i) mx = fmaxf(mx, St[kt][i]);
        mx = fmaxf(mx, __shfl_xor(mx, 32));
        float l = 0.f;
        {
            const float c2 = 0.125f * 1.4426950408889634f, mb = -mx * c2;
#pragma unroll
            for (int kt = 0; kt < 5; ++kt)
#pragma unroll
                for (int i = 0; i < 16; ++i) { St[kt][i] = __builtin_amdgcn_exp2f(__builtin_fmaf(St[kt][i], c2, mb)); l += St[kt][i]; }
        }
        l += __shfl_xor(l, 32);
        f32x16 Ot[2];
#pragma unroll
        for (int dt = 0; dt < 2; ++dt)
#pragma unroll
            for (int i = 0; i < 16; ++i) Ot[dt][i] = 0.f;
#pragma unroll
        for (int kt = 0; kt < 5; ++kt) {
            h16x8 pf[2];
            cvt_frags(St[kt], pf[0], pf[1]);
#pragma unroll
            for (int s2 = 0; s2 < 2; ++s2)
#pragma unroll
                for (int dt = 0; dt < 2; ++dt) {
                    const h16* vp = Vt + (32 * dt + ql) * AT_VT_STRIDE + 32 * (w + kt) + 16 * s2 + 4 * hh;
                    const h16x4 lo = *(const h16x4*)vp, hi = *(const h16x4*)(vp + 8);
                    h16x8 a;
#pragma unroll
                    for (int j = 0; j < 4; ++j) { a[j] = lo[j]; a[4 + j] = hi[j]; }
                    Ot[dt] = __builtin_amdgcn_mfma_f32_32x32x16_f16(a, pf[s2], Ot[dt], 0, 0, 0);
                }
        }
        const float inv = __builtin_amdgcn_rcpf(l);
        h16* orow = ao + ((size_t)au.g * T + qrow) * AW + au.hd * 64;
#pragma unroll
        for (int dt = 0; dt < 2; ++dt)
#pragma unroll
            for (int i4 = 0; i4 < 4; ++i4) {
                h16x4 o;
#pragma unroll
                for (int j = 0; j < 4; ++j) o[j] = (h16)(Ot[dt][4 * i4 + j] * inv);
                *(h16x4*)(orow + 32 * dt + 8 * i4 + 4 * hh) = o;
            }
        if (hh == 0) lse[((size_t)au.g * T + qrow) * 8 + au.hd] = 0.125f * mx + __logf(l);
    }
#undef AT_PREFETCH
}

__device__ __forceinline__ void phase_dnout(const Params& p) {
    const float* o32 = (const float*)(p.ws + WS_O32); const h16* z16 = (const h16*)(p.ws + WS_Z16); const float* nw = p.in[9];
    const h16* ao = (const h16*)(p.ws + WS_AO); const float* lse = (const float*)(p.ws + WS_LSE);
    h16* mix = (h16*)(p.ws + WS_MIX);
    const int tid_ = otid(); const int lane = tid_ & 63, wave = tid_ >> 6;
    const int gw = blockIdx.x * NWAVES + wave, NGW = gridDim.x * NWAVES;
    const f32x2 w2 = *(const f32x2*)(nw + 2 * lane);
    for (int row = gw; row < T; row += NGW) {
        const int ah = lane >> 3;
        const float l0 = lse[((size_t)0 * T + row) * 8 + ah], l1 = lse[((size_t)1 * T + row) * 8 + ah], l2 = lse[((size_t)2 * T + row) * 8 + ah];
        const h16x8 a0 = *(const h16x8*)(ao + ((size_t)0 * T + row) * AW + lane * 8), a1 = *(const h16x8*)(ao + ((size_t)1 * T + row) * AW + lane * 8),
                    a2 = *(const h16x8*)(ao + ((size_t)2 * T + row) * AW + lane * 8);
        const int bq = row / SEQ, tp = row % SEQ, nq = tp >> 6, cq = tp & 63, mtq = cq >> 5, cl = cq & 31, h2 = (cl >> 2) & 1, iq = (cl & 3) + 4 * (cl >> 3);
        f32x2 ov[4]; h16x2 zv[4];
#pragma unroll
        for (int hd = 0; hd < 4; ++hd) {
            { const h16x2* op = (const h16x2*)(p.ws + WS_O32) + ((size_t)(((bq * 4 + hd) * (SEQ / 64) + nq) * 2 + mtq) * 4 + (lane >> 4)) * 512 + (iq >> 1) * 64 + h2 * 32 + ((2 * lane) & 31);
              const h16x2 pa = op[0], pb = op[1]; ov[hd][0] = (float)pa[iq & 1]; ov[hd][1] = (float)pb[iq & 1]; }
            zv[hd] = *(const h16x2*)(z16 + (size_t)row * DW + hd * 128 + 2 * lane);
        }
        {
            const float m = fmaxf(l0, fmaxf(l1, l2));
            const float e0 = __expf(l0 - m), e1 = __expf(l1 - m), e2 = __expf(l2 - m), inv = 1.f / (e0 + e1 + e2);
            h16x8 o;
#pragma unroll
            for (int j = 0; j < 8; ++j) o[j] = (h16)((e0 * (float)a0[j] + e1 * (float)a1[j] + e2 * (float)a2[j]) * inv);
            *(h16x8*)(mix + (size_t)row * D + lane * 8) = o;
        }
#pragma unroll
        for (int hd = 0; hd < 4; ++hd) {
            const float rstd = rsqrtf(wave_sum(ov[hd][0] * ov[hd][0] + ov[hd][1] * ov[hd][1]) * (1.f / 128.f) + EPS);
            h16x2 r; r[0] = (h16)(ov[hd][0] * rstd * w2[0] * silu_f((float)zv[hd][0])); r[1] = (h16)(ov[hd][1] * rstd * w2[1] * silu_f((float)zv[hd][1]));
            *(h16x2*)(mix + (size_t)row * D + 512 + hd * 128 + 2 * lane) = r;
        }
    }
}

__device__ __forceinline__ void phase_final(const Params& p, float* lds) {
    int* li = (int*)lds;
    { const int* cnt = (const int*)(p.ws + WS_CTL);
      if (otid() == 0) { int t = 0; for (int e = 0; e < NE; ++e) { li[e] = t * 256; t += (cnt[e] + 255) / 256; } }
      __syncthreads(); }
    const h16* x1 = (const h16*)(p.ws + WS_X1); const float* mod = (const float*)(p.ws + WS_MOD); const float* fw = p.in[18];
    const h16* y = (const h16*)(p.ws + WS_Y16);
    const int* asg_e = (const int*)(p.ws + WS_ASG_E); const int* asg_p = (const int*)(p.ws + WS_ASG_P); const float* asg_g = (const float*)(p.ws + WS_ASG_G);
    const int tid_ = otid(); const int lane = tid_ & 63, wave = tid_ >> 6;
    const int gw = blockIdx.x * NWAVES + wave, NGW = gridDim.x * NWAVES;
    for (int row0 = gw; row0 < T; row0 += 2 * NGW) {
        size_t slot[2][4]; float gk[2][4]; int rows[2];
#pragma unroll
        for (int rr = 0; rr < 2; ++rr) {
            const int row = (row0 + rr * NGW < T) ? row0 + rr * NGW : row0; rows[rr] = row;
            const int4 ae = *(const int4*)(asg_e + row * 4), ap = *(const int4*)(asg_p + row * 4); const f32x4 ag = *(const f32x4*)(asg_g + row * 4);
            slot[rr][0] = (size_t)(li[ae.x] + ap.x); slot[rr][1] = (size_t)(li[ae.y] + ap.y); slot[rr][2] = (size_t)(li[ae.z] + ap.z); slot[rr][3] = (size_t)(li[ae.w] + ap.w);
            gk[rr][0] = ag[0]; gk[rr][1] = ag[1]; gk[rr][2] = ag[2]; gk[rr][3] = ag[3];
        }
        f32x4 v[2][4]; float ss[2] = {0.f, 0.f};
#pragma unroll
        for (int rr = 0; rr < 2; ++rr) {
            const int row = rows[rr]; const float* gate2 = mod + (row / SEQ) * 6144 + 5120;
#pragma unroll
            for (int j = 0; j < 4; ++j) {
                const int col = 256 * j + 4 * lane;
                h16x4 yv[4];
#pragma unroll
                for (int k = 0; k < 4; ++k) yv[k] = *(const h16x4*)(y + slot[rr][k] * D + col);
                const h16x4 xh = *(const h16x4*)(x1 + (size_t)row * D + col); const f32x4 xv = (f32x4){(float)xh[0], (float)xh[1], (float)xh[2], (float)xh[3]}, g2 = *(const f32x4*)(gate2 + col);
#pragma unroll
                for (int i = 0; i < 4; ++i) {
                    const float acc = gk[rr][0] * (float)yv[0][i] + gk[rr][1] * (float)yv[1][i] + gk[rr][2] * (float)yv[2][i] + gk[rr][3] * (float)yv[3][i];
                    v[rr][j][i] = xv[i] + g2[i] * acc; ss[rr] += v[rr][j][i] * v[rr][j][i];
                }
            }
        }
#pragma unroll
        for (int rr = 0; rr < 2; ++rr) {
            if (rr == 1 && row0 + NGW >= T) break;
            const float rstd = rsqrtf(wave_sum(ss[rr]) * (1.f / D) + EPS);
#pragma unroll
            for (int j = 0; j < 4; ++j) {
                const int col = 256 * j + 4 * lane; const f32x4 w4 = *(const f32x4*)(fw + col);
                f32x4 o; o[0] = v[rr][j][0] * rstd * w4[0]; o[1] = v[rr][j][1] * rstd * w4[1]; o[2] = v[rr][j][2] * rstd * w4[2]; o[3] = v[rr][j][3] * rstd * w4[3];
                *(f32x4*)(p.out + (size_t)rows[rr] * D + col) = o;
            }
        }
    }
}

constexpr float FP8_SA = 4.f, FP8_SW = 64.f;
__device__ __forceinline__ unsigned pack_fp8x4(float a, float b, float c, float d) {
    int w = 0;
    w = __builtin_amdgcn_cvt_pk_fp8_f32(fminf(fmaxf(a, -448.f), 448.f), fminf(fmaxf(b, -448.f), 448.f), w, false);
    w = __builtin_amdgcn_cvt_pk_fp8_f32(fminf(fmaxf(c, -448.f), 448.f), fminf(fmaxf(d, -448.f), 448.f), w, true);
    return (unsigned)w;
}
struct Cvt8Job { const float* src; unsigned char* dst; int N, K; };
__device__ __forceinline__ void cvt8_load(const Cvt8Job& j, int lane, f32x4 (&v)[16]) {
    const int kr = lane >> 4, n4 = (lane & 15) * 4;
#pragma unroll
    for (int i = 0; i < 16; ++i) v[i] = *(const f32x4*)(j.src + (size_t)(4 * i + kr) * j.N + n4);
}
__device__ __forceinline__ void cvt8_store(const Cvt8Job& jb, int lane, float* scr, const f32x4 (&v)[16]) {
    const int kr = lane >> 4, n4 = (lane & 15) * 4;
#pragma unroll
    for (int i = 0; i < 16; ++i) { float* d = scr + (4 * i + kr) * 65 + n4; d[0] = v[i][0]; d[1] = v[i][1]; d[2] = v[i][2]; d[3] = v[i][3]; }
    asm volatile("s_waitcnt lgkmcnt(0)" ::: "memory");
    const int c = lane & 3;
#pragma unroll
    for (int j = 0; j < 4; ++j) { const int n = (lane >> 2) + 16 * j; const float* sp = scr + (16 * c) * 65 + n;
        u32x4 o;
#pragma unroll
        for (int q = 0; q < 4; ++q) o[q] = pack_fp8x4(sp[(4 * q) * 65] * FP8_SW, sp[(4 * q + 1) * 65] * FP8_SW, sp[(4 * q + 2) * 65] * FP8_SW, sp[(4 * q + 3) * 65] * FP8_SW);
        *(u32x4*)(jb.dst + (size_t)n * jb.K + 16 * c) = o; }
    asm volatile("s_waitcnt lgkmcnt(0)" ::: "memory");
}
template <bool BF>
__device__ __forceinline__ void cvt_item(const float* W, int K, int N, h16* WT, int dst_row0, int k0, int n0, float* scr, int lane) {
    const int kr = lane >> 4, n4 = (lane & 15) * 4;
    f32x4 v[16];
#pragma unroll
    for (int i = 0; i < 16; ++i) v[i] = *(const f32x4*)(W + (size_t)(k0 + 4 * i + kr) * N + n0 + n4);
#pragma unroll
    for (int i = 0; i < 16; ++i) { float* d = scr + (4 * i + kr) * 65 + n4; d[0] = v[i][0]; d[1] = v[i][1]; d[2] = v[i][2]; d[3] = v[i][3]; }
    asm volatile("s_waitcnt lgkmcnt(0)" ::: "memory");
    const int c = lane & 7;
#pragma unroll
    for (int j = 0; j < 8; ++j) { const int n = (lane >> 3) + 8 * j; const float* sp = scr + (8 * c) * 65 + n;
        if constexpr (BF) { u32x4 ob; ob[0] = pk_bf16(sp[0], sp[65]); ob[1] = pk_bf16(sp[2 * 65], sp[3 * 65]); ob[2] = pk_bf16(sp[4 * 65], sp[5 * 65]); ob[3] = pk_bf16(sp[6 * 65], sp[7 * 65]);
            *(u32x4*)(WT + (size_t)(dst_row0 + n) * K + k0 + 8 * c) = ob; }
        else { h16x8 o;
#pragma unroll
            for (int q = 0; q < 8; ++q) o[q] = (h16)sp[q * 65];
            *(h16x8*)(WT + (size_t)(dst_row0 + n) * K + k0 + 8 * c) = o; } }
    asm volatile("s_waitcnt lgkmcnt(0)" ::: "memory");
}
__device__ __forceinline__ Cvt8Job cvt8_job(const Params& p, int r) {
    constexpr int I_W1 = 32 * 16 * 32;
    Cvt8Job j;
    if (r < I_W1) { const int e = r / 512, q = r % 512, kb = q / 32, nb = q % 32, n0 = nb * 64, hh = n0 / 1024, jj = n0 % 1024, row0 = (jj / 128) * 256 + hh * 128 + (jj % 128);
        j.N = 2 * FE; j.K = D; j.src = p.in[14] + (size_t)e * D * 2 * FE + (size_t)(kb * 64) * (2 * FE) + n0;
        j.dst = (unsigned char*)(p.ws + WS_W116) + (size_t)e * 2 * FE * D + (size_t)row0 * D + kb * 64; }
    else { r -= I_W1; const int e = r / 256, q = r % 256, kb = q / 16, nb = q % 16;
        j.N = D; j.K = FE; j.src = p.in[16] + (size_t)e * FE * D + (size_t)(kb * 64) * D + nb * 64;
        j.dst = (unsigned char*)(p.ws + WS_W216) + (size_t)e * D * FE + (size_t)(nb * 64) * FE + kb * 64; }
    return j;
}
__device__ __forceinline__ void phase_cvt(const Params& p, float* lds, int part, int vblock, int nvblocks) {
    const int tid_ = otid(); const int lane = tid_ & 63, wave = tid_ >> 6;
    float* scr = lds + wave * (64 * 65);
    const int gw = vblock * NWAVES + wave, NGW = nvblocks * NWAVES;
    constexpr int I_IN = 16 * 56, I_OUT = 16 * 16, I_W1 = 32 * 16 * 32, I_W2 = 32 * 16 * 16;
    const int it_lo = part == 0 ? 0 : I_IN, it_hi = part == 0 ? I_IN : I_IN + I_OUT;
    for (int it = it_lo + gw; it < it_hi; it += NGW) {
        int r = it;
        if (r < I_IN) { const int kb = r / 56, nb = r % 56; cvt_item<false>(p.in[5], D, INC, (h16*)(p.ws + WS_WIN16), nb * 64, kb * 64, nb * 64, scr, lane); continue; } r -= I_IN;
        { const int kb = r / 16, nb = r % 16; cvt_item<false>(p.in[10], D, D, (h16*)(p.ws + WS_WOUT16), nb * 64, kb * 64, nb * 64, scr, lane); }
    }
    if (part == 1) {
        constexpr int NI = I_W1 + I_W2;
        int it = gw;
        if (it < NI) {
            f32x4 v[16]; Cvt8Job jb = cvt8_job(p, it); cvt8_load(jb, lane, v);
            for (;;) {
                const int nx = it + NGW; const bool more = nx < NI;
                f32x4 vn[16]; const Cvt8Job jn = cvt8_job(p, more ? nx : it);
                cvt8_load(jn, lane, vn);
                cvt8_store(jb, lane, scr, v);
                if (!more) break;
#pragma unroll
                for (int i = 0; i < 16; ++i) v[i] = vn[i];
                jb = jn; it = nx;
            }
        }
    }
}

typedef pg8::Unit PUnit;
struct EpiInProjM {
    static constexpr bool PERM = true; unsigned char* ws;
    __device__ __forceinline__ void operator()(const f32x4 (&acc)[2][2][4][2], const PUnit& u, int wr, int wc, int fr, int fq) const {
        const int c0 = u.pn * 256; h16* dst; int ld, cc;
        if (c0 < 512) { dst = (h16*)(ws + WS_Q16); ld = 512; cc = c0; }
        else if (c0 < 1024) { dst = (h16*)(ws + WS_K16); ld = 512; cc = c0 - 512; }
        else if (c0 < 1536) { dst = (h16*)(ws + WS_V16); ld = 512; cc = c0 - 1024; }
        else if (c0 < 3072) { dst = (h16*)(ws + WS_DQKV); ld = 1536; cc = c0 - 1536; }
        else { dst = (h16*)(ws + WS_Z16); ld = 512; cc = c0 - 3072; }
        const int col0 = cc + wc * 32 + 8 * fq;
#pragma unroll
        for (int ai = 0; ai < 2; ++ai)
#pragma unroll
            for (int m = 0; m < 4; ++m) { const size_t row = (size_t)u.pm * 256 + ai * 128 + wr * 64 + m * 16 + fr;
#pragma unroll
                for (int bj = 0; bj < 2; ++bj) { h16x8 o;
#pragma unroll
                    for (int n = 0; n < 2; ++n)
#pragma unroll
                        for (int i = 0; i < 4; ++i) o[4 * n + i] = (h16)acc[ai][bj][m][n][i];
                    *(h16x8*)(dst + row * ld + col0 + bj * 128) = o; } }
    }
};
struct EpiOutProjM {
    static constexpr bool PERM = true; const float* x; const float* mod; h16* x1;
    __device__ __forceinline__ void operator()(const f32x4 (&acc)[2][2][4][2], const PUnit& u, int wr, int wc, int fr, int fq) const {
        const int col0 = u.pn * 256 + wc * 32 + 8 * fq;
#pragma unroll
        for (int ai = 0; ai < 2; ++ai)
#pragma unroll
            for (int m = 0; m < 4; ++m) { const size_t row = (size_t)u.pm * 256 + ai * 128 + wr * 64 + m * 16 + fr; const int b = (int)(row / SEQ);
#pragma unroll
                for (int bj = 0; bj < 2; ++bj) { const int c = col0 + bj * 128; h16x8 o;
#pragma unroll
                    for (int n = 0; n < 2; ++n) { const f32x4 gt = *(const f32x4*)(mod + b * 6144 + 2048 + c + 4 * n); const f32x4 xv = *(const f32x4*)(x + row * D + c + 4 * n);
#pragma unroll
                        for (int i = 0; i < 4; ++i) o[4 * n + i] = (h16)(xv[i] + gt[i] * acc[ai][bj][m][n][i]); }
                    *(h16x8*)(x1 + row * D + c) = o; } }
    }
};
struct EpiSwigluM {
    static constexpr bool PERM = true; h16* act; const float* b1;
    __device__ __forceinline__ void operator()(const f32x4 (&acc)[2][2][4][2], const PUnit& u, int wr, int wc, int fr, int fq) const {
        const float* bb = b1 + (size_t)u.e * 2 * FE; const int j0 = u.pn * 128 + wc * 32 + 8 * fq;
        f32x4 bg[2], bu[2];
#pragma unroll
        for (int n = 0; n < 2; ++n) { bg[n] = *(const f32x4*)(bb + j0 + 4 * n); bu[n] = *(const f32x4*)(bb + FE + j0 + 4 * n); }
        constexpr float RS = 1.f / (FP8_SA * FP8_SW);
        const f32x2 rs2 = {RS, RS}, ke2 = {-1.702f * 1.44269504089f, -1.702f * 1.44269504089f}, one2 = {1.f, 1.f}, sa2 = {FP8_SA, FP8_SA};
#pragma unroll
        for (int ai = 0; ai < 2; ++ai)
#pragma unroll
            for (int m = 0; m < 4; ++m) { const size_t row = (size_t)u.pm * 256 + ai * 128 + wr * 64 + m * 16 + fr; u32x2_t o;
#pragma unroll
                for (int n = 0; n < 2; ++n) { f32x2 ov[2];
#pragma unroll
                    for (int ip = 0; ip < 2; ++ip) { const int i = 2 * ip;
                        f32x2 gt = (f32x2){acc[ai][0][m][n][i], acc[ai][0][m][n][i + 1]} * rs2 + (f32x2){bg[n][i], bg[n][i + 1]};
                        f32x2 up = (f32x2){acc[ai][1][m][n][i], acc[ai][1][m][n][i + 1]} * rs2 + (f32x2){bu[n][i], bu[n][i + 1]};
                        gt[0] = fminf(gt[0], 7.f); gt[1] = fminf(gt[1], 7.f);
                        up[0] = __builtin_amdgcn_fmed3f(up[0], -7.f, 7.f); up[1] = __builtin_amdgcn_fmed3f(up[1], -7.f, 7.f);
                        f32x2 t = gt * ke2; t[0] = __builtin_amdgcn_exp2f(t[0]); t[1] = __builtin_amdgcn_exp2f(t[1]);
                        t = t + one2; t[0] = __builtin_amdgcn_rcpf(t[0]); t[1] = __builtin_amdgcn_rcpf(t[1]);
                        ov[ip] = (gt * t) * (up * sa2 + sa2); }
                    int w = __builtin_amdgcn_cvt_pk_fp8_f32(ov[0][0], ov[0][1], 0, false); w = __builtin_amdgcn_cvt_pk_fp8_f32(ov[1][0], ov[1][1], w, true);
                    o[n] = (unsigned)w; }
                *(u32x2_t*)((unsigned char*)act + row * FE + j0) = o; }
    }
};
struct EpiDownM {
    static constexpr bool PERM = true; h16* y; const float* b2;
    __device__ __forceinline__ void operator()(const f32x4 (&acc)[2][2][4][2], const PUnit& u, int wr, int wc, int fr, int fq) const {
        const float* bb = b2 + (size_t)u.e * D; const int col0 = u.pn * 256 + wc * 32 + 8 * fq;
#pragma unroll
        for (int bj = 0; bj < 2; ++bj) { f32x4 bv[2];
#pragma unroll
            for (int n = 0; n < 2; ++n) bv[n] = *(const f32x4*)(bb + col0 + bj * 128 + 4 * n);
#pragma unroll
            for (int ai = 0; ai < 2; ++ai)
#pragma unroll
                for (int m = 0; m < 4; ++m) { const size_t row = (size_t)u.pm * 256 + ai * 128 + wr * 64 + m * 16 + fr; h16x8 o;
#pragma unroll
                    for (int n = 0; n < 2; ++n)
#pragma unroll
                        for (int i = 0; i < 4; ++i) o[4 * n + i] = (h16)(acc[ai][bj][m][n][i] * (1.f / (FP8_SA * FP8_SW)) + bv[n][i]);
                    *(h16x8*)(y + row * D + col0 + bj * 128) = o; } }
    }
};
#define LAS3 __attribute__((address_space(3)))
__device__ __forceinline__ void phase_inproj_m(const Params& p, LAS3 unsigned char* lds) {
    pg8::Order S; S.init(T / 256, INC_MAIN / 256, gridDim.x, blockIdx.x, nullptr);
    pg8::gemm_phase<EpiInProjM, false>(lds, pg8::Gemm{(const h16*)(p.ws + WS_H16), (const h16*)(p.ws + WS_WIN16), INC_MAIN, D}, S, EpiInProjM{p.ws}, nullptr);
}
__device__ __forceinline__ void phase_outproj_m(const Params& p, LAS3 unsigned char* lds) {
    pg8::Order S; S.init(T / 256, D / 256, gridDim.x, blockIdx.x, nullptr);
    pg8::gemm_phase<EpiOutProjM, false>(lds, pg8::Gemm{(const h16*)(p.ws + WS_MIX), (const h16*)(p.ws + WS_WOUT16), D, D}, S,
                                         EpiOutProjM{p.in[0], (const float*)(p.ws + WS_MOD), (h16*)(p.ws + WS_X1)}, nullptr);
}
__device__ __forceinline__ void moe_prefix_m(const Params& p, LAS3 int* tab) {
    const int* cnt = (const int*)(p.ws + WS_CTL);
    const int t_ = otid();
    if (t_ < NE) tab[40 + t_] = cnt[t_];
    __syncthreads();
    if (t_ == 0) { int t = 0; for (int e = 0; e < NE; ++e) { tab[e] = t; t += (tab[40 + e] + 255) / 256; } tab[NE] = t; }
    __syncthreads();
}
__device__ __forceinline__ void phase_moe1_m(const Params& p, LAS3 unsigned char* lds) {
    LAS3 int* tab = (LAS3 int*)(lds + LDS_TAB); LAS3 int* gtab = (LAS3 int*)(lds + LDS_GTAB);
    moe_prefix_m(p, tab);
    const int* cnt = (const int*)(p.ws + WS_CTL); const int* tok = (const int*)(p.ws + WS_TOK);
    pg8::Order S; S.init(tab[NE], 2 * FE / 256, gridDim.x, blockIdx.x, tab);
    const int tid = otid();
    {
        int src[GTAB_UNITS / 2];
#pragma unroll
        for (int k = 0; k < GTAB_UNITS / 2; ++k) {
            const int ui = 2 * k + (tid >> 8); PUnit u; const bool ok = S.next(ui, u);
            const int e = ok ? u.e : 0, c = tab[40 + e]; int li = ok ? (u.pm - tab[e]) * 256 + (tid & 255) : 0; li = li < c ? li : (c > 0 ? c - 1 : 0);
            src[k] = tok[(size_t)e * T + li];
        }
#pragma unroll
        for (int k = 0; k < GTAB_UNITS / 2; ++k) gtab[(2 * k + (tid >> 8)) * 256 + (tid & 255)] = src[k];
    }
    __syncthreads();
    pg8::gemm_phase<EpiSwigluM, true, 3>(lds, pg8::Gemm{(const h16*)(p.ws + WS_H16), (const h16*)(p.ws + WS_W116), 2 * FE, D}, S,
                                       EpiSwigluM{(h16*)(p.ws + WS_ACT), p.in[15]}, gtab);
}
__device__ __forceinline__ void phase_moe2_m(const Params& p, LAS3 unsigned char* lds) {
    LAS3 int* tab = (LAS3 int*)(lds + LDS_TAB);
    moe_prefix_m(p, tab);
    pg8::Order S; S.init(tab[NE], D / 256, gridDim.x, blockIdx.x, tab);
    pg8::gemm_phase<EpiDownM, false, 3>(lds, pg8::Gemm{(const h16*)(p.ws + WS_ACT), (const h16*)(p.ws + WS_W216), D, FE}, S,
                                      EpiDownM{(h16*)(p.ws + WS_Y16), p.in[17]}, nullptr);
}


typedef float f32x4_t __attribute__((ext_vector_type(4)));
template <int MODE>
__device__ __forceinline__ void phase_rowproj(const Params& p, unsigned char* lds) {
    constexpr int NET = (MODE == 0) ? 1 : 2, RS = 1032;
    const float* xin = p.in[0]; const h16* x1h = (const h16*)(p.ws + WS_X1);
    const float* nw = (MODE == 0) ? p.in[4] : p.in[11];
    const float* mod = (const float*)(p.ws + WS_MOD);
    h16* hout = (h16*)(p.ws + WS_H16);
    h16* HI = (h16*)lds; h16* LO = (h16*)(lds + 33024); float* PART = (float*)(lds + 66048); float* LOGIT = (float*)(lds + 82432);
    int* LCNT = (int*)(lds + 84544); int* GB = (int*)(lds + 84672); int* LIST = (int*)(lds + 84800);
    const int tid = otid(), lane = tid & 63, w = tid >> 6, fr = lane & 15, fq = lane >> 4;
    int nit = 0;
    if (MODE == 1 && tid < 32) LCNT[tid] = 0;
    h16x8 Whi[NET][4], Wlo[NET][4];
#pragma unroll
    for (int et = 0; et < NET; ++et)
#pragma unroll
        for (int s4 = 0; s4 < 4; ++s4)
#pragma unroll
            for (int j = 0; j < 8; ++j) {
                const int k = 128 * w + 32 * s4 + 8 * fq + j, e = 16 * et + fr;
                float wv;
                if (MODE == 0) wv = (e < 8) ? p.in[5][(size_t)k * INC + INC_MAIN + e] : 0.f;
                else wv = p.in[12][(size_t)k * NE + e];
                wv *= 256.f;
                const h16 hi = (h16)wv; Whi[et][s4][j] = hi; Wlo[et][s4][j] = (h16)(wv - (float)hi);
            }
    f32x4 vn[2][4];
#define RP_LOAD(TILE) do { _Pragma("unroll") for (int rr_ = 0; rr_ < 2; ++rr_) { const size_t ro_ = (size_t)((TILE) * 16 + 2 * w + rr_) * D; \
        _Pragma("unroll") for (int j_ = 0; j_ < 4; ++j_) { if (MODE == 0) vn[rr_][j_] = *((const f32x4*)(xin + ro_) + lane + 64 * j_); \
            else { const h16x4 t_ = *((const h16x4*)(x1h + ro_) + lane + 64 * j_); vn[rr_][j_] = (f32x4){(float)t_[0], (float)t_[1], (float)t_[2], (float)t_[3]}; } } } } while (0)
    if ((int)blockIdx.x < T / 16) RP_LOAD(blockIdx.x);
#define RP_STEP_D(DTILE, DNIT) do { { const int rl = 2 * w + (lane >> 5), e = lane & 31, row = (DTILE) * 16 + rl; float v = LOGIT[rl * 33 + e]; float tv[4]; int te[4]; _Pragma("unroll") for (int k = 0; k < 4; ++k) { float bv = v; int bi = e; _Pragma("unroll") for (int o = 1; o < 32; o <<= 1) { const float ov = __shfl_xor(bv, o); const int oi = __shfl_xor(bi, o); const bool take = (ov > bv) || (ov == bv && oi < bi); bv = take ? ov : bv; bi = take ? oi : bi; } tv[k] = bv; te[k] = bi; if (e == bi) v = -INFINITY; } float ex[4]; float sum = 0.f; _Pragma("unroll") for (int k = 0; k < 4; ++k) { ex[k] = __expf(tv[k] - tv[0]); sum += ex[k]; } if (e < 4) { const int ek = (e == 0) ? te[0] : (e == 1) ? te[1] : (e == 2) ? te[2] : te[3]; const float gk = ((e == 0) ? ex[0] : (e == 1) ? ex[1] : (e == 2) ? ex[2] : ex[3]) / sum; const int lpos = atomicAdd(LCNT + ek, 1); LIST[(DNIT) * 64 + rl * 4 + e] = (ek << 16) | lpos; ((int*)(p.ws + WS_ASG_E))[row * 4 + e] = ek; ((float*)(p.ws + WS_ASG_G))[row * 4 + e] = gk; } } } while (0)
    for (int tile = blockIdx.x; tile < T / 16; tile += gridDim.x) {
        f32x4 v[2][4]; float ss[2];
#pragma unroll
        for (int rr = 0; rr < 2; ++rr)
#pragma unroll
            for (int j = 0; j < 4; ++j) v[rr][j] = vn[rr][j];
        if (tile + (int)gridDim.x < T / 16) RP_LOAD(tile + gridDim.x);
#pragma unroll
        for (int rr = 0; rr < 2; ++rr) {
            float a = 0.f;
#pragma unroll
            for (int j = 0; j < 4; ++j) a += v[rr][j][0] * v[rr][j][0] + v[rr][j][1] * v[rr][j][1] + v[rr][j][2] * v[rr][j][2] + v[rr][j][3] * v[rr][j][3];
            ss[rr] = rsqrtf(wave_sum(a) * (1.f / D) + EPS);
        }
        {
            const int b = (tile * 16) / SEQ;
            const float* shift = mod + b * 6144 + (MODE == 0 ? 0 : 3072); const float* scale = shift + 1024;
#pragma unroll
            for (int j = 0; j < 4; ++j) {
                const int col = 256 * j + 4 * lane;
                const f32x4 w4 = *(const f32x4*)(nw + col), sc = *(const f32x4*)(scale + col), sh = *(const f32x4*)(shift + col);
#pragma unroll
                for (int rr = 0; rr < 2; ++rr) {
                    const int rl = 2 * w + rr;
                    h16x4 hi4, lo4;
                    float hvv[4];
#pragma unroll
                    for (int i = 0; i < 4; ++i) { const float hv = v[rr][j][i] * ss[rr] * w4[i] * (1.f + sc[i]) + sh[i]; hvv[i] = hv; const h16 hi = (h16)hv; hi4[i] = hi; lo4[i] = (h16)(hv - (float)hi); }
                    if (MODE == 0) *(h16x4*)(hout + (size_t)(tile * 16 + rl) * D + col) = hi4;
                    else ((unsigned*)(p.ws + WS_H16))[((size_t)(tile * 16 + rl) * D + col) >> 2] = pack_fp8x4(hvv[0] * FP8_SA, hvv[1] * FP8_SA, hvv[2] * FP8_SA, hvv[3] * FP8_SA);
                    *(h16x4*)(HI + rl * RS + col) = hi4;
                    *(h16x4*)(LO + rl * RS + col) = lo4;
                }
            }
        }
        __syncthreads();
        if (MODE == 1 && nit > 0) RP_STEP_D(tile - (int)gridDim.x, nit - 1);
        {
            f32x4 acc[NET];
#pragma unroll
            for (int et = 0; et < NET; ++et) acc[et] = (f32x4){0.f, 0.f, 0.f, 0.f};
#pragma unroll
            for (int s4 = 0; s4 < 4; ++s4) {
                const h16x8 bh = *(const h16x8*)(HI + fr * RS + 128 * w + 32 * s4 + 8 * fq);
                const h16x8 bl = *(const h16x8*)(LO + fr * RS + 128 * w + 32 * s4 + 8 * fq);
#pragma unroll
                for (int et = 0; et < NET; ++et) {
                    acc[et] = __builtin_amdgcn_mfma_f32_16x16x32_f16(Whi[et][s4], bh, acc[et], 0, 0, 0);
                    acc[et] = __builtin_amdgcn_mfma_f32_16x16x32_f16(Wlo[et][s4], bh, acc[et], 0, 0, 0);
                    acc[et] = __builtin_amdgcn_mfma_f32_16x16x32_f16(Whi[et][s4], bl, acc[et], 0, 0, 0);
                }
            }
#pragma unroll
            for (int et = 0; et < NET; ++et)
#pragma unroll
                for (int i = 0; i < 4; ++i) PART[(w * 32 + 16 * et + 4 * fq + i) * 16 + fr] = acc[et][i];
        }
        __syncthreads();
        if (tid < 16 * 16 * NET) {
            const int e = tid >> 4, rl = tid & 15; float a = 0.f;
#pragma unroll
            for (int q = 0; q < 8; ++q) a += PART[(q * 32 + e) * 16 + rl];
            a *= (1.f / 256.f);
            if (MODE == 0) { if (e < 8) ((float*)(p.ws + WS_BA))[(size_t)(tile * 16 + rl) * 8 + e] = a; }
            else LOGIT[rl * 33 + e] = a + p.in[13][e];
        }
        ++nit;
    }
    if (MODE == 1) {
        __syncthreads();
        if (nit > 0) RP_STEP_D(blockIdx.x + (nit - 1) * (int)gridDim.x, nit - 1);
        __syncthreads();
        if (tid < 32) GB[tid] = atomicAdd((int*)(p.ws + WS_CTL) + tid, LCNT[tid]);
        __syncthreads();
        int* tok = (int*)(p.ws + WS_TOK); int* asg_p = (int*)(p.ws + WS_ASG_P);
        for (int idx = tid; idx < nit * 64; idx += NTHREADS) {
            const int pk = LIST[idx], e = pk >> 16, pos = GB[e] + (pk & 0xffff);
            const int row = (blockIdx.x + (idx >> 6) * gridDim.x) * 16 + ((idx & 63) >> 2);
            asg_p[row * 4 + (idx & 3)] = pos; tok[(size_t)e * T + pos] = row;
        }
    }
}

#define XB_TMO      128
#define XB_XCNT(j)  (256  + 64 * (j))
#define XB_XSUB(j)  (1280 + 64 * (j))
#define XB_XGEN(j)  (2304 + 64 * (j))
#define XB_TOP      3328
#define XB_TOPGEN   3392
#define XB_EXIT     3456
#define XCD_BAR_WORDS 3520
#define XB_SPIN_CAP (1u << 22)
__device__ __forceinline__ unsigned xb_ld(unsigned* p)              { return __hip_atomic_load(p, __ATOMIC_RELAXED, __HIP_MEMORY_SCOPE_AGENT); }
__device__ __forceinline__ unsigned xb_add(unsigned* p, unsigned v) { return __hip_atomic_fetch_add(p, v, __ATOMIC_RELAXED, __HIP_MEMORY_SCOPE_AGENT); }
__device__ __forceinline__ unsigned xb_xcc_id() { return (unsigned)__builtin_amdgcn_s_getreg((3 << 11) | 20) & 0xFu; }
#define XB_SPIN(cond, bar) do { unsigned _sp = 0; while (cond) { __builtin_amdgcn_s_sleep(1); \
    if ((++_sp & 255u) == 0u) { if (xb_ld(&(bar)[XB_TMO])) break; if (_sp > XB_SPIN_CAP) { atomicAdd(&(bar)[XB_TMO], 1u); break; } } } } while (0)
__device__ unsigned g_xbar[XCD_BAR_WORDS];
__device__ __forceinline__ void xcd_barrier_retire(unsigned* bar) {
    const unsigned old = xb_add(&bar[XB_EXIT], 1u);
    if (old + 1u == gridDim.x * gridDim.y * gridDim.z) {
        __hip_atomic_store(&bar[XB_TMO], 0u, __ATOMIC_RELAXED, __HIP_MEMORY_SCOPE_AGENT);
        for (unsigned j = 0; j < 16; ++j) { __hip_atomic_store(&bar[XB_XCNT(j)], 0u, __ATOMIC_RELAXED, __HIP_MEMORY_SCOPE_AGENT); __hip_atomic_store(&bar[XB_XSUB(j)], 0u, __ATOMIC_RELAXED, __HIP_MEMORY_SCOPE_AGENT);
            __hip_atomic_store(&bar[XB_XGEN(j)], 0u, __ATOMIC_RELAXED, __HIP_MEMORY_SCOPE_AGENT); }
        __hip_atomic_store(&bar[XB_TOP], 0u, __ATOMIC_RELAXED, __HIP_MEMORY_SCOPE_AGENT); __hip_atomic_store(&bar[XB_TOPGEN], 0u, __ATOMIC_RELAXED, __HIP_MEMORY_SCOPE_AGENT);
        __hip_atomic_store(&bar[XB_EXIT], 0u, __ATOMIC_RELAXED, __HIP_MEMORY_SCOPE_AGENT);
    }
}
struct XcdBarrier { unsigned* bar; unsigned x; volatile __attribute__((address_space(3))) unsigned* st; };
__device__ __forceinline__ XcdBarrier xcd_barrier_post(unsigned* bar, volatile __attribute__((address_space(3))) unsigned* st) {
    XcdBarrier b; b.bar = bar; b.x = xb_xcc_id(); b.st = st;
    if (threadIdx.x == 0) (void)xb_add(&bar[XB_XCNT(b.x)], 1u);
    return b;
}
__device__ __forceinline__ void xcd_barrier_complete(unsigned* bar, unsigned x, unsigned& nloc, unsigned& nx) {
    const unsigned G = gridDim.x * gridDim.y * gridDim.z;
    unsigned sum, cnt, mine, sp = 0u;
    for (;;) {
        sum = 0u; cnt = 0u; mine = 0u;
#pragma unroll
        for (unsigned j = 0; j < 16; ++j) { const unsigned c = xb_ld(&bar[XB_XCNT(j)]); sum += c; cnt += (c > 0u) ? 1u : 0u; mine = (j == x) ? c : mine; }
        if (sum == G) break;
        __builtin_amdgcn_s_sleep(1);
        if ((++sp & 255u) == 0u) { if (xb_ld(&bar[XB_TMO])) break; if (sp > XB_SPIN_CAP) { atomicAdd(&bar[XB_TMO], 1u); break; } }
    }
    nloc = mine > 0u ? mine : 1u; nx = cnt > 0u ? cnt : 1u;
}
__device__ __forceinline__ void xcd_barrier(const XcdBarrier& b) {
    asm volatile("s_waitcnt vmcnt(0)" ::: "memory");
    __syncthreads();
    if (threadIdx.x == 0) {
        unsigned* bar = b.bar;
        __builtin_amdgcn_s_waitcnt(0);
        unsigned nloc = b.st[0], nx = b.st[1];
        if (nloc == 0u) { xcd_barrier_complete(bar, b.x, nloc, nx); b.st[0] = nloc; b.st[1] = nx; }
        const unsigned old = xb_add(&bar[XB_XSUB(b.x)], 1u);
        const unsigned gen = old / nloc;
        if (old + 1u == (gen + 1u) * nloc) {
            __builtin_amdgcn_fence(__ATOMIC_RELEASE, "agent");
            asm volatile("s_waitcnt vmcnt(0)" ::: "memory");
            const unsigned og = xb_add(&bar[XB_TOP], 1u);
            const unsigned tg = og / nx;
            if (og + 1u == (tg + 1u) * nx) xb_add(&bar[XB_TOPGEN], 1u);
            else XB_SPIN(xb_ld(&bar[XB_TOPGEN]) == tg, bar);
            __builtin_amdgcn_fence(__ATOMIC_ACQUIRE, "agent");
            xb_add(&bar[XB_XGEN(b.x)], 1u);
            asm volatile("s_waitcnt vmcnt(0)" ::: "memory");
        } else {
            XB_SPIN(xb_ld(&bar[XB_XGEN(b.x)]) == gen, bar);
            __builtin_amdgcn_fence(__ATOMIC_ACQUIRE, "agent");
            asm volatile("s_waitcnt vmcnt(0)" ::: "memory");
        }
    }
    __syncthreads();
}

__global__ void __launch_bounds__(NTHREADS) fwd_megakernel(Params p) {
    extern __shared__ __attribute__((aligned(16))) unsigned char lds_raw[];
    float* lds = (float*)lds_raw;
    volatile LAS3 unsigned* misc = (volatile LAS3 unsigned*)((LAS3 unsigned char*)lds_raw + LDS_MISC);
    if (threadIdx.x < 2) misc[threadIdx.x] = 0u;
    __syncthreads();
    const XcdBarrier gbar = xcd_barrier_post(g_xbar, misc);
#define GSYNC() xcd_barrier(gbar)
    LAS3 unsigned char* l3 = (LAS3 unsigned char*)lds_raw;
#define REPS(k) for (int rep_ = 0; rep_ < ((PROBE == (k)) ? 2 : 1); ++rep_)
    REPS(1) { phase_mod(p, lds); phase_cvt(p, lds, 0, blockIdx.x, gridDim.x); GSYNC(); }
    REPS(2) { phase_rowproj<0>(p, lds_raw); GSYNC(); }
    REPS(3) { phase_inproj_m(p, l3); GSYNC(); }
    REPS(5) { phase_dnchunk2(p, lds_raw); GSYNC(); }
    for (int rep_ = 0; rep_ < ((PROBE == 6 || (PROBE >= 61 && PROBE <= 64)) ? 2 : 1); ++rep_) {
        const int nscan = 2 * NB * DH;
        if (gridDim.x >= 2 * nscan) {
            if (blockIdx.x < nscan) { if (!((PROBE == 62 || PROBE == 63 || PROBE == 64) && rep_)) phase_scan_mfma(p, lds_raw, ((blockIdx.x >> 4) << 3) + (blockIdx.x & 7), (blockIdx.x >> 3) & 1); }
            else if (!(PROBE == 61 && rep_)) {
                const bool cvt_first = ((blockIdx.x >> 3) & 1) != 0;
                if (cvt_first) { if (!(PROBE == 64 && rep_)) phase_cvt(p, lds, 1, blockIdx.x - nscan, gridDim.x - nscan); __syncthreads(); }
                if (!(PROBE == 63 && rep_)) phase_attn_mfma(p, lds_raw, blockIdx.x - nscan, gridDim.x - nscan);
                if (!cvt_first) { __syncthreads(); if (!(PROBE == 64 && rep_)) phase_cvt(p, lds, 1, blockIdx.x - nscan, gridDim.x - nscan); }
            }
        } else {
            for (int sb = blockIdx.x; sb < nscan; sb += gridDim.x) phase_scan_mfma(p, lds_raw, sb >> 1, sb & 1);
            phase_attn_mfma(p, lds_raw, blockIdx.x, gridDim.x); __syncthreads(); phase_cvt(p, lds, 1, blockIdx.x, gridDim.x);
        }
        GSYNC();
    }
    REPS(7) { phase_dnout(p); GSYNC(); }
    REPS(8) { phase_outproj_m(p, l3); GSYNC(); }
    REPS(9) {
        if (rep_) { if (blockIdx.x == 0 && threadIdx.x < 64) ((int*)(p.ws + WS_CTL))[threadIdx.x] = 0; GSYNC(); }
        phase_rowproj<1>(p, lds_raw); GSYNC();
    }
    REPS(10) { phase_moe1_m(p, l3); GSYNC(); }
    REPS(11) { phase_moe2_m(p, l3); GSYNC(); }
    REPS(12) { phase_final(p, lds); if (PROBE == 12) GSYNC(); }
    if (threadIdx.x == 0) xcd_barrier_retire(g_xbar);
}

extern "C" void kernel_launch(void* const* d_in, const int* in_sizes, int n_in, void* d_out, int out_size, void* d_ws, size_t ws_size, hipStream_t stream) {
    static int grid_blocks = 0;
    if (grid_blocks == 0) {
        if (n_in != 19 || out_size != T * D || ws_size < WS_END) { fprintf(stderr, "kernel_launch: unexpected shapes (n_in %d out %d ws %zu)\n", n_in, out_size, ws_size); grid_blocks = -1; return; }
        int dev = 0, cus = 0, per_cu = 0;
        hipGetDevice(&dev);
        hipDeviceGetAttribute(&cus, hipDeviceAttributeMultiprocessorCount, dev);
        hipFuncSetAttribute((const void*)fwd_megakernel, hipFuncAttributeMaxDynamicSharedMemorySize, LDS_BYTES);
        hipOccupancyMaxActiveBlocksPerMultiprocessor(&per_cu, (const void*)fwd_megakernel, NTHREADS, LDS_BYTES);
        if (per_cu < 1) { fprintf(stderr, "kernel_launch: occupancy query says %d blocks/CU\n", per_cu); grid_blocks = -1; return; }
        grid_blocks = cus;
    }
    if (grid_blocks < 0) return;
    Params p{};
    for (int i = 0; i < 19; ++i) p.in[i] = (const float*)d_in[i];
    p.out = (float*)d_out; p.ws = (unsigned char*)d_ws;
    hipLaunchKernelGGL(fwd_megakernel, dim3(grid_blocks), dim3(NTHREADS), LDS_BYTES, stream, p);
    const hipError_t e = hipPeekAtLastError();
    if (e != hipSuccess) fprintf(stderr, "launch failed: %s (grid %d)\n", hipGetErrorString(e), grid_blocks);
}
```

```cpp
#define PROBE 0
#include <hip/hip_runtime.h>
#include <hip/hip_cooperative_groups.h>
#include <cstdio>
#include <cstdint>
namespace cg = cooperative_groups;

typedef _Float16 h16;
typedef _Float16 h16x2 __attribute__((ext_vector_type(2)));
typedef _Float16 h16x4 __attribute__((ext_vector_type(4)));
typedef _Float16 h16x8 __attribute__((ext_vector_type(8)));
typedef float f32x4 __attribute__((ext_vector_type(4)));
typedef float f32x2 __attribute__((ext_vector_type(2)));
typedef float f32x16 __attribute__((ext_vector_type(16)));
typedef unsigned u32x4 __attribute__((ext_vector_type(4)));
typedef unsigned u32x2_t __attribute__((ext_vector_type(2)));

constexpr int D = 1024, NB = 4, SEQ = 8192, T = NB * SEQ;
constexpr int AH = 8, AHD = 64, AW = 512;
constexpr int DH = 4, DKD = 128, DW = 512, DCONV = 1536;
constexpr int INC = 3592, INC_MAIN = 3584;
constexpr int NE = 32, TOPK = 4, FE = 1024;
constexpr int NASG = T * TOPK;
constexpr float EPS = 1e-6f;
constexpr int NTHREADS = 512, NWAVES = 8;

constexpr size_t MiB = (size_t)1 << 20;
constexpr size_t WS_CTL = 0;
constexpr int CW_BAR = 4096; constexpr size_t CTL_ZERO_BYTES = 65536;
constexpr size_t WS_MOD = 1 * MiB;
constexpr size_t WS_BA = 2 * MiB;
constexpr size_t WS_G = 3 * MiB;
constexpr size_t WS_ASG_E = 4 * MiB;
constexpr size_t WS_ASG_P = 4 * MiB + 512 * 1024;
constexpr size_t WS_ASG_G = 5 * MiB;
constexpr size_t WS_TOK = 6 * MiB;
constexpr size_t WS_WIN16 = 16 * MiB;
constexpr size_t WS_WOUT16 = 24 * MiB;
constexpr size_t WS_W116 = 32 * MiB;
constexpr size_t WS_W216 = 160 * MiB;
constexpr size_t WS_H16 = 224 * MiB;
constexpr size_t WS_X1 = 288 * MiB;
constexpr size_t WS_R = 416 * MiB;
constexpr size_t WS_Q16 = WS_R;
constexpr size_t WS_K16 = WS_R + 32 * MiB;
constexpr size_t WS_V16 = WS_R + 64 * MiB;
constexpr size_t WS_DQKV = WS_R + 96 * MiB;
constexpr size_t WS_Z16 = WS_R + 192 * MiB;
constexpr size_t WS_QN = WS_R + 224 * MiB;
constexpr size_t WS_KN = WS_R + 256 * MiB;
constexpr size_t WS_VV = WS_R + 288 * MiB;
constexpr size_t WS_O32 = WS_R + 320 * MiB;
constexpr size_t WS_MIX = WS_R + 384 * MiB;
constexpr size_t WS_ACT = WS_R;
constexpr float FP8_SY = 32.f;
constexpr size_t WS_Y16 = WS_R + 272 * MiB;
constexpr size_t WS_AO = WS_DQKV;
constexpr size_t WS_LSE = WS_QN;
constexpr size_t WS_DNREC = WS_R + 448 * MiB;
constexpr size_t WS_END = WS_R + 592 * MiB;

constexpr int LDS_STAGE = 131072, LDS_TAB = LDS_STAGE, LDS_GTAB = LDS_STAGE + 1024, GTAB_UNITS = 18;
constexpr int LDS_MISC = LDS_GTAB + GTAB_UNITS * 256 * 4;
constexpr int LDS_BYTES = LDS_MISC + 256;
struct Params { const float* in[19]; float* out; unsigned char* ws; };

__device__ __forceinline__ float wave_sum(float v) {
#pragma unroll
    for (int o = 1; o < 64; o <<= 1) v += __shfl_xor(v, o);
    return v;
}
__device__ __forceinline__ float wave_max(float v) {
#pragma unroll
    for (int o = 1; o < 64; o <<= 1) v = fmaxf(v, __shfl_xor(v, o));
    return v;
}
__device__ __forceinline__ int otid() { int t = threadIdx.x; asm volatile("" : "+v"(t)); return t; }
__device__ __forceinline__ unsigned pk_bf16(float lo, float hi) { unsigned r; asm("v_cvt_pk_bf16_f32 %0, %1, %2" : "=v"(r) : "v"(lo), "v"(hi)); return r; }
__device__ __forceinline__ float silu_f(float v) { return v * __builtin_amdgcn_rcpf(1.f + __expf(-v)); }
__device__ __forceinline__ float sigmoid_f(float v) { return __builtin_amdgcn_rcpf(1.f + __expf(-v)); }


namespace pg8 {
#define PG8_LAS __attribute__((address_space(3)))
constexpr int BM = 256, BK = 64, HALF = 128, HTB = HALF * BK * 2, STAGE_BYTES = 8 * HTB, NXCD = 8, WGM = 4;
__device__ __forceinline__ int lds_byte(int r, int c) { const int st = (r >> 4) * 2 + (c >> 5), rr = r & 15, cc = c & 31, ob = rr * 64 + cc * 2; return st * 1024 + (ob ^ (((ob >> 9) & 1) << 5)); }
__device__ __forceinline__ void stage_rc(int b, int& R, int& C) { const int st = b / 1024, sb = b % 1024, swz = sb ^ (((sb >> 9) & 1) << 5); R = (st >> 1) * 16 + swz / 64; C = (st & 1) * 32 + (swz % 64) / 2; }
__device__ __forceinline__ int perm32(int rho) { const int n = rho >> 4, i = rho & 15; return 8 * (i >> 2) + 4 * n + (i & 3); }

struct Unit { int pm, pn, e; };
struct Gemm { const h16* A; const h16* Bt; int N, K; };

struct Order {
    int nM, nN, nwg, G, c; PG8_LAS const int* tstart;
    __device__ __forceinline__ void init(int nM_, int nN_, int G_, int c_, PG8_LAS const int* ts) { nM = nM_; nN = nN_; nwg = nM * nN; G = G_; c = c_; tstart = ts; }
    __device__ __forceinline__ bool next(int i, Unit& u) const {
        const long L = (long)i * G + c; if (L >= nwg) return false;
        int wgid = (int)L; { const int q = nwg / NXCD, r = nwg % NXCD, xcd = wgid % NXCD, off = wgid / NXCD; wgid = (xcd < r ? xcd * (q + 1) : r * (q + 1) + (xcd - r) * q) + off; }
        const int nig = WGM * nN, gid = wgid / nig, fm = gid * WGM, gsz = (nM - fm) < WGM ? (nM - fm) : WGM;
        u.pm = fm + ((wgid % nig) % gsz); u.pn = (wgid % nig) / gsz;
        int e = 0;
        if (tstart) { for (int q = 1; q < 32; ++q) if (tstart[q] <= u.pm) e = q; }
        u.e = e; return true;
    }
};

typedef __bf16 bf16x8_t __attribute__((ext_vector_type(8)));
typedef long l64x2_t __attribute__((ext_vector_type(2)));
typedef int v8i32 __attribute__((ext_vector_type(8)));
typedef int v4i32 __attribute__((ext_vector_type(4)));
#define PG8_CAT8(a, b) __builtin_shufflevector(__builtin_bit_cast(v4i32, a), __builtin_bit_cast(v4i32, b), 0, 1, 2, 3, 4, 5, 6, 7)
template <class Epi, bool GATHER, int EM = 0>
__device__ __forceinline__ void gemm_phase(PG8_LAS unsigned char* lds, const Gemm g, const Order& S, const Epi& E, PG8_LAS const int* gtab) {
    const int tid = otid(), wid = __builtin_amdgcn_readfirstlane(tid >> 6), lane = tid & 63, wr = wid >> 2, wc = wid & 3, fr = lane & 15, fq = lane >> 4;
    constexpr bool BF16 = (EM == 1); constexpr int ES = (EM >= 2) ? 1 : 2;
    const int K = g.K, nt = (K * ES) / (BK * 2);
    unsigned voffB[2]; int RA[2]; unsigned CA2[2];
#pragma unroll
    for (int i = 0; i < 2; ++i) { int R, C; stage_rc(tid * 16 + i * 8192, R, C); const int Rb = Epi::PERM ? ((R & ~31) + perm32(R & 31)) : R;
        RA[i] = R; CA2[i] = (unsigned)C * 2u; voffB[i] = (unsigned)(Rb * K) * (unsigned)ES + (unsigned)C * 2u; }
    const size_t kstep = (size_t)(BK * 2);
    const size_t hstep = (size_t)HALF * K * ES;
    const size_t tstep = 2 * hstep;
    const unsigned ldsw = (unsigned)wid * 1024u;
    const int aoff = lds_byte(wr * 64 + fr, fq * 8), boff = lds_byte(wc * 32 + fr, fq * 8);
#define PG8_SA(b, h) (((b) * 2 + (h)) * HTB)
#define PG8_SB(b, h) ((4 + (b) * 2 + (h)) * HTB)
#define PG8_STAGE(bufoff, gbase, voff) do { _Pragma("unroll") for (int _i = 0; _i < 2; ++_i) \
        __builtin_amdgcn_global_load_lds((const unsigned*)((const char*)(gbase) + (voff)[_i]), (PG8_LAS unsigned*)(lds + (bufoff) + ldsw + _i * 8192), 16, 0, 0); } while (0)
#define PG8_LDA(dst, b, h) do { _Pragma("unroll") for (int m = 0; m < 4; ++m) _Pragma("unroll") for (int k = 0; k < 2; ++k) dst[m][k] = *(const PG8_LAS h16x8*)(lds + PG8_SA(b, h) + aoff + m * 2048 + k * 1024); } while (0)
#define PG8_LDB(dst, b, h) do { _Pragma("unroll") for (int n = 0; n < 2; ++n) _Pragma("unroll") for (int k = 0; k < 2; ++k) dst[n][k] = *(const PG8_LAS h16x8*)(lds + PG8_SB(b, h) + boff + n * 2048 + k * 1024); } while (0)
#define PG8_MMA(ai, bj, At, Bt) do { __builtin_amdgcn_s_setprio(1); _Pragma("unroll") for (int m = 0; m < 4; ++m) _Pragma("unroll") for (int n = 0; n < 2; ++n) { if constexpr (EM == 3) { \
        { const v8i32 a8_ = PG8_CAT8(Bt[n][0], Bt[n][1]), b8_ = PG8_CAT8(At[m][0], At[m][1]); asm volatile("v_mfma_scale_f32_16x16x128_f8f6f4 %0, %1, %2, %0, %3, %3 op_sel_hi:[0,0,0]" : "+v"(acc[ai][bj][m][n]) : "v"(a8_), "v"(b8_), "v"(sc1)); } } else \
        _Pragma("unroll") for (int k = 0; k < 2; ++k) \
        { if constexpr (EM == 2) { const l64x2_t a_ = __builtin_bit_cast(l64x2_t, Bt[n][k]), b_ = __builtin_bit_cast(l64x2_t, At[m][k]); \
              acc[ai][bj][m][n] = __builtin_amdgcn_mfma_f32_16x16x32_fp8_fp8(a_[0], b_[0], acc[ai][bj][m][n], 0, 0, 0); acc[ai][bj][m][n] = __builtin_amdgcn_mfma_f32_16x16x32_fp8_fp8(a_[1], b_[1], acc[ai][bj][m][n], 0, 0, 0); } \
          else if constexpr (BF16) acc[ai][bj][m][n] = __builtin_amdgcn_mfma_f32_16x16x32_bf16(__builtin_bit_cast(bf16x8_t, Bt[n][k]), __builtin_bit_cast(bf16x8_t, At[m][k]), acc[ai][bj][m][n], 0, 0, 0); \
          else acc[ai][bj][m][n] = __builtin_amdgcn_mfma_f32_16x16x32_f16(Bt[n][k], At[m][k], acc[ai][bj][m][n], 0, 0, 0); } } __builtin_amdgcn_s_setprio(0); } while (0)
#define PG8_WAIT_V(n) asm volatile("s_waitcnt vmcnt(" #n ")" ::: "memory")
#define PG8_WAIT_L(n) asm volatile("s_waitcnt lgkmcnt(" #n ")" ::: "memory")
#define PG8_BAR __builtin_amdgcn_s_barrier()
#define PG8_SCHED __builtin_amdgcn_sched_barrier(0)
#define PG8_AOFF(o, u, uix) do { _Pragma("unroll") for (int _h = 0; _h < 2; ++_h) _Pragma("unroll") for (int _i = 0; _i < 2; ++_i) { \
        const int _r = _h * HALF + RA[_i]; const unsigned _src = GATHER ? (unsigned)gtab[(uix) * BM + _r] : (unsigned)((u).pm * BM + _r); \
        o[_h][_i] = _src * (unsigned)(K * ES) + CA2[_i]; } } while (0)
    Unit cur, nxt; int ui = 0;
    if (!S.next(0, cur)) return;
    int sc1 = 0x7F7F7F7F; asm volatile("" : "+v"(sc1));
    f32x4 acc[2][2][4][2];
#pragma unroll
    for (int a = 0; a < 2; ++a)
#pragma unroll
        for (int b = 0; b < 2; ++b)
#pragma unroll
            for (int m = 0; m < 4; ++m)
#pragma unroll
                for (int n = 0; n < 2; ++n) acc[a][b][m][n] = (f32x4){0.f, 0.f, 0.f, 0.f};
    h16x8 At[4][2], B0[2][2], B1[2][2];
    unsigned oc[2][2], on[2][2];
    PG8_AOFF(oc, cur, 0);
    const char* const A0 = (const char*)g.A;
    const char* cB = (const char*)g.Bt + ((size_t)cur.e * g.N + (size_t)cur.pn * BM) * K * ES;
    PG8_STAGE(PG8_SB(0, 0), cB, voffB); PG8_STAGE(PG8_SB(0, 1), cB + hstep, voffB); PG8_STAGE(PG8_SA(0, 0), A0, oc[0]); PG8_STAGE(PG8_SA(0, 1), A0, oc[1]);
    if (wr == 1) PG8_BAR;
    PG8_WAIT_V(2); PG8_BAR;
    PG8_STAGE(PG8_SB(1, 0), cB + kstep, voffB); PG8_STAGE(PG8_SA(1, 0), A0 + kstep, oc[0]); PG8_STAGE(PG8_SB(1, 1), cB + hstep + kstep, voffB);
    PG8_WAIT_V(6); PG8_BAR;
    for (;;) {
        const bool has_next = S.next(ui + 1, nxt);
        const char* nB = cB;
        if (has_next) { nB = (const char*)g.Bt + ((size_t)nxt.e * g.N + (size_t)nxt.pn * BM) * K * ES; PG8_AOFF(on, nxt, ui + 1); }
        else {
#pragma unroll
            for (int h = 0; h < 2; ++h)
#pragma unroll
                for (int i = 0; i < 2; ++i) on[h][i] = oc[h][i];
        }
#pragma unroll 1
        for (int t = 0; t < nt; t += 2) {
            const bool last = (t == nt - 2);
            const char* a1 = A0 + (size_t)(t + 1) * kstep;
            const char* a2 = last ? A0 : A0 + (size_t)(t + 2) * kstep; const char* b2 = last ? nB : cB + (size_t)(t + 2) * kstep;
            const char* a3 = a2 + kstep; const char* b3 = b2 + kstep;
            unsigned o2[2][2];
#pragma unroll
            for (int h = 0; h < 2; ++h)
#pragma unroll
                for (int i = 0; i < 2; ++i) o2[h][i] = last ? on[h][i] : oc[h][i];
            PG8_LDB(B0, 0, 0); PG8_LDB(B1, 0, 1); PG8_SCHED; PG8_LDA(At, 0, 0); PG8_STAGE(PG8_SA(1, 1), a1, oc[1]);
            PG8_WAIT_V(8); PG8_WAIT_L(0); PG8_BAR; PG8_MMA(0, 0, At, B0); PG8_MMA(0, 1, At, B1); PG8_BAR; PG8_SCHED;
            PG8_LDA(At, 0, 1); PG8_STAGE(PG8_SB(0, 0), b2, voffB); PG8_STAGE(PG8_SB(0, 1), b2 + hstep, voffB); PG8_STAGE(PG8_SA(0, 0), a2, o2[0]);
            PG8_WAIT_V(8); PG8_WAIT_L(0); PG8_BAR; PG8_MMA(1, 0, At, B0); PG8_MMA(1, 1, At, B1); PG8_BAR; PG8_SCHED;
            PG8_LDB(B0, 1, 0); PG8_LDB(B1, 1, 1); PG8_SCHED; PG8_LDA(At, 1, 0); PG8_STAGE(PG8_SA(0, 1), a2, o2[1]);
            PG8_WAIT_V(8); PG8_WAIT_L(0); PG8_BAR; PG8_MMA(0, 0, At, B0); PG8_MMA(0, 1, At, B1); PG8_BAR; PG8_SCHED;
            PG8_LDA(At, 1, 1); PG8_STAGE(PG8_SB(1, 0), b3, voffB); PG8_STAGE(PG8_SB(1, 1), b3 + hstep, voffB); PG8_STAGE(PG8_SA(1, 0), a3, o2[0]);
            PG8_WAIT_V(8); PG8_WAIT_L(0); PG8_BAR; PG8_MMA(1, 0, At, B0); PG8_MMA(1, 1, At, B1); PG8_BAR; PG8_SCHED;
        }
        if (wr == 0) PG8_BAR;
        if constexpr (EM == 3) asm volatile("s_nop 15\n\ts_nop 15" ::: "memory");
        E(acc, cur, wr, wc, fr, fq);
        if (!has_next) break;
#pragma unroll
        for (int a = 0; a < 2; ++a)
#pragma unroll
            for (int b = 0; b < 2; ++b)
#pragma unroll
                for (int m = 0; m < 4; ++m)
#pragma unroll
                    for (int n = 0; n < 2; ++n) acc[a][b][m][n] = (f32x4){0.f, 0.f, 0.f, 0.f};
        cur = nxt; cB = nB; ++ui;
#pragma unroll
        for (int h = 0; h < 2; ++h)
#pragma unroll
            for (int i = 0; i < 2; ++i) oc[h][i] = on[h][i];
        if (wr == 1) PG8_BAR;
    }
    PG8_WAIT_V(0);
    PG8_BAR;
#undef PG8_SA
#undef PG8_SB
#undef PG8_STAGE
#undef PG8_LDA
#undef PG8_LDB
#undef PG8_MMA
#undef PG8_WAIT_V
#undef PG8_WAIT_L
#undef PG8_BAR
#undef PG8_SCHED
#undef PG8_AOFF
}
}

__device__ __forceinline__ void phase_mod(const Params& p, float* lds) {
    const float* c = p.in[1]; const float* w = p.in[2]; const float* bias = p.in[3];
    float* mod = (float*)(p.ws + WS_MOD);
    const int tid = otid();
    for (int i = tid; i < 4096; i += NTHREADS) lds[i] = silu_f(c[i]);
    __syncthreads();
    float* red = lds + 4096;
    for (int cb = blockIdx.x; cb < 192; cb += gridDim.x) {
        const int cc = tid & 31, col = cb * 32 + cc, ks = tid >> 5;
        float a0 = 0.f, a1 = 0.f, a2 = 0.f, a3 = 0.f;
#pragma unroll 16
        for (int k = ks * 64; k < ks * 64 + 64; ++k) {
            const float wv = w[(size_t)k * 6144 + col];
            a0 += lds[k] * wv; a1 += lds[1024 + k] * wv; a2 += lds[2048 + k] * wv; a3 += lds[3072 + k] * wv;
        }
        red[(ks * 4 + 0) * 32 + cc] = a0; red[(ks * 4 + 1) * 32 + cc] = a1; red[(ks * 4 + 2) * 32 + cc] = a2; red[(ks * 4 + 3) * 32 + cc] = a3;
        __syncthreads();
        if (tid < 128) {
            const int b = tid >> 5; float s = 0.f;
            for (int q = 0; q < 16; ++q) s += red[(q * 4 + b) * 32 + cc];
            mod[b * 6144 + col] = s + bias[col];
        }
        __syncthreads();
    }
    if (blockIdx.x == 0 && tid < 64) ((int*)(p.ws + WS_CTL))[tid] = 0;
}

constexpr int DN_REC = 73728, DN_NW = 0, DN_QD = 16384, DN_KD = 32768, DN_IN = 49152, DN_U = 57344, DN_GL = 51200;
template <int NS, int PLO, int PHI>
__device__ __forceinline__ void dn_conv_rows(const h16* dqkv, const float* cw, size_t t0, int n, int hd, int r, int c8, h16* QS, h16* KS, h16* VS) {
#pragma unroll 1
    for (int part = PLO; part < PHI; ++part) {
        h16x8 xr[NS][4][2];
#pragma unroll
        for (int q = 0; q < NS; ++q)
#pragma unroll
            for (int j = 0; j < 4; ++j) {
                const int rr = r + 32 * q; const bool ok = (n * 64 + rr - 3 + j >= 0);
                const h16* rowp = dqkv + (t0 + rr - (ok ? 3 - j : 0)) * DCONV + part * 512 + hd * 128 + c8 * 16;
                const h16x8 x0 = *(const h16x8*)rowp, x1 = *(const h16x8*)(rowp + 8);
#pragma unroll
                for (int i = 0; i < 8; ++i) { xr[q][j][0][i] = ok ? x0[i] : (h16)0.f; xr[q][j][1][i] = ok ? x1[i] : (h16)0.f; }
            }
#pragma unroll
        for (int q = 0; q < NS; ++q) {
            float acc[16];
#pragma unroll
            for (int i = 0; i < 16; ++i) acc[i] = 0.f;
#pragma unroll
            for (int j = 0; j < 4; ++j) {
                const float* wp = cw + hd * 1536 + j * 384 + part * 128 + c8 * 16;
#pragma unroll
                for (int i4 = 0; i4 < 2; ++i4) { const f32x4 wa = *(const f32x4*)(wp + 4 * i4), wb = *(const f32x4*)(wp + 8 + 4 * i4);
#pragma unroll
                    for (int i = 0; i < 4; ++i) { acc[4 * i4 + i] += (float)xr[q][j][0][4 * i4 + i] * wa[i]; acc[8 + 4 * i4 + i] += (float)xr[q][j][1][4 * i4 + i] * wb[i]; } }
            }
            float ssq = 0.f;
#pragma unroll
            for (int i = 0; i < 16; ++i) { acc[i] = silu_f(acc[i]); ssq += acc[i] * acc[i]; }
            float sc = 1.f;
            if (part < 2) { ssq += __shfl_xor(ssq, 1); ssq += __shfl_xor(ssq, 2); ssq += __shfl_xor(ssq, 4); sc = rsqrtf(ssq + EPS) * (part == 0 ? 0.08838834764831845f : 1.f); }
            h16x8 o0, o1;
#pragma unroll
            for (int i = 0; i < 8; ++i) { o0[i] = (h16)(acc[i] * sc); o1[i] = (h16)(acc[8 + i] * sc); }
            h16* dst = (part == 0 ? QS : (part == 1 ? KS : VS)) + (r + 32 * q) * 136 + c8 * 16;
            *(h16x8*)dst = o0; *(h16x8*)(dst + 8) = o1;
        }
    }
}
__device__ __forceinline__ void dn_gates(const float* ba, const float* A_log, const float* dt_bias, size_t t0, int hd, int lane, float* GC, float* EG, float* BT) {
    const float dbv = ba[(t0 + lane) * 8 + hd], dav = ba[(t0 + lane) * 8 + 4 + hd];
    const float xsp = dav + dt_bias[hd];
    const float sp = (xsp > 20.f) ? xsp : log1pf(__expf(xsp));
    float x = -__expf(A_log[hd]) * sp;
#pragma unroll
    for (int o = 1; o < 64; o <<= 1) { const float y = __shfl_up(x, o); if (lane >= o) x += y; }
    GC[lane] = x; EG[lane] = __expf(x); BT[lane] = sigmoid_f(dbv);
    GC[192 + lane] = __expf(__shfl(x, 63) - x);
}
__device__ __forceinline__ void phase_dnchunk2(const Params& p, unsigned char* lds) {
    const h16* dqkv = (const h16*)(p.ws + WS_DQKV); const float* ba = (const float*)(p.ws + WS_BA);
    const float* A_log = p.in[7]; const float* dt_bias = p.in[8];
    h16* QS = (h16*)lds; h16* KS = (h16*)(lds + 17408); h16* VS = (h16*)(lds + 34816);
    float* KKA = (float*)(lds + 52224); float* QKA = (float*)(lds + 69632);
    h16* UL = (h16*)(lds + 87040); h16* WL = (h16*)(lds + 104448);
    float* GC = (float*)(lds + 121856); float* BT = GC + 64; float* EG = GC + 128;
    const int tid0 = otid(), wave = __builtin_amdgcn_readfirstlane(tid0 >> 6);
    constexpr int NITEM = NB * DH * (SEQ / 64);
    float* CWS = (float*)(lds + 122880);
    { const float* cwg = p.in[6];
      for (int i = tid0; i < 4 * 1536; i += NTHREADS) { const int hq = i / 1536, q = i % 1536, j = q / 384, c = q % 384; CWS[i] = cwg[j * DCONV + (c >> 7) * 512 + hq * 128 + (c & 127)]; }
      __syncthreads(); }
    const float* cw = CWS;
    if ((int)blockIdx.x < NITEM) {
        const int item = blockIdx.x, bh = item >> 7, n = item & 127; const size_t t0 = (size_t)(bh >> 2) * SEQ + n * 64;
        dn_conv_rows<1, 0, 3>(dqkv, cw, t0, n, bh & 3, tid0 >> 3, tid0 & 7, QS, KS, VS);
        if (wave == 0) dn_gates(ba, A_log, dt_bias, t0, bh & 3, tid0 & 63, GC, EG, BT);
    }
    __syncthreads();
    for (int item = blockIdx.x; item < NITEM; item += gridDim.x) {
        int tid = tid0; asm volatile("" : "+v"(tid));
        const int lane = tid & 63;
        unsigned char* rec = p.ws + WS_DNREC + (size_t)item * DN_REC;
        if (wave < 6) {
            const int kind = wave / 3, tl = wave - 3 * kind, I = (tl >= 1) ? 1 : 0, J = (tl == 2) ? 1 : 0, r32 = lane & 31, hh = lane >> 5;
            const h16* Ar = (kind == 0 ? KS : QS) + (32 * I + r32) * 136 + 8 * hh; const h16* Br = KS + (32 * J + r32) * 136 + 8 * hh;
            f32x16 acc;
#pragma unroll
            for (int i = 0; i < 16; ++i) acc[i] = 0.f;
#pragma unroll
            for (int s8 = 0; s8 < 8; ++s8) acc = __builtin_amdgcn_mfma_f32_32x32x16_f16(*(const h16x8*)(Ar + 16 * s8), *(const h16x8*)(Br + 16 * s8), acc, 0, 0, 0);
            const int j = 32 * J + r32; const float gj = GC[j];
            if (kind == 0) {
#pragma unroll
                for (int g4 = 0; g4 < 4; ++g4) {
                    f32x4 o;
#pragma unroll
                    for (int q = 0; q < 4; ++q) { const int i = 32 * I + 8 * g4 + 4 * hh + q; o[q] = (j < i) ? acc[4 * g4 + q] * __expf(GC[i] - gj) * BT[i] : 0.f; }
                    *(f32x4*)(KKA + j * 68 + 32 * I + 8 * g4 + 4 * hh) = o;
                }
            } else {
#pragma unroll
                for (int reg = 0; reg < 16; ++reg) {
                    const int i = 32 * I + (reg & 3) + 8 * (reg >> 2) + 4 * hh;
                    QKA[i * 68 + j] = (j <= i) ? acc[reg] * __expf(GC[i] - gj) : 0.f;
                }
            }
        } else if (wave == 6) {
            for (int idx = lane; idx < 1024; idx += 64) KKA[(32 + (idx >> 5)) * 68 + (idx & 31)] = 0.f;
        } else {
            for (int idx = lane; idx < 1024; idx += 64) QKA[(idx >> 5) * 68 + 32 + (idx & 31)] = 0.f;
        }
        __syncthreads();
        const float gclast = GC[63];
        for (int pc = tid; pc < 2560; pc += NTHREADS) {
            h16x8 o; int off;
            if (pc < 1024) {
                const int fs = pc >> 6, l = pc & 63, mt = fs >> 3, s8 = fs & 7, r = l & 31, hh = l >> 5, c = 32 * mt + r;
                const h16* sp = QS + c * 136 + 16 * s8 + 4 * hh;
                const h16x4 lo = *(const h16x4*)sp, hi = *(const h16x4*)(sp + 8);
                const float sc = EG[c];
#pragma unroll
                for (int j = 0; j < 4; ++j) { o[j] = (h16)((float)lo[j] * sc); o[4 + j] = (h16)((float)hi[j] * sc); }
                off = DN_QD + pc * 16;
            } else if (pc < 2048) {
                const int q = pc - 1024, fs = q >> 6, l = q & 63, kt = fs >> 2, s4 = fs & 3, r = l & 31, hh = l >> 5, dk = 32 * kt + r;
#pragma unroll
                for (int j = 0; j < 8; ++j) { const int c = 16 * s4 + 8 * (j >> 2) + 4 * hh + (j & 3); o[j] = (h16)((float)KS[c * 136 + dk] * GC[192 + c]); }
                off = DN_KD + q * 16;
            } else {
                const int q = pc - 2048, fs = q >> 6, l = q & 63, mt = fs >> 2, s4 = fs & 3, r = l & 31, hh = l >> 5, c = 32 * mt + r;
#pragma unroll
                for (int j = 0; j < 8; ++j) { const int c2 = 16 * s4 + 8 * (j >> 2) + 4 * hh + (j & 3); o[j] = (h16)QKA[c * 68 + c2]; }
                off = DN_IN + q * 16;
                if (fs == 2 && l == 0) { const unsigned gb = __float_as_uint(__expf(gclast)); const unsigned short lo16 = (unsigned short)(gb & 0xffffu), hi16 = (unsigned short)(gb >> 16);
                    o[0] = __builtin_bit_cast(h16, lo16); o[1] = __builtin_bit_cast(h16, hi16); }
            }
            *(h16x8*)(rec + off) = o;
        }
        for (int idx = tid; idx < 4096; idx += NTHREADS) {
            const int i = idx >> 6, c4 = (idx & 63) * 4; const bool wpart = c4 >= 128; const int dd = c4 & 127;
            const h16x4 sv = *(const h16x4*)((wpart ? KS : VS) + i * 136 + dd);
            const float sc = wpart ? BT[i] * EG[i] : BT[i];
            h16x4 o; o[0] = (h16)((float)sv[0] * sc); o[1] = (h16)((float)sv[1] * sc); o[2] = (h16)((float)sv[2] * sc); o[3] = (h16)((float)sv[3] * sc);
            *(h16x4*)((wpart ? WL : UL) + i * 136 + dd) = o;
        }
        __syncthreads();
        if (wave < 2) {
            const int d = tid & 127;
            h16* dU = UL + d; h16* dW = WL + d;
            int zl = 0; asm volatile("" : "+v"(zl));
            const float* Ab = KKA + zl;
            f32x2 XU[32], XW[32];
#pragma unroll
            for (int m = 0; m < 32; ++m) { XU[m][0] = (float)dU[(2 * m) * 136]; XU[m][1] = (float)dU[(2 * m + 1) * 136]; XW[m][0] = (float)dW[(2 * m) * 136]; XW[m][1] = (float)dW[(2 * m + 1) * 136]; }
#pragma unroll
            for (int j = 0; j < 64; ++j) {
                const float xu = XU[j / 2][j & 1], xw = XW[j / 2][j & 1];
                dU[j * 136] = (h16)xu; dW[j * 136] = (h16)(-xw);
                const f32x2 xu2 = (f32x2){xu, xu}, xw2 = (f32x2){xw, xw};
#pragma unroll
                for (int i4 = ((j + 1) & ~3); i4 < 64; i4 += 4) {
                    const f32x4 av = *(const f32x4*)(Ab + j * 68 + i4);
                    const f32x2 a01 = (f32x2){av[0], av[1]}, a23 = (f32x2){av[2], av[3]};
                    XU[i4 / 2] -= a01 * xu2; XU[i4 / 2 + 1] -= a23 * xu2;
                    XW[i4 / 2] -= a01 * xw2; XW[i4 / 2 + 1] -= a23 * xw2;
                }
                if ((j & 7) == 7) asm volatile("" ::: "memory");
            }
        } else if (wave != 5 && item + (int)gridDim.x < NITEM) {
            const int nitem = item + gridDim.x, bh = nitem >> 7, n = nitem & 127; const size_t t0 = (size_t)(bh >> 2) * SEQ + n * 64;
            if (wave == 4) dn_gates(ba, A_log, dt_bias, t0, bh & 3, lane, GC, EG, BT);
            else { const int lt = (wave < 4) ? tid - 128 : tid - 256;
                   dn_conv_rows<2, 0, 3>(dqkv, cw, t0, n, bh & 3, lt >> 3, lt & 7, QS, KS, VS); }
        }
        __syncthreads();
        for (int pc = tid; pc < 2048; pc += NTHREADS) {
            h16x8 o; int off;
            if (pc < 1024) {
                const int fs = pc >> 6, l = pc & 63, mt = fs >> 3, s8 = fs & 7, r = l & 31, hh = l >> 5, c = 32 * mt + r;
                const h16* sp = WL + c * 136 + 16 * s8 + 4 * hh;
                const h16x4 lo = *(const h16x4*)sp, hi = *(const h16x4*)(sp + 8);
#pragma unroll
                for (int j = 0; j < 4; ++j) { o[j] = lo[j]; o[4 + j] = hi[j]; }
                off = DN_NW + pc * 16;
            } else {
                const int q = pc - 1024, half8 = q & 1, l = (q >> 1) & 63, ms = q >> 7, mt = ms >> 2, sl = ms & 3, col = l & 31, hh = l >> 5;
#pragma unroll
                for (int j = 0; j < 8; ++j) { const int i = 8 * half8 + j; const int c = 32 * mt + (i & 3) + 8 * (i >> 2) + 4 * hh; o[j] = UL[c * 136 + 32 * sl + col]; }
                off = DN_U + q * 16;
            }
            *(h16x8*)(rec + off) = o;
        }
    }
}

__device__ __forceinline__ void cvt_frags(const f32x16& a, h16x8& f0, h16x8& f1) {
#pragma unroll
    for (int j = 0; j < 8; ++j) { f0[j] = (h16)a[j]; f1[j] = (h16)a[8 + j]; }
}
__device__ __forceinline__ void phase_scan_mfma(const Params& p, unsigned char* lds, int bh, int half) {
    const int tid = otid(), lane = tid & 63, wave = __builtin_amdgcn_readfirstlane(tid >> 6);
    const unsigned char* recs = p.ws + WS_DNREC + (size_t)bh * 128 * DN_REC;
    constexpr int NCH = SEQ / 64;
    if (wave >= 2) {
        const int lt = tid - 128;
        u32x4 R0[12], R1[12], R2[12];
#define DN_LOAD(R, n) do { const u32x4* s_ = (const u32x4*)(recs + (size_t)(n) * DN_REC) + lt; _Pragma("unroll") for (int k = 0; k < 12; ++k) R[k] = s_[k * 384]; } while (0)
#define DN_WRITE(R, n) do { u32x4* d_ = (u32x4*)(lds + ((n) & 1) * DN_REC) + lt; _Pragma("unroll") for (int k = 0; k < 12; ++k) d_[k * 384] = R[k]; } while (0)
        DN_LOAD(R0, 0); DN_WRITE(R0, 0); DN_LOAD(R1, 1); DN_LOAD(R2, 2);
        __syncthreads();
        for (int n = 0; n < NCH - 2; n += 3) {
            DN_LOAD(R0, min(n + 3, NCH - 1)); DN_WRITE(R1, n + 1); __syncthreads();
            DN_LOAD(R1, min(n + 4, NCH - 1)); DN_WRITE(R2, n + 2); __syncthreads();
            DN_LOAD(R2, min(n + 5, NCH - 1)); DN_WRITE(R0, n + 3); __syncthreads();
        }
        DN_WRITE(R1, NCH - 1); __syncthreads();
        __syncthreads();
        static_assert((NCH - 2) % 3 == 0 && (NCH - 1) % 3 == 1, "loader schedule assumes NCH = 3k + 2");
#undef DN_LOAD
#undef DN_WRITE
    } else {
        const int sl = 2 * half + wave, hh = lane >> 5;
        h16x2* o16 = (h16x2*)(p.ws + WS_O32);
        f32x16 S[4];
        h16x8 S16[4][2];
#pragma unroll
        for (int kt = 0; kt < 4; ++kt) {
#pragma unroll
            for (int i = 0; i < 16; ++i) S[kt][i] = 0.f;
#pragma unroll
            for (int j = 0; j < 8; ++j) { S16[kt][0][j] = (h16)0.f; S16[kt][1][j] = (h16)0.f; }
        }
        (void)hh;
        __syncthreads();
#define SB() __builtin_amdgcn_sched_barrier(0)
#define LD4(F, o0, o1, o2, o3) do { F[0] = *(const h16x8*)(fb + (o0)); F[1] = *(const h16x8*)(fb + (o1)); F[2] = *(const h16x8*)(fb + (o2)); F[3] = *(const h16x8*)(fb + (o3)); } while (0)
#define LDSEQ(F, base) LD4(F, (base), (base) + 1024, (base) + 2048, (base) + 3072)
#define MM(ACC, A, B) ACC = __builtin_amdgcn_mfma_f32_32x32x16_f16(A, B, ACC, 0, 0, 0)
        unsigned long long tacc_ = 0ull;
        for (int n = 0; n < NCH; ++n) {
            unsigned long long ts0_ = 0ull; if (PROBE == 70) ts0_ = __builtin_amdgcn_s_memtime();
            const unsigned char* buf = lds + (n & 1) * DN_REC;
            const unsigned char* fb = buf + lane * 16;
            h16x8 F0[4], F1[4], F2[4];
            f32x16 VN[2], O[2];
            h16x8 VN16[2][2];
            LDSEQ(F0, DN_NW + 0 * 1024); LDSEQ(F1, DN_NW + 4 * 1024);
            const float gl = *(const float*)(buf + DN_GL);
            h16x8 ur[2][2];
#pragma unroll
            for (int mt = 0; mt < 2; ++mt) { const h16x8* up = (const h16x8*)(buf + DN_U + ((mt * 4 + sl) * 64 + lane) * 32); ur[mt][0] = up[0]; ur[mt][1] = up[1]; }
            const f32x16 Z16 = {0.f, 0.f, 0.f, 0.f, 0.f, 0.f, 0.f, 0.f, 0.f, 0.f, 0.f, 0.f, 0.f, 0.f, 0.f, 0.f};
            SB();
            LDSEQ(F2, DN_NW + 8 * 1024);
            VN[0] = __builtin_amdgcn_mfma_f32_32x32x16_f16(F0[0], S16[0][0], Z16, 0, 0, 0); MM(VN[0], F0[1], S16[0][1]); MM(VN[0], F0[2], S16[1][0]); MM(VN[0], F0[3], S16[1][1]);
            SB();
            LDSEQ(F0, DN_NW + 12 * 1024);
            MM(VN[0], F1[0], S16[2][0]); MM(VN[0], F1[1], S16[2][1]); MM(VN[0], F1[2], S16[3][0]); MM(VN[0], F1[3], S16[3][1]);
            SB();
            LDSEQ(F1, DN_QD + 0 * 1024);
            VN[1] = __builtin_amdgcn_mfma_f32_32x32x16_f16(F2[0], S16[0][0], Z16, 0, 0, 0); MM(VN[1], F2[1], S16[0][1]); MM(VN[1], F2[2], S16[1][0]); MM(VN[1], F2[3], S16[1][1]);
            SB();
            LDSEQ(F2, DN_QD + 4 * 1024);
            MM(VN[1], F0[0], S16[2][0]); MM(VN[1], F0[1], S16[2][1]); MM(VN[1], F0[2], S16[3][0]); MM(VN[1], F0[3], S16[3][1]);
            SB();
            LDSEQ(F0, DN_QD + 8 * 1024);
            O[0] = __builtin_amdgcn_mfma_f32_32x32x16_f16(F1[0], S16[0][0], Z16, 0, 0, 0); MM(O[0], F1[1], S16[0][1]); MM(O[0], F1[2], S16[1][0]); MM(O[0], F1[3], S16[1][1]);
#pragma unroll
            for (int i = 0; i < 16; ++i) { S[0][i] *= gl; S[1][i] *= gl; }
#pragma unroll
            for (int j = 0; j < 8; ++j) { VN[0][j] += (float)ur[0][0][j]; VN[0][8 + j] += (float)ur[0][1][j]; }
            SB();
            LDSEQ(F1, DN_QD + 12 * 1024);
            MM(O[0], F2[0], S16[2][0]); MM(O[0], F2[1], S16[2][1]); MM(O[0], F2[2], S16[3][0]); MM(O[0], F2[3], S16[3][1]);
#pragma unroll
            for (int i = 0; i < 16; ++i) { S[2][i] *= gl; S[3][i] *= gl; }
#pragma unroll
            for (int j = 0; j < 8; ++j) { VN[1][j] += (float)ur[1][0][j]; VN[1][8 + j] += (float)ur[1][1][j]; }
            SB();
            LD4(F2, DN_IN + 0 * 1024, DN_IN + 1 * 1024, DN_IN + 4 * 1024, DN_IN + 5 * 1024);
            O[1] = __builtin_amdgcn_mfma_f32_32x32x16_f16(F0[0], S16[0][0], Z16, 0, 0, 0); MM(O[1], F0[1], S16[0][1]); MM(O[1], F0[2], S16[1][0]); MM(O[1], F0[3], S16[1][1]);
            cvt_frags(VN[0], VN16[0][0], VN16[0][1]);
            SB();
            F0[0] = *(const h16x8*)(fb + DN_IN + 6 * 1024); F0[1] = *(const h16x8*)(fb + DN_IN + 7 * 1024);
            MM(O[1], F1[0], S16[2][0]); MM(O[1], F1[1], S16[2][1]); MM(O[1], F1[2], S16[3][0]); MM(O[1], F1[3], S16[3][1]);
            cvt_frags(VN[1], VN16[1][0], VN16[1][1]);
            SB();
            LDSEQ(F1, DN_KD + 0 * 1024);
            MM(O[0], F2[0], VN16[0][0]); MM(O[0], F2[1], VN16[0][1]); MM(O[1], F2[2], VN16[0][0]); MM(O[1], F2[3], VN16[0][1]);
            SB();
            LDSEQ(F2, DN_KD + 4 * 1024);
            MM(O[1], F0[0], VN16[1][0]); MM(O[1], F0[1], VN16[1][1]);
            SB();
            h16x2* ob = o16 + ((size_t)((bh * NCH + n) * 2) * 4 + sl) * 512 + lane;
            LDSEQ(F0, DN_KD + 8 * 1024);
            MM(S[0], F1[0], VN16[0][0]); MM(S[0], F1[1], VN16[0][1]); MM(S[0], F1[2], VN16[1][0]); MM(S[0], F1[3], VN16[1][1]);
#pragma unroll
            for (int i = 0; i < 8; ++i) { h16x2 t2; t2[0] = (h16)O[0][2 * i]; t2[1] = (h16)O[0][2 * i + 1]; ob[i * 64] = t2; }
            SB();
            LDSEQ(F1, DN_KD + 12 * 1024);
            MM(S[1], F2[0], VN16[0][0]); MM(S[1], F2[1], VN16[0][1]); MM(S[1], F2[2], VN16[1][0]); MM(S[1], F2[3], VN16[1][1]);
#pragma unroll
            for (int i = 0; i < 8; ++i) { h16x2 t2; t2[0] = (h16)O[1][2 * i]; t2[1] = (h16)O[1][2 * i + 1]; ob[2048 + i * 64] = t2; }
            SB();
            MM(S[2], F0[0], VN16[0][0]); MM(S[2], F0[1], VN16[0][1]); MM(S[2], F0[2], VN16[1][0]); MM(S[2], F0[3], VN16[1][1]);
            cvt_frags(S[0], S16[0][0], S16[0][1]);
            SB();
            MM(S[3], F1[0], VN16[0][0]); MM(S[3], F1[1], VN16[0][1]); MM(S[3], F1[2], VN16[1][0]); MM(S[3], F1[3], VN16[1][1]);
            cvt_frags(S[1], S16[1][0], S16[1][1]);
            SB();
            cvt_frags(S[2], S16[2][0], S16[2][1]); cvt_frags(S[3], S16[3][0], S16[3][1]);
            if (PROBE == 70) { asm volatile("s_nop 0" :: "v"(S16[3][1])); tacc_ += __builtin_amdgcn_s_memtime() - ts0_; }
            if (PROBE == 71) ts0_ = __builtin_amdgcn_s_memtime();
            __syncthreads();
            if (PROBE == 71) tacc_ += __builtin_amdgcn_s_memtime() - ts0_;
        }
        if ((PROBE == 70 || PROBE == 71) && bh == 0 && tid == 0) *(float*)(p.ws + WS_CTL + 32768) = 0.02f * floorf((float)tacc_ / (float)NCH / 250.f);
#undef SB
#undef LD4
#undef LDSEQ
#undef MM
    }
}

constexpr int AT_KS_STRIDE = 72, AT_VT_STRIDE = 388, AT_VT_OFF = 384 * AT_KS_STRIDE * 2;
struct AttnUnit { int g, b, hd, dil, r, m0; size_t rowbase; };
__device__ __forceinline__ AttnUnit attn_unit(int u) {
    AttnUnit a; a.g = u >> 10; const int rem = u & 1023, x = (rem >> 3) & 31; a.b = rem >> 8; a.hd = rem & 7;
    a.dil = (a.g == 0) ? 1 : ((a.g == 1) ? 4 : 16); a.r = x & (a.dil - 1); a.m0 = (x / a.dil) * 256; a.rowbase = (size_t)a.b * SEQ + a.r; return a;
}
__device__ __forceinline__ void phase_attn_mfma(const Params& p, unsigned char* lds, int vblock, int nvblocks) {
    const h16* q16 = (const h16*)(p.ws + WS_Q16); const h16* k16 = (const h16*)(p.ws + WS_K16); const h16* v16 = (const h16*)(p.ws + WS_V16);
    h16* ao = (h16*)(p.ws + WS_AO); float* lse = (float*)(p.ws + WS_LSE);
    h16* Ks = (h16*)lds; h16* Vt = (h16*)(lds + AT_VT_OFF);
    const int tid = otid(), lane = tid & 63, w = tid >> 6, ql = lane & 31, hh = lane >> 5;
    h16x8 kr[6], vr[6], qf[4];
#define AT_PREFETCH(U) do { const AttnUnit a_ = attn_unit(U); \
        _Pragma("unroll") for (int k_ = 0; k_ < 6; ++k_) { const int idx_ = tid + 512 * k_, pc_ = idx_ & 7, kk_ = idx_ >> 3, m_ = a_.m0 - 128 + kk_; \
            const size_t go_ = (a_.rowbase + (size_t)(m_ < 0 ? 0 : m_) * a_.dil) * AW + a_.hd * 64 + pc_ * 8; \
            kr[k_] = *(const h16x8*)(k16 + go_); vr[k_] = *(const h16x8*)(v16 + go_); } \
        const size_t qrow_ = a_.rowbase + (size_t)(a_.m0 + 32 * w + ql) * a_.dil; \
        _Pragma("unroll") for (int s_ = 0; s_ < 4; ++s_) qf[s_] = *(const h16x8*)(q16 + qrow_ * AW + a_.hd * 64 + 16 * s_ + 8 * hh); } while (0)
    float bnd0[16], bnd4[16];
#pragma unroll
    for (int i = 0; i < 16; ++i) { const int row = (i & 3) + 8 * (i >> 2) + 4 * hh; bnd0[i] = (row >= ql) ? INFINITY : -INFINITY; bnd4[i] = (row <= ql) ? INFINITY : -INFINITY; }
    int u = vblock;
    if (u < 3 * 1024) AT_PREFETCH(u);
    for (; u < 3 * 1024; u += nvblocks) {
        const AttnUnit au = attn_unit(u);
        const int m0 = au.m0;
        const size_t qrow = au.rowbase + (size_t)(m0 + 32 * w + ql) * au.dil;
        __syncthreads();
#pragma unroll
        for (int k = 0; k < 6; ++k) {
            const int idx = tid + 512 * k, pc = idx & 7, kk = idx >> 3;
            const h16x8 kv = kr[k], vv = vr[k];
            *(h16x8*)(Ks + kk * AT_KS_STRIDE + pc * 8) = kv;
#pragma unroll
            for (int j = 0; j < 8; ++j) Vt[(pc * 8 + j) * AT_VT_STRIDE + kk] = vv[j];
        }
        h16x8 qc[4];
#pragma unroll
        for (int s4 = 0; s4 < 4; ++s4) qc[s4] = qf[s4];
        __syncthreads();
        if (u + nvblocks < 3 * 1024) AT_PREFETCH(u + nvblocks);
        f32x16 St[5];
#pragma unroll
        for (int kt = 0; kt < 5; ++kt) {
#pragma unroll
            for (int i = 0; i < 16; ++i) St[kt][i] = 0.f;
#pragma unroll
            for (int s4 = 0; s4 < 4; ++s4) {
                const h16x8 a = *(const h16x8*)(Ks + (32 * (w + kt) + ql) * AT_KS_STRIDE + 16 * s4 + 8 * hh);
                St[kt] = __builtin_amdgcn_mfma_f32_32x32x16_f16(a, qc[s4], St[kt], 0, 0, 0);
            }
        }
#pragma unroll
        for (int i = 0; i < 16; ++i) { St[0][i] = fminf(St[0][i], bnd0[i]); St[4][i] = fminf(St[4][i], bnd4[i]); }
        if (m0 == 0) {
#pragma unroll
            for (int kt = 0; kt < 4; ++kt)
                if (w + kt < 4) {
#pragma unroll
                    for (int i = 0; i < 16; ++i) St[kt][i] = -INFINITY;
                }
        }
        float mx = -INFINITY;
#pragma unroll
        for (int kt = 0; kt < 5; ++kt)
#pragma unroll
            for (int i = 0; i < 16; ++i) mx = fmaxf(mx, St[kt][i]);
        mx = fmaxf(mx, __shfl_xor(mx, 32));
        float l = 0.f;
        {
            const float c2 = 0.125f * 1.4426950408889634f, mb = -mx * c2;
#pragma unroll
            for (int kt = 0; kt < 5; ++kt)
#pragma unroll
                for (int i = 0; i < 16; ++i) { St[kt][i] = __builtin_amdgcn_exp2f(__builtin_fmaf(St[kt][i], c2, mb)); l += St[kt][i]; }
        }
        l += __shfl_xor(l, 32);
        f32x16 Ot[2];
#pragma unroll
        for (int dt = 0; dt < 2; ++dt)
#pragma unroll
            for (int i = 0; i < 16; ++i) Ot[dt][i] = 0.f;
#pragma unroll
        for (int kt = 0; kt < 5; ++kt) {
            h16x8 pf[2];
            cvt_frags(St[kt], pf[0], pf[1]);
#pragma unroll
            for (int s2 = 0; s2 < 2; ++s2)
#pragma unroll
                for (int dt = 0; dt < 2; ++dt) {
                    const h16* vp = Vt + (32 * dt + ql) * AT_VT_STRIDE + 32 * (w + kt) + 16 * s2 + 4 * hh;
                    const h16x4 lo = *(const h16x4*)vp, hi = *(const h16x4*)(vp + 8);
                    h16x8 a;
#pragma unroll
                    for (int j = 0; j < 4; ++j) { a[j] = lo[j]; a[4 + j] = hi[j]; }
                    Ot[dt] = __builtin_amdgcn_mfma_f32_32x32x16_f16(a, pf[s2], Ot[dt], 0, 0, 0);
                }
        }
        const float inv = __builtin_amdgcn_rcpf(l);
        h16* orow = ao + ((size_t)au.g * T + qrow) * AW + au.hd * 64;
#pragma unroll
        for (int dt = 0; dt < 2; ++dt)
#pragma unroll
            for (int i4 = 0; i4 < 4; ++i4) {
                h16x4 o;
#pragma unroll
                for (int j = 0; j < 4; ++j) o[j] = (h16)(Ot[dt][4 * i4 + j] * inv);
                *(h16x4*)(orow + 32 * dt + 8 * i4 + 4 * hh) = o;
            }
        if (hh == 0) lse[((size_t)au.g * T + qrow) * 8 + au.hd] = 0.125f * mx + __logf(l);
    }
#undef AT_PREFETCH
}

__device__ __forceinline__ void phase_dnout(const Params& p) {
    const float* o32 = (const float*)(p.ws + WS_O32); const h16* z16 = (const h16*)(p.ws + WS_Z16); const float* nw = p.in[9];
    const h16* ao = (const h16*)(p.ws + WS_AO); const float* lse = (const float*)(p.ws + WS_LSE);
    h16* mix = (h16*)(p.ws + WS_MIX);
    const int tid_ = otid(); const int lane = tid_ & 63, wave = tid_ >> 6;
    const int gw = blockIdx.x * NWAVES + wave, NGW = gridDim.x * NWAVES;
    const f32x2 w2 = *(const f32x2*)(nw + 2 * lane);
    for (int row = gw; row < T; row += NGW) {
        const int ah = lane >> 3;
        const float l0 = lse[((size_t)0 * T + row) * 8 + ah], l1 = lse[((size_t)1 * T + row) * 8 + ah], l2 = lse[((size_t)2 * T + row) * 8 + ah];
        const h16x8 a0 = *(const h16x8*)(ao + ((size_t)0 * T + row) * AW + lane * 8), a1 = *(const h16x8*)(ao + ((size_t)1 * T + row) * AW + lane * 8),
                    a2 = *(const h16x8*)(ao + ((size_t)2 * T + row) * AW + lane * 8);
        const int bq = row / SEQ, tp = row % SEQ, nq = tp >> 6, cq = tp & 63, mtq = cq >> 5, cl = cq & 31, h2 = (cl >> 2) & 1, iq = (cl & 3) + 4 * (cl >> 3);
        f32x2 ov[4]; h16x2 zv[4];
#pragma unroll
        for (int hd = 0; hd < 4; ++hd) {
            { const h16x2* op = (const h16x2*)(p.ws + WS_O32) + ((size_t)(((bq * 4 + hd) * (SEQ / 64) + nq) * 2 + mtq) * 4 + (lane >> 4)) * 512 + (iq >> 1) * 64 + h2 * 32 + ((2 * lane) & 31);
              const h16x2 pa = op[0], pb = op[1]; ov[hd][0] = (float)pa[iq & 1]; ov[hd][1] = (float)pb[iq & 1]; }
            zv[hd] = *(const h16x2*)(z16 + (size_t)row * DW + hd * 128 + 2 * lane);
        }
        {
            const float m = fmaxf(l0, fmaxf(l1, l2));
            const float e0 = __expf(l0 - m), e1 = __expf(l1 - m), e2 = __expf(l2 - m), inv = 1.f / (e0 + e1 + e2);
            h16x8 o;
#pragma unroll
            for (int j = 0; j < 8; ++j) o[j] = (h16)((e0 * (float)a0[j] + e1 * (float)a1[j] + e2 * (float)a2[j]) * inv);
            *(h16x8*)(mix + (size_t)row * D + lane * 8) = o;
        }
#pragma unroll
        for (int hd = 0; hd < 4; ++hd) {
            const float rstd = rsqrtf(wave_sum(ov[hd][0] * ov[hd][0] + ov[hd][1] * ov[hd][1]) * (1.f / 128.f) + EPS);
            h16x2 r; r[0] = (h16)(ov[hd][0] * rstd * w2[0] * silu_f((float)zv[hd][0])); r[1] = (h16)(ov[hd][1] * rstd * w2[1] * silu_f((float)zv[hd][1]));
            *(h16x2*)(mix + (size_t)row * D + 512 + hd * 128 + 2 * lane) = r;
        }
    }
}

__device__ __forceinline__ void phase_final(const Params& p, float* lds) {
    int* li = (int*)lds;
    { const int* cnt = (const int*)(p.ws + WS_CTL);
      if (otid() == 0) { int t = 0; for (int e = 0; e < NE; ++e) { li[e] = t * 256; t += (cnt[e] + 255) / 256; } }
      __syncthreads(); }
    const h16* x1 = (const h16*)(p.ws + WS_X1); const float* mod = (const float*)(p.ws + WS_MOD); const float* fw = p.in[18];
    const h16* y = (const h16*)(p.ws + WS_Y16);
    const int* asg_e = (const int*)(p.ws + WS_ASG_E); const int* asg_p = (const int*)(p.ws + WS_ASG_P); const float* asg_g = (const float*)(p.ws + WS_ASG_G);
    const int tid_ = otid(); const int lane = tid_ & 63, wave = tid_ >> 6;
    const int gw = blockIdx.x * NWAVES + wave, NGW = gridDim.x * NWAVES;
    for (int row0 = gw; row0 < T; row0 += 2 * NGW) {
        size_t slot[2][4]; float gk[2][4]; int rows[2];
#pragma unroll
        for (int rr = 0; rr < 2; ++rr) {
            const int row = (row0 + rr * NGW < T) ? row0 + rr * NGW : row0; rows[rr] = row;
            const int4 ae = *(const int4*)(asg_e + row * 4), ap = *(const int4*)(asg_p + row * 4); const f32x4 ag = *(const f32x4*)(asg_g + row * 4);
            slot[rr][0] = (size_t)(li[ae.x] + ap.x); slot[rr][1] = (size_t)(li[ae.y] + ap.y); slot[rr][2] = (size_t)(li[ae.z] + ap.z); slot[rr][3] = (size_t)(li[ae.w] + ap.w);
            gk[rr][0] = ag[0] * (1.f / FP8_SY); gk[rr][1] = ag[1] * (1.f / FP8_SY); gk[rr][2] = ag[2] * (1.f / FP8_SY); gk[rr][3] = ag[3] * (1.f / FP8_SY);
        }
        f32x4 v[2][4]; float ss[2] = {0.f, 0.f};
#pragma unroll
        for (int rr = 0; rr < 2; ++rr) {
            const int row = rows[rr]; const float* gate2 = mod + (row / SEQ) * 6144 + 5120;
#pragma unroll
            for (int j = 0; j < 4; ++j) {
                const int col = 256 * j + 4 * lane;
                f32x4 yv[4];
#pragma unroll
                for (int k = 0; k < 4; ++k) { const int yw = *(const int*)((const unsigned char*)y + slot[rr][k] * D + col);
                    const f32x2 lo = __builtin_amdgcn_cvt_pk_f32_fp8(yw, false), hi = __builtin_amdgcn_cvt_pk_f32_fp8(yw, true); yv[k] = (f32x4){lo[0], lo[1], hi[0], hi[1]}; }
                const h16x4 xh = *(const h16x4*)(x1 + (size_t)row * D + col); const f32x4 xv = (f32x4){(float)xh[0], (float)xh[1], (float)xh[2], (float)xh[3]}, g2 = *(const f32x4*)(gate2 + col);
#pragma unroll
                for (int i = 0; i < 4; ++i) {
                    const float acc = gk[rr][0] * yv[0][i] + gk[rr][1] * yv[1][i] + gk[rr][2] * yv[2][i] + gk[rr][3] * yv[3][i];
                    v[rr][j][i] = xv[i] + g2[i] * acc; ss[rr] += v[rr][j][i] * v[rr][j][i];
                }
            }
        }
#pragma unroll
        for (int rr = 0; rr < 2; ++rr) {
            if (rr == 1 && row0 + NGW >= T) break;
            const float rstd = rsqrtf(wave_sum(ss[rr]) * (1.f / D) + EPS);
#pragma unroll
            for (int j = 0; j < 4; ++j) {
                const int col = 256 * j + 4 * lane; const f32x4 w4 = *(const f32x4*)(fw + col);
                f32x4 o; o[0] = v[rr][j][0] * rstd * w4[0]; o[1] = v[rr][j][1] * rstd * w4[1]; o[2] = v[rr][j][2] * rstd * w4[2]; o[3] = v[rr][j][3] * rstd * w4[3];
                *(f32x4*)(p.out + (size_t)rows[rr] * D + col) = o;
            }
        }
    }
}

constexpr float FP8_SA = 4.f, FP8_SW = 64.f;
__device__ __forceinline__ unsigned pack_fp8x4(float a, float b, float c, float d) {
    int w = 0;
    w = __builtin_amdgcn_cvt_pk_fp8_f32(fminf(fmaxf(a, -448.f), 448.f), fminf(fmaxf(b, -448.f), 448.f), w, false);
    w = __builtin_amdgcn_cvt_pk_fp8_f32(fminf(fmaxf(c, -448.f), 448.f), fminf(fmaxf(d, -448.f), 448.f), w, true);
    return (unsigned)w;
}
struct Cvt8Job { const float* src; unsigned char* dst; int N, K; };
__device__ __forceinline__ void cvt8_load(const Cvt8Job& j, int lane, f32x4 (&v)[16]) {
    const int kr = lane >> 4, n4 = (lane & 15) * 4;
#pragma unroll
    for (int i = 0; i < 16; ++i) v[i] = *(const f32x4*)(j.src + (size_t)(4 * i + kr) * j.N + n4);
}
__device__ __forceinline__ void cvt8_store(const Cvt8Job& jb, int lane, float* scr, const f32x4 (&v)[16]) {
    const int kr = lane >> 4, n4 = (lane & 15) * 4;
#pragma unroll
    for (int i = 0; i < 16; ++i) { float* d = scr + (4 * i + kr) * 65 + n4; d[0] = v[i][0]; d[1] = v[i][1]; d[2] = v[i][2]; d[3] = v[i][3]; }
    asm volatile("s_waitcnt lgkmcnt(0)" ::: "memory");
    const int c = lane & 3;
#pragma unroll
    for (int j = 0; j < 4; ++j) { const int n = (lane >> 2) + 16 * j; const float* sp = scr + (16 * c) * 65 + n;
        u32x4 o;
#pragma unroll
        for (int q = 0; q < 4; ++q) o[q] = pack_fp8x4(sp[(4 * q) * 65] * FP8_SW, sp[(4 * q + 1) * 65] * FP8_SW, sp[(4 * q + 2) * 65] * FP8_SW, sp[(4 * q + 3) * 65] * FP8_SW);
        *(u32x4*)(jb.dst + (size_t)n * jb.K + 16 * c) = o; }
    asm volatile("s_waitcnt lgkmcnt(0)" ::: "memory");
}
template <bool BF>
__device__ __forceinline__ void cvt_item(const float* W, int K, int N, h16* WT, int dst_row0, int k0, int n0, float* scr, int lane) {
    const int kr = lane >> 4, n4 = (lane & 15) * 4;
    f32x4 v[16];
#pragma unroll
    for (int i = 0; i < 16; ++i) v[i] = *(const f32x4*)(W + (size_t)(k0 + 4 * i + kr) * N + n0 + n4);
#pragma unroll
    for (int i = 0; i < 16; ++i) { float* d = scr + (4 * i + kr) * 65 + n4; d[0] = v[i][0]; d[1] = v[i][1]; d[2] = v[i][2]; d[3] = v[i][3]; }
    asm volatile("s_waitcnt lgkmcnt(0)" ::: "memory");
    const int c = lane & 7;
#pragma unroll
    for (int j = 0; j < 8; ++j) { const int n = (lane >> 3) + 8 * j; const float* sp = scr + (8 * c) * 65 + n;
        if constexpr (BF) { u32x4 ob; ob[0] = pk_bf16(sp[0], sp[65]); ob[1] = pk_bf16(sp[2 * 65], sp[3 * 65]); ob[2] = pk_bf16(sp[4 * 65], sp[5 * 65]); ob[3] = pk_bf16(sp[6 * 65], sp[7 * 65]);
            *(u32x4*)(WT + (size_t)(dst_row0 + n) * K + k0 + 8 * c) = ob; }
        else { h16x8 o;
#pragma unroll
            for (int q = 0; q < 8; ++q) o[q] = (h16)sp[q * 65];
            *(h16x8*)(WT + (size_t)(dst_row0 + n) * K + k0 + 8 * c) = o; } }
    asm volatile("s_waitcnt lgkmcnt(0)" ::: "memory");
}
__device__ __forceinline__ Cvt8Job cvt8_job(const Params& p, int r) {
    constexpr int I_W1 = 32 * 16 * 32;
    Cvt8Job j;
    if (r < I_W1) { const int e = r / 512, q = r % 512, kb = q / 32, nb = q % 32, n0 = nb * 64, hh = n0 / 1024, jj = n0 % 1024, row0 = (jj / 128) * 256 + hh * 128 + (jj % 128);
        j.N = 2 * FE; j.K = D; j.src = p.in[14] + (size_t)e * D * 2 * FE + (size_t)(kb * 64) * (2 * FE) + n0;
        j.dst = (unsigned char*)(p.ws + WS_W116) + (size_t)e * 2 * FE * D + (size_t)row0 * D + kb * 64; }
    else { r -= I_W1; const int e = r / 256, q = r % 256, kb = q / 16, nb = q % 16;
        j.N = D; j.K = FE; j.src = p.in[16] + (size_t)e * FE * D + (size_t)(kb * 64) * D + nb * 64;
        j.dst = (unsigned char*)(p.ws + WS_W216) + (size_t)e * D * FE + (size_t)(nb * 64) * FE + kb * 64; }
    return j;
}
__device__ __forceinline__ void phase_cvt(const Params& p, float* lds, int part, int vblock, int nvblocks) {
    const int tid_ = otid(); const int lane = tid_ & 63, wave = tid_ >> 6;
    float* scr = lds + wave * (64 * 65);
    const int gw = vblock * NWAVES + wave, NGW = nvblocks * NWAVES;
    constexpr int I_IN = 16 * 56, I_OUT = 16 * 16, I_W1 = 32 * 16 * 32, I_W2 = 32 * 16 * 16;
    const int it_lo = part == 0 ? 0 : I_IN, it_hi = part == 0 ? I_IN : I_IN + I_OUT;
    for (int it = it_lo + gw; it < it_hi; it += NGW) {
        int r = it;
        if (r < I_IN) { const int kb = r / 56, nb = r % 56; cvt_item<false>(p.in[5], D, INC, (h16*)(p.ws + WS_WIN16), nb * 64, kb * 64, nb * 64, scr, lane); continue; } r -= I_IN;
        { const int kb = r / 16, nb = r % 16; cvt_item<false>(p.in[10], D, D, (h16*)(p.ws + WS_WOUT16), nb * 64, kb * 64, nb * 64, scr, lane); }
    }
    if (part == 1) {
        constexpr int NI = I_W1 + I_W2;
        int it = gw;
        if (it < NI) {
            f32x4 v[16]; Cvt8Job jb = cvt8_job(p, it); cvt8_load(jb, lane, v);
            for (;;) {
                const int nx = it + NGW; const bool more = nx < NI;
                f32x4 vn[16]; const Cvt8Job jn = cvt8_job(p, more ? nx : it);
                cvt8_load(jn, lane, vn);
                cvt8_store(jb, lane, scr, v);
                if (!more) break;
#pragma unroll
                for (int i = 0; i < 16; ++i) v[i] = vn[i];
                jb = jn; it = nx;
            }
        }
    }
}

typedef pg8::Unit PUnit;
struct EpiInProjM {
    static constexpr bool PERM = true; unsigned char* ws;
    __device__ __forceinline__ void operator()(const f32x4 (&acc)[2][2][4][2], const PUnit& u, int wr, int wc, int fr, int fq) const {
        const int c0 = u.pn * 256; h16* dst; int ld, cc;
        if (c0 < 512) { dst = (h16*)(ws + WS_Q16); ld = 512; cc = c0; }
        else if (c0 < 1024) { dst = (h16*)(ws + WS_K16); ld = 512; cc = c0 - 512; }
        else if (c0 < 1536) { dst = (h16*)(ws + WS_V16); ld = 512; cc = c0 - 1024; }
        else if (c0 < 3072) { dst = (h16*)(ws + WS_DQKV); ld = 1536; cc = c0 - 1536; }
        else { dst = (h16*)(ws + WS_Z16); ld = 512; cc = c0 - 3072; }
        const int col0 = cc + wc * 32 + 8 * fq;
#pragma unroll
        for (int ai = 0; ai < 2; ++ai)
#pragma unroll
            for (int m = 0; m < 4; ++m) { const size_t row = (size_t)u.pm * 256 + ai * 128 + wr * 64 + m * 16 + fr;
#pragma unroll
                for (int bj = 0; bj < 2; ++bj) { h16x8 o;
#pragma unroll
                    for (int n = 0; n < 2; ++n)
#pragma unroll
                        for (int i = 0; i < 4; ++i) o[4 * n + i] = (h16)acc[ai][bj][m][n][i];
                    *(h16x8*)(dst + row * ld + col0 + bj * 128) = o; } }
    }
};
struct EpiOutProjM {
    static constexpr bool PERM = true; const float* x; const float* mod; h16* x1;
    __device__ __forceinline__ void operator()(const f32x4 (&acc)[2][2][4][2], const PUnit& u, int wr, int wc, int fr, int fq) const {
        const int col0 = u.pn * 256 + wc * 32 + 8 * fq;
#pragma unroll
        for (int ai = 0; ai < 2; ++ai)
#pragma unroll
            for (int m = 0; m < 4; ++m) { const size_t row = (size_t)u.pm * 256 + ai * 128 + wr * 64 + m * 16 + fr; const int b = (int)(row / SEQ);
#pragma unroll
                for (int bj = 0; bj < 2; ++bj) { const int c = col0 + bj * 128; h16x8 o;
#pragma unroll
                    for (int n = 0; n < 2; ++n) { const f32x4 gt = *(const f32x4*)(mod + b * 6144 + 2048 + c + 4 * n); const f32x4 xv = *(const f32x4*)(x + row * D + c + 4 * n);
#pragma unroll
                        for (int i = 0; i < 4; ++i) o[4 * n + i] = (h16)(xv[i] + gt[i] * acc[ai][bj][m][n][i]); }
                    *(h16x8*)(x1 + row * D + c) = o; } }
    }
};
struct EpiSwigluM {
    static constexpr bool PERM = true; h16* act; const float* b1;
    __device__ __forceinline__ void operator()(const f32x4 (&acc)[2][2][4][2], const PUnit& u, int wr, int wc, int fr, int fq) const {
        const float* bb = b1 + (size_t)u.e * 2 * FE; const int j0 = u.pn * 128 + wc * 32 + 8 * fq;
        f32x4 bg[2], bu[2];
#pragma unroll
        for (int n = 0; n < 2; ++n) { bg[n] = *(const f32x4*)(bb + j0 + 4 * n); bu[n] = *(const f32x4*)(bb + FE + j0 + 4 * n); }
        constexpr float RS = 1.f / (FP8_SA * FP8_SW);
        const f32x2 rs2 = {RS, RS}, ke2 = {-1.702f * 1.44269504089f, -1.702f * 1.44269504089f}, one2 = {1.f, 1.f}, sa2 = {FP8_SA, FP8_SA};
#pragma unroll
        for (int ai = 0; ai < 2; ++ai)
#pragma unroll
            for (int m = 0; m < 4; ++m) { const size_t row = (size_t)u.pm * 256 + ai * 128 + wr * 64 + m * 16 + fr; u32x2_t o;
#pragma unroll
                for (int n = 0; n < 2; ++n) { f32x2 ov[2];
#pragma unroll
                    for (int ip = 0; ip < 2; ++ip) { const int i = 2 * ip;
                        f32x2 gt = (f32x2){acc[ai][0][m][n][i], acc[ai][0][m][n][i + 1]} * rs2 + (f32x2){bg[n][i], bg[n][i + 1]};
                        f32x2 up = (f32x2){acc[ai][1][m][n][i], acc[ai][1][m][n][i + 1]} * rs2 + (f32x2){bu[n][i], bu[n][i + 1]};
                        gt[0] = fminf(gt[0], 7.f); gt[1] = fminf(gt[1], 7.f);
                        up[0] = __builtin_amdgcn_fmed3f(up[0], -7.f, 7.f); up[1] = __builtin_amdgcn_fmed3f(up[1], -7.f, 7.f);
                        f32x2 t = gt * ke2; t[0] = __builtin_amdgcn_exp2f(t[0]); t[1] = __builtin_amdgcn_exp2f(t[1]);
                        t = t + one2; t[0] = __builtin_amdgcn_rcpf(t[0]); t[1] = __builtin_amdgcn_rcpf(t[1]);
                        ov[ip] = (gt * t) * (up * sa2 + sa2); }
                    int w = __builtin_amdgcn_cvt_pk_fp8_f32(ov[0][0], ov[0][1], 0, false); w = __builtin_amdgcn_cvt_pk_fp8_f32(ov[1][0], ov[1][1], w, true);
                    o[n] = (unsigned)w; }
                *(u32x2_t*)((unsigned char*)act + row * FE + j0) = o; }
    }
};
struct EpiDownM {
    static constexpr bool PERM = true; h16* y; const float* b2;
    __device__ __forceinline__ void operator()(const f32x4 (&acc)[2][2][4][2], const PUnit& u, int wr, int wc, int fr, int fq) const {
        const float* bb = b2 + (size_t)u.e * D; const int col0 = u.pn * 256 + wc * 32 + 8 * fq;
#pragma unroll
        for (int bj = 0; bj < 2; ++bj) { f32x4 bv[2];
#pragma unroll
            for (int n = 0; n < 2; ++n) bv[n] = *(const f32x4*)(bb + col0 + bj * 128 + 4 * n);
#pragma unroll
            for (int ai = 0; ai < 2; ++ai)
#pragma unroll
                for (int m = 0; m < 4; ++m) { const size_t row = (size_t)u.pm * 256 + ai * 128 + wr * 64 + m * 16 + fr; u32x2_t o;
#pragma unroll
                    for (int n = 0; n < 2; ++n) { float t[4];
#pragma unroll
                        for (int i = 0; i < 4; ++i) t[i] = acc[ai][bj][m][n][i] * (FP8_SY / (FP8_SA * FP8_SW)) + bv[n][i] * FP8_SY;
                        o[n] = pack_fp8x4(t[0], t[1], t[2], t[3]); }
                    *(u32x2_t*)((unsigned char*)y + row * D + col0 + bj * 128) = o; } }
    }
};
#define LAS3 __attribute__((address_space(3)))
__device__ __forceinline__ void phase_inproj_m(const Params& p, LAS3 unsigned char* lds) {
    pg8::Order S; S.init(T / 256, INC_MAIN / 256, gridDim.x, blockIdx.x, nullptr);
    pg8::gemm_phase<EpiInProjM, false>(lds, pg8::Gemm{(const h16*)(p.ws + WS_H16), (const h16*)(p.ws + WS_WIN16), INC_MAIN, D}, S, EpiInProjM{p.ws}, nullptr);
}
__device__ __forceinline__ void phase_outproj_m(const Params& p, LAS3 unsigned char* lds) {
    pg8::Order S; S.init(T / 256, D / 256, gridDim.x, blockIdx.x, nullptr);
    pg8::gemm_phase<EpiOutProjM, false>(lds, pg8::Gemm{(const h16*)(p.ws + WS_MIX), (const h16*)(p.ws + WS_WOUT16), D, D}, S,
                                         EpiOutProjM{p.in[0], (const float*)(p.ws + WS_MOD), (h16*)(p.ws + WS_X1)}, nullptr);
}
__device__ __forceinline__ void moe_prefix_m(const Params& p, LAS3 int* tab) {
    const int* cnt = (const int*)(p.ws + WS_CTL);
    const int t_ = otid();
    if (t_ < NE) tab[40 + t_] = cnt[t_];
    __syncthreads();
    if (t_ == 0) { int t = 0; for (int e = 0; e < NE; ++e) { tab[e] = t; t += (tab[40 + e] + 255) / 256; } tab[NE] = t; }
    __syncthreads();
}
__device__ __forceinline__ void phase_moe1_m(const Params& p, LAS3 unsigned char* lds) {
    LAS3 int* tab = (LAS3 int*)(lds + LDS_TAB); LAS3 int* gtab = (LAS3 int*)(lds + LDS_GTAB);
    moe_prefix_m(p, tab);
    const int* cnt = (const int*)(p.ws + WS_CTL); const int* tok = (const int*)(p.ws + WS_TOK);
    pg8::Order S; S.init(tab[NE], 2 * FE / 256, gridDim.x, blockIdx.x, tab);
    const int tid = otid();
    {
        int src[GTAB_UNITS / 2];
#pragma unroll
        for (int k = 0; k < GTAB_UNITS / 2; ++k) {
            const int ui = 2 * k + (tid >> 8); PUnit u; const bool ok = S.next(ui, u);
            const int e = ok ? u.e : 0, c = tab[40 + e]; int li = ok ? (u.pm - tab[e]) * 256 + (tid & 255) : 0; li = li < c ? li : (c > 0 ? c - 1 : 0);
            src[k] = tok[(size_t)e * T + li];
        }
#pragma unroll
        for (int k = 0; k < GTAB_UNITS / 2; ++k) gtab[(2 * k + (tid >> 8)) * 256 + (tid & 255)] = src[k];
    }
    __syncthreads();
    pg8::gemm_phase<EpiSwigluM, true, 3>(lds, pg8::Gemm{(const h16*)(p.ws + WS_H16), (const h16*)(p.ws + WS_W116), 2 * FE, D}, S,
                                       EpiSwigluM{(h16*)(p.ws + WS_ACT), p.in[15]}, gtab);
}
__device__ __forceinline__ void phase_moe2_m(const Params& p, LAS3 unsigned char* lds) {
    LAS3 int* tab = (LAS3 int*)(lds + LDS_TAB);
    moe_prefix_m(p, tab);
    pg8::Order S; S.init(tab[NE], D / 256, gridDim.x, blockIdx.x, tab);
    pg8::gemm_phase<EpiDownM, false, 3>(lds, pg8::Gemm{(const h16*)(p.ws + WS_ACT), (const h16*)(p.ws + WS_W216), D, FE}, S,
                                      EpiDownM{(h16*)(p.ws + WS_Y16), p.in[17]}, nullptr);
}


typedef float f32x4_t __attribute__((ext_vector_type(4)));
template <int MODE>
__device__ __forceinline__ void phase_rowproj(const Params& p, unsigned char* lds) {
    constexpr int NET = (MODE == 0) ? 1 : 2, RS = 1032;
    const float* xin = p.in[0]; const h16* x1h = (const h16*)(p.ws + WS_X1);
    const float* nw = (MODE == 0) ? p.in[4] : p.in[11];
    const float* mod = (const float*)(p.ws + WS_MOD);
    h16* hout = (h16*)(p.ws + WS_H16);
    h16* HI = (h16*)lds; h16* LO = (h16*)(lds + 33024); float* PART = (float*)(lds + 66048); float* LOGIT = (float*)(lds + 82432);
    int* LCNT = (int*)(lds + 84544); int* GB = (int*)(lds + 84672); int* LIST = (int*)(lds + 84800);
    const int tid = otid(), lane = tid & 63, w = tid >> 6, fr = lane & 15, fq = lane >> 4;
    int nit = 0;
    if (MODE == 1 && tid < 32) LCNT[tid] = 0;
    h16x8 Whi[NET][4], Wlo[NET][4];
#pragma unroll
    for (int et = 0; et < NET; ++et)
#pragma unroll
        for (int s4 = 0; s4 < 4; ++s4)
#pragma unroll
            for (int j = 0; j < 8; ++j) {
                const int k = 128 * w + 32 * s4 + 8 * fq + j, e = 16 * et + fr;
                float wv;
                if (MODE == 0) wv = (e < 8) ? p.in[5][(size_t)k * INC + INC_MAIN + e] : 0.f;
                else wv = p.in[12][(size_t)k * NE + e];
                wv *= 256.f;
                const h16 hi = (h16)wv; Whi[et][s4][j] = hi; Wlo[et][s4][j] = (h16)(wv - (float)hi);
            }
    f32x4 vn[2][4];
#define RP_LOAD(TILE) do { _Pragma("unroll") for (int rr_ = 0; rr_ < 2; ++rr_) { const size_t ro_ = (size_t)((TILE) * 16 + 2 * w + rr_) * D; \
        _Pragma("unroll") for (int j_ = 0; j_ < 4; ++j_) { if (MODE == 0) vn[rr_][j_] = *((const f32x4*)(xin + ro_) + lane + 64 * j_); \
            else { const h16x4 t_ = *((const h16x4*)(x1h + ro_) + lane + 64 * j_); vn[rr_][j_] = (f32x4){(float)t_[0], (float)t_[1], (float)t_[2], (float)t_[3]}; } } } } while (0)
    if ((int)blockIdx.x < T / 16) RP_LOAD(blockIdx.x);
    for (int tile = blockIdx.x; tile < T / 16; tile += gridDim.x) {
        f32x4 v[2][4]; float ss[2];
#pragma unroll
        for (int rr = 0; rr < 2; ++rr)
#pragma unroll
            for (int j = 0; j < 4; ++j) v[rr][j] = vn[rr][j];
        if (tile + (int)gridDim.x < T / 16) RP_LOAD(tile + gridDim.x);
#pragma unroll
        for (int rr = 0; rr < 2; ++rr) {
            float a = 0.f;
#pragma unroll
            for (int j = 0; j < 4; ++j) a += v[rr][j][0] * v[rr][j][0] + v[rr][j][1] * v[rr][j][1] + v[rr][j][2] * v[rr][j][2] + v[rr][j][3] * v[rr][j][3];
            ss[rr] = rsqrtf(wave_sum(a) * (1.f / D) + EPS);
        }
        {
            const int b = (tile * 16) / SEQ;
            const float* shift = mod + b * 6144 + (MODE == 0 ? 0 : 3072); const float* scale = shift + 1024;
#pragma unroll
            for (int j = 0; j < 4; ++j) {
                const int col = 256 * j + 4 * lane;
                const f32x4 w4 = *(const f32x4*)(nw + col), sc = *(const f32x4*)(scale + col), sh = *(const f32x4*)(shift + col);
#pragma unroll
                for (int rr = 0; rr < 2; ++rr) {
                    const int rl = 2 * w + rr;
                    h16x4 hi4, lo4;
                    float hvv[4];
#pragma unroll
                    for (int i = 0; i < 4; ++i) { const float hv = v[rr][j][i] * ss[rr] * w4[i] * (1.f + sc[i]) + sh[i]; hvv[i] = hv; const h16 hi = (h16)hv; hi4[i] = hi; lo4[i] = (h16)(hv - (float)hi); }
                    if (MODE == 0) *(h16x4*)(hout + (size_t)(tile * 16 + rl) * D + col) = hi4;
                    else ((unsigned*)(p.ws + WS_H16))[((size_t)(tile * 16 + rl) * D + col) >> 2] = pack_fp8x4(hvv[0] * FP8_SA, hvv[1] * FP8_SA, hvv[2] * FP8_SA, hvv[3] * FP8_SA);
                    *(h16x4*)(HI + rl * RS + col) = hi4;
                    *(h16x4*)(LO + rl * RS + col) = lo4;
                }
            }
        }
        __syncthreads();
        {
            f32x4 acc[NET];
#pragma unroll
            for (int et = 0; et < NET; ++et) acc[et] = (f32x4){0.f, 0.f, 0.f, 0.f};
#pragma unroll
            for (int s4 = 0; s4 < 4; ++s4) {
                const h16x8 bh = *(const h16x8*)(HI + fr * RS + 128 * w + 32 * s4 + 8 * fq);
                const h16x8 bl = *(const h16x8*)(LO + fr * RS + 128 * w + 32 * s4 + 8 * fq);
#pragma unroll
                for (int et = 0; et < NET; ++et) {
                    acc[et] = __builtin_amdgcn_mfma_f32_16x16x32_f16(Whi[et][s4], bh, acc[et], 0, 0, 0);
                    acc[et] = __builtin_amdgcn_mfma_f32_16x16x32_f16(Wlo[et][s4], bh, acc[et], 0, 0, 0);
                    acc[et] = __builtin_amdgcn_mfma_f32_16x16x32_f16(Whi[et][s4], bl, acc[et], 0, 0, 0);
                }
            }
#pragma unroll
            for (int et = 0; et < NET; ++et)
#pragma unroll
                for (int i = 0; i < 4; ++i) PART[(w * 32 + 16 * et + 4 * fq + i) * 16 + fr] = acc[et][i];
        }
        __syncthreads();
        if (tid < 16 * 16 * NET) {
            const int e = tid >> 4, rl = tid & 15; float a = 0.f;
#pragma unroll
            for (int q = 0; q < 8; ++q) a += PART[(q * 32 + e) * 16 + rl];
            a *= (1.f / 256.f);
            if (MODE == 0) { if (e < 8) ((float*)(p.ws + WS_BA))[(size_t)(tile * 16 + rl) * 8 + e] = a; }
            else LOGIT[rl * 33 + e] = a + p.in[13][e];
        }
        if (MODE == 1) {
            __syncthreads();
            {
                const int rl = 2 * w + (lane >> 5), e = lane & 31, row = tile * 16 + rl;
                float v = LOGIT[rl * 33 + e];
                float tv[4]; int te[4];
#pragma unroll
                for (int k = 0; k < 4; ++k) {
                    float bv = v; int bi = e;
#pragma unroll
                    for (int o = 1; o < 32; o <<= 1) { const float ov = __shfl_xor(bv, o); const int oi = __shfl_xor(bi, o); const bool take = (ov > bv) || (ov == bv && oi < bi); bv = take ? ov : bv; bi = take ? oi : bi; }
                    tv[k] = bv; te[k] = bi; if (e == bi) v = -INFINITY;
                }
                float ex[4]; float sum = 0.f;
#pragma unroll
                for (int k = 0; k < 4; ++k) { ex[k] = __expf(tv[k] - tv[0]); sum += ex[k]; }
                if (e < 4) {
                    const int ek = (e == 0) ? te[0] : (e == 1) ? te[1] : (e == 2) ? te[2] : te[3];
                    const float gk = ((e == 0) ? ex[0] : (e == 1) ? ex[1] : (e == 2) ? ex[2] : ex[3]) / sum;
                    const int lpos = atomicAdd(LCNT + ek, 1);
                    LIST[nit * 64 + rl * 4 + e] = (ek << 16) | lpos;
                    ((int*)(p.ws + WS_ASG_E))[row * 4 + e] = ek; ((float*)(p.ws + WS_ASG_G))[row * 4 + e] = gk;
                }
            }
        }
        ++nit;
    }
    if (MODE == 1) {
        __syncthreads();
        if (tid < 32) GB[tid] = atomicAdd((int*)(p.ws + WS_CTL) + tid, LCNT[tid]);
        __syncthreads();
        int* tok = (int*)(p.ws + WS_TOK); int* asg_p = (int*)(p.ws + WS_ASG_P);
        for (int idx = tid; idx < nit * 64; idx += NTHREADS) {
            const int pk = LIST[idx], e = pk >> 16, pos = GB[e] + (pk & 0xffff);
            const int row = (blockIdx.x + (idx >> 6) * gridDim.x) * 16 + ((idx & 63) >> 2);
            asg_p[row * 4 + (idx & 3)] = pos; tok[(size_t)e * T + pos] = row;
        }
    }
}

#define XB_TMO      128
#define XB_XCNT(j)  (256  + 64 * (j))
#define XB_XSUB(j)  (1280 + 64 * (j))
#define XB_XGEN(j)  (2304 + 64 * (j))
#define XB_TOP      3328
#define XB_TOPGEN   3392
#define XB_EXIT     3456
#define XCD_BAR_WORDS 3520
#define XB_SPIN_CAP (1u << 22)
__device__ __forceinline__ unsigned xb_ld(unsigned* p)              { return __hip_atomic_load(p, __ATOMIC_RELAXED, __HIP_MEMORY_SCOPE_AGENT); }
__device__ __forceinline__ unsigned xb_add(unsigned* p, unsigned v) { return __hip_atomic_fetch_add(p, v, __ATOMIC_RELAXED, __HIP_MEMORY_SCOPE_AGENT); }
__device__ __forceinline__ unsigned xb_xcc_id() { return (unsigned)__builtin_amdgcn_s_getreg((3 << 11) | 20) & 0xFu; }
#define XB_SPIN(cond, bar) do { unsigned _sp = 0; while (cond) { __builtin_amdgcn_s_sleep(1); \
    if ((++_sp & 255u) == 0u) { if (xb_ld(&(bar)[XB_TMO])) break; if (_sp > XB_SPIN_CAP) { atomicAdd(&(bar)[XB_TMO], 1u); break; } } } } while (0)
__device__ unsigned g_xbar[XCD_BAR_WORDS];
__device__ __forceinline__ void xcd_barrier_retire(unsigned* bar) {
    const unsigned old = xb_add(&bar[XB_EXIT], 1u);
    if (old + 1u == gridDim.x * gridDim.y * gridDim.z) {
        __hip_atomic_store(&bar[XB_TMO], 0u, __ATOMIC_RELAXED, __HIP_MEMORY_SCOPE_AGENT);
        for (unsigned j = 0; j < 16; ++j) { __hip_atomic_store(&bar[XB_XCNT(j)], 0u, __ATOMIC_RELAXED, __HIP_MEMORY_SCOPE_AGENT); __hip_atomic_store(&bar[XB_XSUB(j)], 0u, __ATOMIC_RELAXED, __HIP_MEMORY_SCOPE_AGENT);
            __hip_atomic_store(&bar[XB_XGEN(j)], 0u, __ATOMIC_RELAXED, __HIP_MEMORY_SCOPE_AGENT); }
        __hip_atomic_store(&bar[XB_TOP], 0u, __ATOMIC_RELAXED, __HIP_MEMORY_SCOPE_AGENT); __hip_atomic_store(&bar[XB_TOPGEN], 0u, __ATOMIC_RELAXED, __HIP_MEMORY_SCOPE_AGENT);
        __hip_atomic_store(&bar[XB_EXIT], 0u, __ATOMIC_RELAXED, __HIP_MEMORY_SCOPE_AGENT);
    }
}
struct XcdBarrier { unsigned* bar; unsigned x; volatile __attribute__((address_space(3))) unsigned* st; };
__device__ __forceinline__ XcdBarrier xcd_barrier_post(unsigned* bar, volatile __attribute__((address_space(3))) unsigned* st) {
    XcdBarrier b; b.bar = bar; b.x = xb_xcc_id(); b.st = st;
    if (threadIdx.x == 0) (void)xb_add(&bar[XB_XCNT(b.x)], 1u);
    return b;
}
__device__ __forceinline__ void xcd_barrier_complete(unsigned* bar, unsigned x, unsigned& nloc, unsigned& nx) {
    const unsigned G = gridDim.x * gridDim.y * gridDim.z;
    unsigned sum, cnt, mine, sp = 0u;
    for (;;) {
        sum = 0u; cnt = 0u; mine = 0u;
#pragma unroll
        for (unsigned j = 0; j < 16; ++j) { const unsigned c = xb_ld(&bar[XB_XCNT(j)]); sum += c; cnt += (c > 0u) ? 1u : 0u; mine = (j == x) ? c : mine; }
        if (sum == G) break;
        __builtin_amdgcn_s_sleep(1);
        if ((++sp & 255u) == 0u) { if (xb_ld(&bar[XB_TMO])) break; if (sp > XB_SPIN_CAP) { atomicAdd(&bar[XB_TMO], 1u); break; } }
    }
    nloc = mine > 0u ? mine : 1u; nx = cnt > 0u ? cnt : 1u;
}
__device__ __forceinline__ void xcd_barrier(const XcdBarrier& b) {
    asm volatile("s_waitcnt vmcnt(0)" ::: "memory");
    __syncthreads();
    if (threadIdx.x == 0) {
        unsigned* bar = b.bar;
        __builtin_amdgcn_s_waitcnt(0);
        unsigned nloc = b.st[0], nx = b.st[1];
        if (nloc == 0u) { xcd_barrier_complete(bar, b.x, nloc, nx); b.st[0] = nloc; b.st[1] = nx; }
        const unsigned old = xb_add(&bar[XB_XSUB(b.x)], 1u);
        const unsigned gen = old / nloc;
        if (old + 1u == (gen + 1u) * nloc) {
            __builtin_amdgcn_fence(__ATOMIC_RELEASE, "agent");
            asm volatile("s_waitcnt vmcnt(0)" ::: "memory");
            const unsigned og = xb_add(&bar[XB_TOP], 1u);
            const unsigned tg = og / nx;
            if (og + 1u == (tg + 1u) * nx) xb_add(&bar[XB_TOPGEN], 1u);
            else XB_SPIN(xb_ld(&bar[XB_TOPGEN]) == tg, bar);
            __builtin_amdgcn_fence(__ATOMIC_ACQUIRE, "agent");
            xb_add(&bar[XB_XGEN(b.x)], 1u);
            asm volatile("s_waitcnt vmcnt(0)" ::: "memory");
        } else {
            XB_SPIN(xb_ld(&bar[XB_XGEN(b.x)]) == gen, bar);
            __builtin_amdgcn_fence(__ATOMIC_ACQUIRE, "agent");
            asm volatile("s_waitcnt vmcnt(0)" ::: "memory");
        }
    }
    __syncthreads();
}

__global__ void __launch_bounds__(NTHREADS) fwd_megakernel(Params p) {
    extern __shared__ __attribute__((aligned(16))) unsigned char lds_raw[];
    float* lds = (float*)lds_raw;
    volatile LAS3 unsigned* misc = (volatile LAS3 unsigned*)((LAS3 unsigned char*)lds_raw + LDS_MISC);
    if (threadIdx.x < 2) misc[threadIdx.x] = 0u;
    __syncthreads();
    const XcdBarrier gbar = xcd_barrier_post(g_xbar, misc);
#define GSYNC() xcd_barrier(gbar)
    LAS3 unsigned char* l3 = (LAS3 unsigned char*)lds_raw;
#define REPS(k) for (int rep_ = 0; rep_ < ((PROBE == (k)) ? 2 : 1); ++rep_)
    REPS(1) { phase_mod(p, lds); phase_cvt(p, lds, 0, blockIdx.x, gridDim.x); GSYNC(); }
    REPS(2) { phase_rowproj<0>(p, lds_raw); GSYNC(); }
    REPS(3) { phase_inproj_m(p, l3); GSYNC(); }
    REPS(5) { phase_dnchunk2(p, lds_raw); GSYNC(); }
    for (int rep_ = 0; rep_ < ((PROBE == 6 || (PROBE >= 61 && PROBE <= 64)) ? 2 : 1); ++rep_) {
        const int nscan = 2 * NB * DH;
        if (gridDim.x >= 2 * nscan) {
            if (blockIdx.x < nscan) { if (!((PROBE == 62 || PROBE == 63 || PROBE == 64) && rep_)) phase_scan_mfma(p, lds_raw, ((blockIdx.x >> 4) << 3) + (blockIdx.x & 7), (blockIdx.x >> 3) & 1); }
            else if (!(PROBE == 61 && rep_)) {
                const bool cvt_first = ((blockIdx.x >> 3) & 1) != 0;
                if (cvt_first) { if (!(PROBE == 64 && rep_)) phase_cvt(p, lds, 1, blockIdx.x - nscan, gridDim.x - nscan); __syncthreads(); }
                if (!(PROBE == 63 && rep_)) phase_attn_mfma(p, lds_raw, blockIdx.x - nscan, gridDim.x - nscan);
                if (!cvt_first) { __syncthreads(); if (!(PROBE == 64 && rep_)) phase_cvt(p, lds, 1, blockIdx.x - nscan, gridDim.x - nscan); }
            }
        } else {
            for (int sb = blockIdx.x; sb < nscan; sb += gridDim.x) phase_scan_mfma(p, lds_raw, sb >> 1, sb & 1);
            phase_attn_mfma(p, lds_raw, blockIdx.x, gridDim.x); __syncthreads(); phase_cvt(p, lds, 1, blockIdx.x, gridDim.x);
        }
        GSYNC();
    }
    REPS(7) { phase_dnout(p); GSYNC(); }
    REPS(8) { phase_outproj_m(p, l3); GSYNC(); }
    REPS(9) {
        if (rep_) { if (blockIdx.x == 0 && threadIdx.x < 64) ((int*)(p.ws + WS_CTL))[threadIdx.x] = 0; GSYNC(); }
        phase_rowproj<1>(p, lds_raw); GSYNC();
    }
    REPS(10) { phase_moe1_m(p, l3); GSYNC(); }
    REPS(11) { phase_moe2_m(p, l3); GSYNC(); }
    REPS(12) { phase_final(p, lds); if (PROBE == 12) GSYNC(); }
    if (threadIdx.x == 0) xcd_barrier_retire(g_xbar);
}

extern "C" void kernel_launch(void* const* d_in, const int* in_sizes, int n_in, void* d_out, int out_size, void* d_ws, size_t ws_size, hipStream_t stream) {
    static int grid_blocks = 0;
    if (grid_blocks == 0) {
        if (n_in != 19 || out_size != T * D || ws_size < WS_END) { fprintf(stderr, "kernel_launch: unexpected shapes (n_in %d out %d ws %zu)\n", n_in, out_size, ws_size); grid_blocks = -1; return; }
        int dev = 0, cus = 0, per_cu = 0;
        hipGetDevice(&dev);
        hipDeviceGetAttribute(&cus, hipDeviceAttributeMultiprocessorCount, dev);
        hipFuncSetAttribute((const void*)fwd_megakernel, hipFuncAttributeMaxDynamicSharedMemorySize, LDS_BYTES);
        hipOccupancyMaxActiveBlocksPerMultiprocessor(&per_cu, (const void*)fwd_megakernel, NTHREADS, LDS_BYTES);
        if (per_cu < 1) { fprintf(stderr, "kernel_launch: occupancy query says %d blocks/CU\n", per_cu); grid_blocks = -1; return; }
        grid_blocks = cus;
    }
    if (grid_blocks < 0) return;
    Params p{};
    for (int i = 0; i < 19; ++i) p.in[i] = (const float*)d_in[i];
    p.out = (float*)d_out; p.ws = (unsigned char*)d_ws;
    hipLaunchKernelGGL(fwd_megakernel, dim3(grid_blocks), dim3(NTHREADS), LDS_BYTES, stream, p);
    const hipError_t e = hipPeekAtLastError();
    if (e != hipSuccess) fprintf(stderr, "launch failed: %s (grid %d)\n", hipGetErrorString(e), grid_blocks);
}
```

```cpp
#define PROBE 0
#include <hip/hip_runtime.h>
#include <hip/hip_cooperative_groups.h>
#include <cstdio>
#include <cstdint>
namespace cg = cooperative_groups;

typedef _Float16 h16;
typedef _Float16 h16x2 __attribute__((ext_vector_type(2)));
typedef _Float16 h16x4 __attribute__((ext_vector_type(4)));
typedef _Float16 h16x8 __attribute__((ext_vector_type(8)));
typedef float f32x4 __attribute__((ext_vector_type(4)));
typedef float f32x2 __attribute__((ext_vector_type(2)));
typedef float f32x16 __attribute__((ext_vector_type(16)));
typedef unsigned u32x4 __attribute__((ext_vector_type(4)));
typedef unsigned u32x2_t __attribute__((ext_vector_type(2)));

constexpr int D = 1024, NB = 4, SEQ = 8192, T = NB * SEQ;
constexpr int AH = 8, AHD = 64, AW = 512;
constexpr int DH = 4, DKD = 128, DW = 512, DCONV = 1536;
constexpr int INC = 3592, INC_MAIN = 3584;
constexpr int NE = 32, TOPK = 4, FE = 1024;
constexpr int NASG = T * TOPK;
constexpr float EPS = 1e-6f;
constexpr int NTHREADS = 512, NWAVES = 8;

constexpr size_t MiB = (size_t)1 << 20;
constexpr size_t WS_CTL = 0;
constexpr int CW_BAR = 4096; constexpr size_t CTL_ZERO_BYTES = 65536;
constexpr size_t WS_MOD = 1 * MiB;
constexpr size_t WS_BA = 2 * MiB;
constexpr size_t WS_G = 3 * MiB;
constexpr size_t WS_ASG_E = 4 * MiB;
constexpr size_t WS_ASG_P = 4 * MiB + 512 * 1024;
constexpr size_t WS_ASG_G = 5 * MiB;
constexpr size_t WS_TOK = 6 * MiB;
constexpr size_t WS_WIN16 = 16 * MiB;
constexpr size_t WS_WOUT16 = 24 * MiB;
constexpr size_t WS_W116 = 32 * MiB;
constexpr size_t WS_W216 = 160 * MiB;
constexpr size_t WS_H16 = 224 * MiB;
constexpr size_t WS_X1 = 288 * MiB;
constexpr size_t WS_R = 416 * MiB;
constexpr size_t WS_Q16 = WS_R;
constexpr size_t WS_K16 = WS_R + 32 * MiB;
constexpr size_t WS_V16 = WS_R + 64 * MiB;
constexpr size_t WS_DQKV = WS_R + 96 * MiB;
constexpr size_t WS_Z16 = WS_R + 192 * MiB;
constexpr size_t WS_QN = WS_R + 224 * MiB;
constexpr size_t WS_KN = WS_R + 256 * MiB;
constexpr size_t WS_VV = WS_R + 288 * MiB;
constexpr size_t WS_O32 = WS_R + 320 * MiB;
constexpr size_t WS_MIX = WS_R + 384 * MiB;
constexpr size_t WS_ACT = WS_R;
constexpr float FP8_SY = 32.f;
constexpr size_t WS_Y16 = WS_R + 272 * MiB;
constexpr size_t WS_AO = WS_DQKV;
constexpr size_t WS_LSE = WS_QN;
constexpr size_t WS_DNREC = WS_R + 448 * MiB;
constexpr size_t WS_END = WS_R + 592 * MiB;

constexpr int LDS_STAGE = 131072, LDS_TAB = LDS_STAGE, LDS_GTAB = LDS_STAGE + 1024, GTAB_UNITS = 18;
constexpr int LDS_MISC = LDS_GTAB + GTAB_UNITS * 256 * 4;
constexpr int LDS_BYTES = LDS_MISC + 256;
struct Params { const float* in[19]; float* out; unsigned char* ws; };

__device__ __forceinline__ float wave_sum(float v) {
#pragma unroll
    for (int o = 1; o < 64; o <<= 1) v += __shfl_xor(v, o);
    return v;
}
__device__ __forceinline__ float wave_max(float v) {
#pragma unroll
    for (int o = 1; o < 64; o <<= 1) v = fmaxf(v, __shfl_xor(v, o));
    return v;
}
__device__ __forceinline__ int otid() { int t = threadIdx.x; asm volatile("" : "+v"(t)); return t; }
__device__ __forceinline__ unsigned pk_bf16(float lo, float hi) { unsigned r; asm("v_cvt_pk_bf16_f32 %0, %1, %2" : "=v"(r) : "v"(lo), "v"(hi)); return r; }
__device__ __forceinline__ float silu_f(float v) { return v * __builtin_amdgcn_rcpf(1.f + __expf(-v)); }
__device__ __forceinline__ float sigmoid_f(float v) { return __builtin_amdgcn_rcpf(1.f + __expf(-v)); }


namespace pg8 {
#define PG8_LAS __attribute__((address_space(3)))
constexpr int BM = 256, BK = 64, HALF = 128, HTB = HALF * BK * 2, STAGE_BYTES = 8 * HTB, NXCD = 8, WGM = 4;
__device__ __forceinline__ int lds_byte(int r, int c) { const int st = (r >> 4) * 2 + (c >> 5), rr = r & 15, cc = c & 31, ob = rr * 64 + cc * 2; return st * 1024 + (ob ^ (((ob >> 9) & 1) << 5)); }
__device__ __forceinline__ void stage_rc(int b, int& R, int& C) { const int st = b / 1024, sb = b % 1024, swz = sb ^ (((sb >> 9) & 1) << 5); R = (st >> 1) * 16 + swz / 64; C = (st & 1) * 32 + (swz % 64) / 2; }
__device__ __forceinline__ int perm32(int rho) { const int n = rho >> 4, i = rho & 15; return 8 * (i >> 2) + 4 * n + (i & 3); }

struct Unit { int pm, pn, e; };
struct Gemm { const h16* A; const h16* Bt; int N, K; };

struct Order {
    int nM, nN, nwg, G, c; PG8_LAS const int* tstart;
    __device__ __forceinline__ void init(int nM_, int nN_, int G_, int c_, PG8_LAS const int* ts) { nM = nM_; nN = nN_; nwg = nM * nN; G = G_; c = c_; tstart = ts; }
    __device__ __forceinline__ bool next(int i, Unit& u) const {
        const long L = (long)i * G + c; if (L >= nwg) return false;
        int wgid = (int)L; { const int q = nwg / NXCD, r = nwg % NXCD, xcd = wgid % NXCD, off = wgid / NXCD; wgid = (xcd < r ? xcd * (q + 1) : r * (q + 1) + (xcd - r) * q) + off; }
        const int nig = WGM * nN, gid = wgid / nig, fm = gid * WGM, gsz = (nM - fm) < WGM ? (nM - fm) : WGM;
        u.pm = fm + ((wgid % nig) % gsz); u.pn = (wgid % nig) / gsz;
        int e = 0;
        if (tstart) { for (int q = 1; q < 32; ++q) if (tstart[q] <= u.pm) e = q; }
        u.e = e; return true;
    }
};

typedef __bf16 bf16x8_t __attribute__((ext_vector_type(8)));
typedef long l64x2_t __attribute__((ext_vector_type(2)));
typedef int v8i32 __attribute__((ext_vector_type(8)));
typedef int v4i32 __attribute__((ext_vector_type(4)));
#define PG8_CAT8(a, b) __builtin_shufflevector(__builtin_bit_cast(v4i32, a), __builtin_bit_cast(v4i32, b), 0, 1, 2, 3, 4, 5, 6, 7)
template <class Epi, bool GATHER, int EM = 0>
__device__ __forceinline__ void gemm_phase(PG8_LAS unsigned char* lds, const Gemm g, const Order& S, const Epi& E, PG8_LAS const int* gtab) {
    const int tid = otid(), wid = __builtin_amdgcn_readfirstlane(tid >> 6), lane = tid & 63, wr = wid >> 2, wc = wid & 3, fr = lane & 15, fq = lane >> 4;
    constexpr bool BF16 = (EM == 1); constexpr int ES = (EM >= 2) ? 1 : 2;
    const int K = g.K, nt = (K * ES) / (BK * 2);
    unsigned voffB[2]; int RA[2]; unsigned CA2[2];
#pragma unroll
    for (int i = 0; i < 2; ++i) { int R, C; stage_rc(tid * 16 + i * 8192, R, C); const int Rb = Epi::PERM ? ((R & ~31) + perm32(R & 31)) : R;
        RA[i] = R; CA2[i] = (unsigned)C * 2u; voffB[i] = (unsigned)(Rb * K) * (unsigned)ES + (unsigned)C * 2u; }
    const size_t kstep = (size_t)(BK * 2);
    const size_t hstep = (size_t)HALF * K * ES;
    const size_t tstep = 2 * hstep;
    const unsigned ldsw = (unsigned)wid * 1024u;
    const int aoff = lds_byte(wr * 64 + fr, fq * 8), boff = lds_byte(wc * 32 + fr, fq * 8);
#define PG8_SA(b, h) (((b) * 2 + (h)) * HTB)
#define PG8_SB(b, h) ((4 + (b) * 2 + (h)) * HTB)
#define PG8_STAGE(bufoff, gbase, voff) do { _Pragma("unroll") for (int _i = 0; _i < 2; ++_i) \
        __builtin_amdgcn_global_load_lds((const unsigned*)((const char*)(gbase) + (voff)[_i]), (PG8_LAS unsigned*)(lds + (bufoff) + ldsw + _i * 8192), 16, 0, 0); } while (0)
#define PG8_LDA(dst, b, h) do { _Pragma("unroll") for (int m = 0; m < 4; ++m) _Pragma("unroll") for (int k = 0; k < 2; ++k) dst[m][k] = *(const PG8_LAS h16x8*)(lds + PG8_SA(b, h) + aoff + m * 2048 + k * 1024); } while (0)
#define PG8_LDB(dst, b, h) do { _Pragma("unroll") for (int n = 0; n < 2; ++n) _Pragma("unroll") for (int k = 0; k < 2; ++k) dst[n][k] = *(const PG8_LAS h16x8*)(lds + PG8_SB(b, h) + boff + n * 2048 + k * 1024); } while (0)
#define PG8_MMA(ai, bj, At, Bt) do { __builtin_amdgcn_s_setprio(1); _Pragma("unroll") for (int m = 0; m < 4; ++m) _Pragma("unroll") for (int n = 0; n < 2; ++n) { if constexpr (EM == 3) { \
        { const v8i32 a8_ = PG8_CAT8(Bt[n][0], Bt[n][1]), b8_ = PG8_CAT8(At[m][0], At[m][1]); asm volatile("v_mfma_scale_f32_16x16x128_f8f6f4 %0, %1, %2, %0, %3, %3 op_sel_hi:[0,0,0]" : "+v"(acc[ai][bj][m][n]) : "v"(a8_), "v"(b8_), "v"(sc1)); } } else \
        _Pragma("unroll") for (int k = 0; k < 2; ++k) \
        { if constexpr (EM == 2) { const l64x2_t a_ = __builtin_bit_cast(l64x2_t, Bt[n][k]), b_ = __builtin_bit_cast(l64x2_t, At[m][k]); \
              acc[ai][bj][m][n] = __builtin_amdgcn_mfma_f32_16x16x32_fp8_fp8(a_[0], b_[0], acc[ai][bj][m][n], 0, 0, 0); acc[ai][bj][m][n] = __builtin_amdgcn_mfma_f32_16x16x32_fp8_fp8(a_[1], b_[1], acc[ai][bj][m][n], 0, 0, 0); } \
          else if constexpr (BF16) acc[ai][bj][m][n] = __builtin_amdgcn_mfma_f32_16x16x32_bf16(__builtin_bit_cast(bf16x8_t, Bt[n][k]), __builtin_bit_cast(bf16x8_t, At[m][k]), acc[ai][bj][m][n], 0, 0, 0); \
          else acc[ai][bj][m][n] = __builtin_amdgcn_mfma_f32_16x16x32_f16(Bt[n][k], At[m][k], acc[ai][bj][m][n], 0, 0, 0); } } __builtin_amdgcn_s_setprio(0); } while (0)
#define PG8_WAIT_V(n) asm volatile("s_waitcnt vmcnt(" #n ")" ::: "memory")
#define PG8_WAIT_L(n) asm volatile("s_waitcnt lgkmcnt(" #n ")" ::: "memory")
#define PG8_BAR __builtin_amdgcn_s_barrier()
#define PG8_SCHED __builtin_amdgcn_sched_barrier(0)
#define PG8_AOFF(o, u, uix) do { _Pragma("unroll") for (int _h = 0; _h < 2; ++_h) _Pragma("unroll") for (int _i = 0; _i < 2; ++_i) { \
        const int _r = _h * HALF + RA[_i]; const unsigned _src = GATHER ? (unsigned)gtab[(uix) * BM + _r] : (unsigned)((u).pm * BM + _r); \
        o[_h][_i] = _src * (unsigned)(K * ES) + CA2[_i]; } } while (0)
    Unit cur, nxt; int ui = 0;
    if (!S.next(0, cur)) return;
    int sc1 = 0x7F7F7F7F; asm volatile("" : "+v"(sc1));
    f32x4 acc[2][2][4][2];
#pragma unroll
    for (int a = 0; a < 2; ++a)
#pragma unroll
        for (int b = 0; b < 2; ++b)
#pragma unroll
            for (int m = 0; m < 4; ++m)
#pragma unroll
                for (int n = 0; n < 2; ++n) acc[a][b][m][n] = (f32x4){0.f, 0.f, 0.f, 0.f};
    h16x8 At[4][2], B0[2][2], B1[2][2];
    unsigned oc[2][2], on[2][2];
    PG8_AOFF(oc, cur, 0);
    const char* const A0 = (const char*)g.A;
    const char* cB = (const char*)g.Bt + ((size_t)cur.e * g.N + (size_t)cur.pn * BM) * K * ES;
    PG8_STAGE(PG8_SB(0, 0), cB, voffB); PG8_STAGE(PG8_SB(0, 1), cB + hstep, voffB); PG8_STAGE(PG8_SA(0, 0), A0, oc[0]); PG8_STAGE(PG8_SA(0, 1), A0, oc[1]);
    if (wr == 1) PG8_BAR;
    PG8_WAIT_V(2); PG8_BAR;
    PG8_STAGE(PG8_SB(1, 0), cB + kstep, voffB); PG8_STAGE(PG8_SA(1, 0), A0 + kstep, oc[0]); PG8_STAGE(PG8_SB(1, 1), cB + hstep + kstep, voffB);
    PG8_WAIT_V(6); PG8_BAR;
    for (;;) {
        const bool has_next = S.next(ui + 1, nxt);
        const char* nB = cB;
        if (has_next) { nB = (const char*)g.Bt + ((size_t)nxt.e * g.N + (size_t)nxt.pn * BM) * K * ES; PG8_AOFF(on, nxt, ui + 1); }
        else {
#pragma unroll
            for (int h = 0; h < 2; ++h)
#pragma unroll
                for (int i = 0; i < 2; ++i) on[h][i] = oc[h][i];
        }
#pragma unroll 1
        for (int t = 0; t < nt; t += 2) {
            const bool last = (t == nt - 2);
            const char* a1 = A0 + (size_t)(t + 1) * kstep;
            const char* a2 = last ? A0 : A0 + (size_t)(t + 2) * kstep; const char* b2 = last ? nB : cB + (size_t)(t + 2) * kstep;
            const char* a3 = a2 + kstep; const char* b3 = b2 + kstep;
            unsigned o2[2][2];
#pragma unroll
            for (int h = 0; h < 2; ++h)
#pragma unroll
                for (int i = 0; i < 2; ++i) o2[h][i] = last ? on[h][i] : oc[h][i];
            PG8_LDB(B0, 0, 0); PG8_LDB(B1, 0, 1); PG8_SCHED; PG8_LDA(At, 0, 0); PG8_STAGE(PG8_SA(1, 1), a1, oc[1]);
            PG8_WAIT_V(8); PG8_WAIT_L(0); PG8_BAR; PG8_MMA(0, 0, At, B0); PG8_MMA(0, 1, At, B1); PG8_BAR; PG8_SCHED;
            PG8_LDA(At, 0, 1); PG8_STAGE(PG8_SB(0, 0), b2, voffB); PG8_STAGE(PG8_SB(0, 1), b2 + hstep, voffB); PG8_STAGE(PG8_SA(0, 0), a2, o2[0]);
            PG8_WAIT_V(8); PG8_WAIT_L(0); PG8_BAR; PG8_MMA(1, 0, At, B0); PG8_MMA(1, 1, At, B1); PG8_BAR; PG8_SCHED;
            PG8_LDB(B0, 1, 0); PG8_LDB(B1, 1, 1); PG8_SCHED; PG8_LDA(At, 1, 0); PG8_STAGE(PG8_SA(0, 1), a2, o2[1]);
            PG8_WAIT_V(8); PG8_WAIT_L(0); PG8_BAR; PG8_MMA(0, 0, At, B0); PG8_MMA(0, 1, At, B1); PG8_BAR; PG8_SCHED;
            PG8_LDA(At, 1, 1); PG8_STAGE(PG8_SB(1, 0), b3, voffB); PG8_STAGE(PG8_SB(1, 1), b3 + hstep, voffB); PG8_STAGE(PG8_SA(1, 0), a3, o2[0]);
            PG8_WAIT_V(8); PG8_WAIT_L(0); PG8_BAR; PG8_MMA(1, 0, At, B0); PG8_MMA(1, 1, At, B1); PG8_BAR; PG8_SCHED;
        }
        if (wr == 0) PG8_BAR;
        if constexpr (EM == 3) asm volatile("s_nop 15\n\ts_nop 15" ::: "memory");
        E(acc, cur, wr, wc, fr, fq);
        if (!has_next) break;
#pragma unroll
        for (int a = 0; a < 2; ++a)
#pragma unroll
            for (int b = 0; b < 2; ++b)
#pragma unroll
                for (int m = 0; m < 4; ++m)
#pragma unroll
                    for (int n = 0; n < 2; ++n) acc[a][b][m][n] = (f32x4){0.f, 0.f, 0.f, 0.f};
        cur = nxt; cB = nB; ++ui;
#pragma unroll
        for (int h = 0; h < 2; ++h)
#pragma unroll
            for (int i = 0; i < 2; ++i) oc[h][i] = on[h][i];
        if (wr == 1) PG8_BAR;
    }
    PG8_WAIT_V(0);
    PG8_BAR;
#undef PG8_SA
#undef PG8_SB
#undef PG8_STAGE
#undef PG8_LDA
#undef PG8_LDB
#undef PG8_MMA
#undef PG8_WAIT_V
#undef PG8_WAIT_L
#undef PG8_BAR
#undef PG8_SCHED
#undef PG8_AOFF
}
}

__device__ __forceinline__ void phase_mod(const Params& p, float* lds) {
    const float* c = p.in[1]; const float* w = p.in[2]; const float* bias = p.in[3];
    float* mod = (float*)(p.ws + WS_MOD);
    const int tid = otid();
    for (int i = tid; i < 4096; i += NTHREADS) lds[i] = silu_f(c[i]);
    __syncthreads();
    float* red = lds + 4096;
    for (int cb = blockIdx.x; cb < 192; cb += gridDim.x) {
        const int cc = tid & 31, col = cb * 32 + cc, ks = tid >> 5;
        float a0 = 0.f, a1 = 0.f, a2 = 0.f, a3 = 0.f;
#pragma unroll 16
        for (int k = ks * 64; k < ks * 64 + 64; ++k) {
            const float wv = w[(size_t)k * 6144 + col];
            a0 += lds[k] * wv; a1 += lds[1024 + k] * wv; a2 += lds[2048 + k] * wv; a3 += lds[3072 + k] * wv;
        }
        red[(ks * 4 + 0) * 32 + cc] = a0; red[(ks * 4 + 1) * 32 + cc] = a1; red[(ks * 4 + 2) * 32 + cc] = a2; red[(ks * 4 + 3) * 32 + cc] = a3;
        __syncthreads();
        if (tid < 128) {
            const int b = tid >> 5; float s = 0.f;
            for (int q = 0; q < 16; ++q) s += red[(q * 4 + b) * 32 + cc];
            mod[b * 6144 + col] = s + bias[col];
        }
        __syncthreads();
    }
    if (blockIdx.x == 0 && tid < 64) ((int*)(p.ws + WS_CTL))[tid] = 0;
}

constexpr int DN_REC = 73728, DN_NW = 0, DN_QD = 16384, DN_KD = 32768, DN_IN = 49152, DN_U = 57344, DN_GL = 51200;
template <int NS, int PLO, int PHI>
__device__ __forceinline__ void dn_conv_rows(const h16* dqkv, const float* cw, size_t t0, int n, int hd, int r, int c8, h16* QS, h16* KS, h16* VS) {
#pragma unroll 1
    for (int part = PLO; part < PHI; ++part) {
        h16x8 xr[NS][4][2];
#pragma unroll
        for (int q = 0; q < NS; ++q)
#pragma unroll
            for (int j = 0; j < 4; ++j) {
                const int rr = r + 32 * q; const bool ok = (n * 64 + rr - 3 + j >= 0);
                const h16* rowp = dqkv + (t0 + rr - (ok ? 3 - j : 0)) * DCONV + part * 512 + hd * 128 + c8 * 16;
                const h16x8 x0 = *(const h16x8*)rowp, x1 = *(const h16x8*)(rowp + 8);
#pragma unroll
                for (int i = 0; i < 8; ++i) { xr[q][j][0][i] = ok ? x0[i] : (h16)0.f; xr[q][j][1][i] = ok ? x1[i] : (h16)0.f; }
            }
#pragma unroll
        for (int q = 0; q < NS; ++q) {
            float acc[16];
#pragma unroll
            for (int i = 0; i < 16; ++i) acc[i] = 0.f;
#pragma unroll
            for (int j = 0; j < 4; ++j) {
                const float* wp = cw + hd * 1536 + j * 384 + part * 128 + c8 * 16;
#pragma unroll
                for (int i4 = 0; i4 < 2; ++i4) { const f32x4 wa = *(const f32x4*)(wp + 4 * i4), wb = *(const f32x4*)(wp + 8 + 4 * i4);
#pragma unroll
                    for (int i = 0; i < 4; ++i) { acc[4 * i4 + i] += (float)xr[q][j][0][4 * i4 + i] * wa[i]; acc[8 + 4 * i4 + i] += (float)xr[q][j][1][4 * i4 + i] * wb[i]; } }
            }
            float ssq = 0.f;
#pragma unroll
            for (int i = 0; i < 16; ++i) { acc[i] = silu_f(acc[i]); ssq += acc[i] * acc[i]; }
            float sc = 1.f;
            if (part < 2) { ssq += __shfl_xor(ssq, 1); ssq += __shfl_xor(ssq, 2); ssq += __shfl_xor(ssq, 4); sc = rsqrtf(ssq + EPS) * (part == 0 ? 0.08838834764831845f : 1.f); }
            h16x8 o0, o1;
#pragma unroll
            for (int i = 0; i < 8; ++i) { o0[i] = (h16)(acc[i] * sc); o1[i] = (h16)(acc[8 + i] * sc); }
            h16* dst = (part == 0 ? QS : (part == 1 ? KS : VS)) + (r + 32 * q) * 136 + c8 * 16;
            *(h16x8*)dst = o0; *(h16x8*)(dst + 8) = o1;
        }
    }
}
__device__ __forceinline__ void dn_gates(const float* ba, const float* A_log, const float* dt_bias, size_t t0, int hd, int lane, float* GC, float* EG, float* BT) {
    const float dbv = ba[(t0 + lane) * 8 + hd], dav = ba[(t0 + lane) * 8 + 4 + hd];
    const float xsp = dav + dt_bias[hd];
    const float sp = (xsp > 20.f) ? xsp : log1pf(__expf(xsp));
    float x = -__expf(A_log[hd]) * sp;
#pragma unroll
    for (int o = 1; o < 64; o <<= 1) { const float y = __shfl_up(x, o); if (lane >= o) x += y; }
    GC[lane] = x; EG[lane] = __expf(x); BT[lane] = sigmoid_f(dbv);
    GC[192 + lane] = __expf(__shfl(x, 63) - x);
}
__device__ __forceinline__ void phase_dnchunk2(const Params& p, unsigned char* lds) {
    const h16* dqkv = (const h16*)(p.ws + WS_DQKV); const float* ba = (const float*)(p.ws + WS_BA);
    const float* A_log = p.in[7]; const float* dt_bias = p.in[8];
    h16* QS = (h16*)lds; h16* KS = (h16*)(lds + 17408); h16* VS = (h16*)(lds + 34816);
    float* KKA = (float*)(lds + 52224); float* QKA = (float*)(lds + 69632);
    h16* UL = (h16*)(lds + 87040); h16* WL = (h16*)(lds + 104448);
    float* GC = (float*)(lds + 121856); float* BT = GC + 64; float* EG = GC + 128;
    const int tid0 = otid(), wave = __builtin_amdgcn_readfirstlane(tid0 >> 6);
    constexpr int NITEM = NB * DH * (SEQ / 64);
    float* CWS = (float*)(lds + 122880);
    { const float* cwg = p.in[6];
      for (int i = tid0; i < 4 * 1536; i += NTHREADS) { const int hq = i / 1536, q = i % 1536, j = q / 384, c = q % 384; CWS[i] = cwg[j * DCONV + (c >> 7) * 512 + hq * 128 + (c & 127)]; }
      __syncthreads(); }
    const float* cw = CWS;
    if ((int)blockIdx.x < NITEM) {
        const int item = blockIdx.x, bh = item >> 7, n = item & 127; const size_t t0 = (size_t)(bh >> 2) * SEQ + n * 64;
        dn_conv_rows<1, 0, 3>(dqkv, cw, t0, n, bh & 3, tid0 >> 3, tid0 & 7, QS, KS, VS);
        if (wave == 0) dn_gates(ba, A_log, dt_bias, t0, bh & 3, tid0 & 63, GC, EG, BT);
    }
    __syncthreads();
    for (int item = blockIdx.x; item < NITEM; item += gridDim.x) {
        int tid = tid0; asm volatile("" : "+v"(tid));
        const int lane = tid & 63;
        unsigned char* rec = p.ws + WS_DNREC + (size_t)item * DN_REC;
        if (wave < 6) {
            const int kind = wave / 3, tl = wave - 3 * kind, I = (tl >= 1) ? 1 : 0, J = (tl == 2) ? 1 : 0, r32 = lane & 31, hh = lane >> 5;
            const h16* Ar = (kind == 0 ? KS : QS) + (32 * I + r32) * 136 + 8 * hh; const h16* Br = KS + (32 * J + r32) * 136 + 8 * hh;
            f32x16 acc;
#pragma unroll
            for (int i = 0; i < 16; ++i) acc[i] = 0.f;
#pragma unroll
            for (int s8 = 0; s8 < 8; ++s8) acc = __builtin_amdgcn_mfma_f32_32x32x16_f16(*(const h16x8*)(Ar + 16 * s8), *(const h16x8*)(Br + 16 * s8), acc, 0, 0, 0);
            const int j = 32 * J + r32; const float gj = GC[j];
            if (kind == 0) {
#pragma unroll
                for (int g4 = 0; g4 < 4; ++g4) {
                    f32x4 o;
#pragma unroll
                    for (int q = 0; q < 4; ++q) { const int i = 32 * I + 8 * g4 + 4 * hh + q; o[q] = (j < i) ? acc[4 * g4 + q] * __expf(GC[i] - gj) * BT[i] : 0.f; }
                    *(f32x4*)(KKA + j * 68 + 32 * I + 8 * g4 + 4 * hh) = o;
                }
            } else {
#pragma unroll
                for (int reg = 0; reg < 16; ++reg) {
                    const int i = 32 * I + (reg & 3) + 8 * (reg >> 2) + 4 * hh;
                    QKA[i * 68 + j] = (j <= i) ? acc[reg] * __expf(GC[i] - gj) : 0.f;
                }
            }
        } else if (wave == 6) {
            for (int idx = lane; idx < 1024; idx += 64) KKA[(32 + (idx >> 5)) * 68 + (idx & 31)] = 0.f;
        } else {
            for (int idx = lane; idx < 1024; idx += 64) QKA[(idx >> 5) * 68 + 32 + (idx & 31)] = 0.f;
        }
        __syncthreads();
        const float gclast = GC[63];
        for (int pc = tid; pc < 2560; pc += NTHREADS) {
            h16x8 o; int off;
            if (pc < 1024) {
                const int fs = pc >> 6, l = pc & 63, mt = fs >> 3, s8 = fs & 7, r = l & 31, hh = l >> 5, c = 32 * mt + r;
                const h16* sp = QS + c * 136 + 16 * s8 + 4 * hh;
                const h16x4 lo = *(const h16x4*)sp, hi = *(const h16x4*)(sp + 8);
                const float sc = EG[c];
#pragma unroll
                for (int j = 0; j < 4; ++j) { o[j] = (h16)((float)lo[j] * sc); o[4 + j] = (h16)((float)hi[j] * sc); }
                off = DN_QD + pc * 16;
            } else if (pc < 2048) {
                const int q = pc - 1024, fs = q >> 6, l = q & 63, kt = fs >> 2, s4 = fs & 3, r = l & 31, hh = l >> 5, dk = 32 * kt + r;
#pragma unroll
                for (int j = 0; j < 8; ++j) { const int c = 16 * s4 + 8 * (j >> 2) + 4 * hh + (j & 3); o[j] = (h16)((float)KS[c * 136 + dk] * GC[192 + c]); }
                off = DN_KD + q * 16;
            } else {
                const int q = pc - 2048, fs = q >> 6, l = q & 63, mt = fs >> 2, s4 = fs & 3, r = l & 31, hh = l >> 5, c = 32 * mt + r;
#pragma unroll
                for (int j = 0; j < 8; ++j) { const int c2 = 16 * s4 + 8 * (j >> 2) + 4 * hh + (j & 3); o[j] = (h16)QKA[c * 68 + c2]; }
                off = DN_IN + q * 16;
                if (fs == 2 && l == 0) { const unsigned gb = __float_as_uint(__expf(gclast)); const unsigned short lo16 = (unsigned short)(gb & 0xffffu), hi16 = (unsigned short)(gb >> 16);
                    o[0] = __builtin_bit_cast(h16, lo16); o[1] = __builtin_bit_cast(h16, hi16); }
            }
            *(h16x8*)(rec + off) = o;
        }
        for (int idx = tid; idx < 4096; idx += NTHREADS) {
            const int i = idx >> 6, c4 = (idx & 63) * 4; const bool wpart = c4 >= 128; const int dd = c4 & 127;
            const h16x4 sv = *(const h16x4*)((wpart ? KS : VS) + i * 136 + dd);
            const float sc = wpart ? BT[i] * EG[i] : BT[i];
            h16x4 o; o[0] = (h16)((float)sv[0] * sc); o[1] = (h16)((float)sv[1] * sc); o[2] = (h16)((float)sv[2] * sc); o[3] = (h16)((float)sv[3] * sc);
            *(h16x4*)((wpart ? WL : UL) + i * 136 + dd) = o;
        }
        __syncthreads();
        if (wave < 2) {
            const int d = tid & 127;
            h16* dU = UL + d; h16* dW = WL + d;
            int zl = 0; asm volatile("" : "+v"(zl));
            const float* Ab = KKA + zl;
            f32x2 XU[32], XW[32];
#pragma unroll
            for (int m = 0; m < 32; ++m) { XU[m][0] = (float)dU[(2 * m) * 136]; XU[m][1] = (float)dU[(2 * m + 1) * 136]; XW[m][0] = (float)dW[(2 * m) * 136]; XW[m][1] = (float)dW[(2 * m + 1) * 136]; }
#pragma unroll
            for (int j = 0; j < 64; ++j) {
                const float xu = XU[j / 2][j & 1], xw = XW[j / 2][j & 1];
                dU[j * 136] = (h16)xu; dW[j * 136] = (h16)(-xw);
                const f32x2 xu2 = (f32x2){xu, xu}, xw2 = (f32x2){xw, xw};
#pragma unroll
                for (int i4 = ((j + 1) & ~3); i4 < 64; i4 += 4) {
                    const f32x4 av = *(const f32x4*)(Ab + j * 68 + i4);
                    const f32x2 a01 = (f32x2){av[0], av[1]}, a23 = (f32x2){av[2], av[3]};
                    XU[i4 / 2] -= a01 * xu2; XU[i4 / 2 + 1] -= a23 * xu2;
                    XW[i4 / 2] -= a01 * xw2; XW[i4 / 2 + 1] -= a23 * xw2;
                }
                if ((j & 7) == 7) asm volatile("" ::: "memory");
            }
        } else if (wave != 5 && item + (int)gridDim.x < NITEM) {
            const int nitem = item + gridDim.x, bh = nitem >> 7, n = nitem & 127; const size_t t0 = (size_t)(bh >> 2) * SEQ + n * 64;
            if (wave == 4) dn_gates(ba, A_log, dt_bias, t0, bh & 3, lane, GC, EG, BT);
            else { const int lt = (wave < 4) ? tid - 128 : tid - 256;
                   dn_conv_rows<2, 0, 3>(dqkv, cw, t0, n, bh & 3, lt >> 3, lt & 7, QS, KS, VS); }
        }
        __syncthreads();
        for (int pc = tid; pc < 2048; pc += NTHREADS) {
            h16x8 o; int off;
            if (pc < 1024) {
                const int fs = pc >> 6, l = pc & 63, mt = fs >> 3, s8 = fs & 7, r = l & 31, hh = l >> 5, c = 32 * mt + r;
                const h16* sp = WL + c * 136 + 16 * s8 + 4 * hh;
                const h16x4 lo = *(const h16x4*)sp, hi = *(const h16x4*)(sp + 8);
#pragma unroll
                for (int j = 0; j < 4; ++j) { o[j] = lo[j]; o[4 + j] = hi[j]; }
                off = DN_NW + pc * 16;
            } else {
                const int q = pc - 1024, half8 = q & 1, l = (q >> 1) & 63, ms = q >> 7, mt = ms >> 2, sl = ms & 3, col = l & 31, hh = l >> 5;
#pragma unroll
                for (int j = 0; j < 8; ++j) { const int i = 8 * half8 + j; const int c = 32 * mt + (i & 3) + 8 * (i >> 2) + 4 * hh; o[j] = UL[c * 136 + 32 * sl + col]; }
                off = DN_U + q * 16;
            }
            *(h16x8*)(rec + off) = o;
        }
    }
}

__device__ __forceinline__ void cvt_frags(const f32x16& a, h16x8& f0, h16x8& f1) {
#pragma unroll
    for (int j = 0; j < 8; ++j) { f0[j] = (h16)a[j]; f1[j] = (h16)a[8 + j]; }
}
__device__ __forceinline__ void phase_scan_mfma(const Params& p, unsigned char* lds, int bh, int half) {
    const int tid = otid(), lane = tid & 63, wave = __builtin_amdgcn_readfirstlane(tid >> 6);
    const unsigned char* recs = p.ws + WS_DNREC + (size_t)bh * 128 * DN_REC;
    constexpr int NCH = SEQ / 64;
    if (wave >= 2) {
        const int lt = tid - 128;
        u32x4 R0[12], R1[12], R2[12];
#define DN_LOAD(R, n) do { const u32x4* s_ = (const u32x4*)(recs + (size_t)(n) * DN_REC) + lt; _Pragma("unroll") for (int k = 0; k < 12; ++k) R[k] = s_[k * 384]; } while (0)
#define DN_WRITE(R, n) do { u32x4* d_ = (u32x4*)(lds + ((n) & 1) * DN_REC) + lt; _Pragma("unroll") for (int k = 0; k < 12; ++k) d_[k * 384] = R[k]; } while (0)
        DN_LOAD(R0, 0); DN_WRITE(R0, 0); DN_LOAD(R1, 1); DN_LOAD(R2, 2);
        __syncthreads();
        for (int n = 0; n < NCH - 2; n += 3) {
            DN_LOAD(R0, min(n + 3, NCH - 1)); DN_WRITE(R1, n + 1); __syncthreads();
            DN_LOAD(R1, min(n + 4, NCH - 1)); DN_WRITE(R2, n + 2); __syncthreads();
            DN_LOAD(R2, min(n + 5, NCH - 1)); DN_WRITE(R0, n + 3); __syncthreads();
        }
        DN_WRITE(R1, NCH - 1); __syncthreads();
        __syncthreads();
        static_assert((NCH - 2) % 3 == 0 && (NCH - 1) % 3 == 1, "loader schedule assumes NCH = 3k + 2");
#undef DN_LOAD
#undef DN_WRITE
    } else {
        const int sl = 2 * half + wave, hh = lane >> 5;
        h16x2* o16 = (h16x2*)(p.ws + WS_O32);
        f32x16 S[4];
        h16x8 S16[4][2];
#pragma unroll
        for (int kt = 0; kt < 4; ++kt) {
#pragma unroll
            for (int i = 0; i < 16; ++i) S[kt][i] = 0.f;
#pragma unroll
            for (int j = 0; j < 8; ++j) { S16[kt][0][j] = (h16)0.f; S16[kt][1][j] = (h16)0.f; }
        }
        (void)hh;
        __syncthreads();
#define SB() __builtin_amdgcn_sched_barrier(0)
#define LD4(F, o0, o1, o2, o3) do { F[0] = *(const h16x8*)(fb + (o0)); F[1] = *(const h16x8*)(fb + (o1)); F[2] = *(const h16x8*)(fb + (o2)); F[3] = *(const h16x8*)(fb + (o3)); } while (0)
#define LDSEQ(F, base) LD4(F, (base), (base) + 1024, (base) + 2048, (base) + 3072)
#define MM(ACC, A, B) ACC = __builtin_amdgcn_mfma_f32_32x32x16_f16(A, B, ACC, 0, 0, 0)
        unsigned long long tacc_ = 0ull;
        for (int n = 0; n < NCH; ++n) {
            unsigned long long ts0_ = 0ull; if (PROBE == 70) ts0_ = __builtin_amdgcn_s_memtime();
            const unsigned char* buf = lds + (n & 1) * DN_REC;
            const unsigned char* fb = buf + lane * 16;
            h16x8 F0[4], F1[4], F2[4];
            f32x16 VN[2], O[2];
            h16x8 VN16[2][2];
            LDSEQ(F0, DN_NW + 0 * 1024); LDSEQ(F1, DN_NW + 4 * 1024);
            const float gl = *(const float*)(buf + DN_GL);
            h16x8 ur[2][2];
#pragma unroll
            for (int mt = 0; mt < 2; ++mt) { const h16x8* up = (const h16x8*)(buf + DN_U + ((mt * 4 + sl) * 64 + lane) * 32); ur[mt][0] = up[0]; ur[mt][1] = up[1]; }
            const f32x16 Z16 = {0.f, 0.f, 0.f, 0.f, 0.f, 0.f, 0.f, 0.f, 0.f, 0.f, 0.f, 0.f, 0.f, 0.f, 0.f, 0.f};
            SB();
            LDSEQ(F2, DN_NW + 8 * 1024);
            VN[0] = __builtin_amdgcn_mfma_f32_32x32x16_f16(F0[0], S16[0][0], Z16, 0, 0, 0); MM(VN[0], F0[1], S16[0][1]); MM(VN[0], F0[2], S16[1][0]); MM(VN[0], F0[3], S16[1][1]);
            SB();
            LDSEQ(F0, DN_NW + 12 * 1024);
            MM(VN[0], F1[0], S16[2][0]); MM(VN[0], F1[1], S16[2][1]); MM(VN[0], F1[2], S16[3][0]); MM(VN[0], F1[3], S16[3][1]);
            SB();
            LDSEQ(F1, DN_QD + 0 * 1024);
            VN[1] = __builtin_amdgcn_mfma_f32_32x32x16_f16(F2[0], S16[0][0], Z16, 0, 0, 0); MM(VN[1], F2[1], S16[0][1]); MM(VN[1], F2[2], S16[1][0]); MM(VN[1], F2[3], S16[1][1]);
            SB();
            LDSEQ(F2, DN_QD + 4 * 1024);
            MM(VN[1], F0[0], S16[2][0]); MM(VN[1], F0[1], S16[2][1]); MM(VN[1], F0[2], S16[3][0]); MM(VN[1], F0[3], S16[3][1]);
            SB();
            LDSEQ(F0, DN_QD + 8 * 1024);
            O[0] = __builtin_amdgcn_mfma_f32_32x32x16_f16(F1[0], S16[0][0], Z16, 0, 0, 0); MM(O[0], F1[1], S16[0][1]); MM(O[0], F1[2], S16[1][0]); MM(O[0], F1[3], S16[1][1]);
#pragma unroll
            for (int i = 0; i < 16; ++i) { S[0][i] *= gl; S[1][i] *= gl; }
#pragma unroll
            for (int j = 0; j < 8; ++j) { VN[0][j] += (float)ur[0][0][j]; VN[0][8 + j] += (float)ur[0][1][j]; }
            SB();
            LDSEQ(F1, DN_QD + 12 * 1024);
            MM(O[0], F2[0], S16[2][0]); MM(O[0], F2[1], S16[2][1]); MM(O[0], F2[2], S16[3][0]); MM(O[0], F2[3], S16[3][1]);
#pragma unroll
            for (int i = 0; i < 16; ++i) { S[2][i] *= gl; S[3][i] *= gl; }
#pragma unroll
            for (int j = 0; j < 8; ++j) { VN[1][j] += (float)ur[1][0][j]; VN[1][8 + j] += (float)ur[1][1][j]; }
            SB();
            LD4(F2, DN_IN + 0 * 1024, DN_IN + 1 * 1024, DN_IN + 4 * 1024, DN_IN + 5 * 1024);
            O[1] = __builtin_amdgcn_mfma_f32_32x32x16_f16(F0[0], S16[0][0], Z16, 0, 0, 0); MM(O[1], F0[1], S16[0][1]); MM(O[1], F0[2], S16[1][0]); MM(O[1], F0[3], S16[1][1]);
            cvt_frags(VN[0], VN16[0][0], VN16[0][1]);
            SB();
            F0[0] = *(const h16x8*)(fb + DN_IN + 6 * 1024); F0[1] = *(const h16x8*)(fb + DN_IN + 7 * 1024);
            MM(O[1], F1[0], S16[2][0]); MM(O[1], F1[1], S16[2][1]); MM(O[1], F1[2], S16[3][0]); MM(O[1], F1[3], S16[3][1]);
            cvt_frags(VN[1], VN16[1][0], VN16[1][1]);
            SB();
            LDSEQ(F1, DN_KD + 0 * 1024);
            MM(O[0], F2[0], VN16[0][0]); MM(O[0], F2[1], VN16[0][1]); MM(O[1], F2[2], VN16[0][0]); MM(O[1], F2[3], VN16[0][1]);
            SB();
            LDSEQ(F2, DN_KD + 4 * 1024);
            MM(O[1], F0[0], VN16[1][0]); MM(O[1], F0[1], VN16[1][1]);
            SB();
            h16x2* ob = o16 + ((size_t)((bh * NCH + n) * 2) * 4 + sl) * 512 + lane;
            LDSEQ(F0, DN_KD + 8 * 1024);
            MM(S[0], F1[0], VN16[0][0]); MM(S[0], F1[1], VN16[0][1]); MM(S[0], F1[2], VN16[1][0]); MM(S[0], F1[3], VN16[1][1]);
#pragma unroll
            for (int i = 0; i < 8; ++i) { h16x2 t2; t2[0] = (h16)O[0][2 * i]; t2[1] = (h16)O[0][2 * i + 1]; ob[i * 64] = t2; }
            SB();
            LDSEQ(F1, DN_KD + 12 * 1024);
            MM(S[1], F2[0], VN16[0][0]); MM(S[1], F2[1], VN16[0][1]); MM(S[1], F2[2], VN16[1][0]); MM(S[1], F2[3], VN16[1][1]);
#pragma unroll
            for (int i = 0; i < 8; ++i) { h16x2 t2; t2[0] = (h16)O[1][2 * i]; t2[1] = (h16)O[1][2 * i + 1]; ob[2048 + i * 64] = t2; }
            SB();
            MM(S[2], F0[0], VN16[0][0]); MM(S[2], F0[1], VN16[0][1]); MM(S[2], F0[2], VN16[1][0]); MM(S[2], F0[3], VN16[1][1]);
            cvt_frags(S[0], S16[0][0], S16[0][1]);
            SB();
            MM(S[3], F1[0], VN16[0][0]); MM(S[3], F1[1], VN16[0][1]); MM(S[3], F1[2], VN16[1][0]); MM(S[3], F1[3], VN16[1][1]);
            cvt_frags(S[1], S16[1][0], S16[1][1]);
            SB();
            cvt_frags(S[2], S16[2][0], S16[2][1]); cvt_frags(S[3], S16[3][0], S16[3][1]);
            if (PROBE == 70) { asm volatile("s_nop 0" :: "v"(S16[3][1])); tacc_ += __builtin_amdgcn_s_memtime() - ts0_; }
            if (PROBE == 71) ts0_ = __builtin_amdgcn_s_memtime();
            __syncthreads();
            if (PROBE == 71) tacc_ += __builtin_amdgcn_s_memtime() - ts0_;
        }
        if ((PROBE == 70 || PROBE == 71) && bh == 0 && tid == 0) *(float*)(p.ws + WS_CTL + 32768) = 0.02f * floorf((float)tacc_ / (float)NCH / 250.f);
#undef SB
#undef LD4
#undef LDSEQ
#undef MM
    }
}

constexpr int AT_KS_STRIDE = 72, AT_VT_STRIDE = 388, AT_VT_OFF = 384 * AT_KS_STRIDE * 2;
struct AttnUnit { int g, b, hd, dil, r, m0; size_t rowbase; };
__device__ __forceinline__ AttnUnit attn_unit(int u) {
    AttnUnit a; a.g = u >> 10; const int rem = u & 1023, x = (rem >> 3) & 31; a.b = rem >> 8; a.hd = rem & 7;
    a.dil = (a.g == 0) ? 1 : ((a.g == 1) ? 4 : 16); a.r = x & (a.dil - 1); a.m0 = (x / a.dil) * 256; a.rowbase = (size_t)a.b * SEQ + a.r; return a;
}
__device__ __forceinline__ void phase_attn_mfma(const Params& p, unsigned char* lds, int vblock, int nvblocks) {
    const h16* q16 = (const h16*)(p.ws + WS_Q16); const h16* k16 = (const h16*)(p.ws + WS_K16); const h16* v16 = (const h16*)(p.ws + WS_V16);
    h16* ao = (h16*)(p.ws + WS_AO); float* lse = (float*)(p.ws + WS_LSE);
    h16* Ks = (h16*)lds; h16* Vt = (h16*)(lds + AT_VT_OFF);
    const int tid = otid(), lane = tid & 63, w = tid >> 6, ql = lane & 31, hh = lane >> 5;
    h16x8 kr[6], vr[6], qf[4];
#define AT_PREFETCH(U) do { const AttnUnit a_ = attn_unit(U); \
        _Pragma("unroll") for (int k_ = 0; k_ < 6; ++k_) { const int idx_ = tid + 512 * k_, pc_ = idx_ & 7, kk_ = idx_ >> 3, m_ = a_.m0 - 128 + kk_; \
            const size_t go_ = (a_.rowbase + (size_t)(m_ < 0 ? 0 : m_) * a_.dil) * AW + a_.hd * 64 + pc_ * 8; \
            kr[k_] = *(const h16x8*)(k16 + go_); vr[k_] = *(const h16x8*)(v16 + go_); } \
        const size_t qrow_ = a_.rowbase + (size_t)(a_.m0 + 32 * w + ql) * a_.dil; \
        _Pragma("unroll") for (int s_ = 0; s_ < 4; ++s_) qf[s_] = *(const h16x8*)(q16 + qrow_ * AW + a_.hd * 64 + 16 * s_ + 8 * hh); } while (0)
    float bnd0[16], bnd4[16];
#pragma unroll
    for (int i = 0; i < 16; ++i) { const int row = (i & 3) + 8 * (i >> 2) + 4 * hh; bnd0[i] = (row >= ql) ? INFINITY : -INFINITY; bnd4[i] = (row <= ql) ? INFINITY : -INFINITY; }
    int u = vblock;
    if (u < 3 * 1024) AT_PREFETCH(u);
    for (; u < 3 * 1024; u += nvblocks) {
        const AttnUnit au = attn_unit(u);
        const int m0 = au.m0;
        const size_t qrow = au.rowbase + (size_t)(m0 + 32 * w + ql) * au.dil;
        __syncthreads();
#pragma unroll
        for (int k = 0; k < 6; ++k) {
            const int idx = tid + 512 * k, pc = idx & 7, kk = idx >> 3;
            const h16x8 kv = kr[k], vv = vr[k];
            *(h16x8*)(Ks + kk * AT_KS_STRIDE + pc * 8) = kv;
#pragma unroll
            for (int j = 0; j < 8; ++j) Vt[(pc * 8 + j) * AT_VT_STRIDE + kk] = vv[j];
        }
        h16x8 qc[4];
#pragma unroll
        for (int s4 = 0; s4 < 4; ++s4) qc[s4] = qf[s4];
        __syncthreads();
        if (u + nvblocks < 3 * 1024) AT_PREFETCH(u + nvblocks);
        f32x16 St[5];
#pragma unroll
        for (int kt = 0; kt < 5; ++kt) {
#pragma unroll
            for (int i = 0; i < 16; ++i) St[kt][i] = 0.f;
#pragma unroll
            for (int s4 = 0; s4 < 4; ++s4) {
                const h16x8 a = *(const h16x8*)(Ks + (32 * (w + kt) + ql) * AT_KS_STRIDE + 16 * s4 + 8 * hh);
                St[kt] = __builtin_amdgcn_mfma_f32_32x32x16_f16(a, qc[s4], St[kt], 0, 0, 0);
            }
        }
#pragma unroll
        for (int i = 0; i < 16; ++i) { St[0][i] = fminf(St[0][i], bnd0[i]); St[4][i] = fminf(St[4][i], bnd4[i]); }
        if (m0 == 0) {
#pragma unroll
            for (int kt = 0; kt < 4; ++kt)
                if (w + kt < 4) {
#pragma unroll
                    for (int i = 0; i < 16; ++i) St[kt][i] = -INFINITY;
                }
        }
        float mx = -INFINITY;
#pragma unroll
        for (int kt = 0; kt < 5; ++kt)
#pragma unroll
            for (int i = 0; i < 16; ++i) mx = fmaxf(mx, St[kt][i]);
        mx = fmaxf(mx, __shfl_xor(mx, 32));
        float l = 0.f;
        {
            const float c2 = 0.125f * 1.4426950408889634f, mb = -mx * c2;
#pragma unroll
            for (int kt = 0; kt < 5; ++kt)
#pragma unroll
                for (int i = 0; i < 16; ++i) { St[kt][i] = __builtin_amdgcn_exp2f(__builtin_fmaf(St[kt][i], c2, mb)); l += St[kt][i]; }
        }
        l += __shfl_xor(l, 32);
        f32x16 Ot[2];
#pragma unroll
        for (int dt = 0; dt < 2; ++dt)
#pragma unroll
            for (int i = 0; i < 16; ++i) Ot[dt][i] = 0.f;
#pragma unroll
        for (int kt = 0; kt < 5; ++kt) {
            h16x8 pf[2];
            cvt_frags(St[kt], pf[0], pf[1]);
#pragma unroll
            for (int s2 = 0; s2 < 2; ++s2)
#pragma unroll
                for (int dt = 0; dt < 2; ++dt) {
                    const h16* vp = Vt + (32 * dt + ql) * AT_VT_STRIDE + 32 * (w + kt) + 16 * s2 + 4 * hh;
                    const h16x4 lo = *(const h16x4*)vp, hi = *(const h16x4*)(vp + 8);
                    h16x8 a;
#pragma unroll
                    for (int j = 0; j < 4; ++j) { a[j] = lo[j]; a[4 + j] = hi[j]; }
                    Ot[dt] = __builtin_amdgcn_mfma_f32_32x32x16_f16(a, pf[s2], Ot[dt], 0, 0, 0);
                }
        }
        const float inv = __builtin_amdgcn_rcpf(l);
        h16* orow = ao + ((size_t)au.g * T + qrow) * AW + au.hd * 64;
#pragma unroll
        for (int dt = 0; dt < 2; ++dt)
#pragma unroll
            for (int i4 = 0; i4 < 4; ++i4) {
                h16x4 o;
#pragma unroll
                for (int j = 0; j < 4; ++j) o[j] = (h16)(Ot[dt][4 * i4 + j] * inv);
                *(h16x4*)(orow + 32 * dt + 8 * i4 + 4 * hh) = o;
            }
        if (hh == 0) lse[((size_t)au.g * T + qrow) * 8 + au.hd] = 0.125f * mx + __logf(l);
    }
#undef AT_PREFETCH
}

__device__ __forceinline__ void phase_dnout(const Params& p) {
    const float* o32 = (const float*)(p.ws + WS_O32); const h16* z16 = (const h16*)(p.ws + WS_Z16); const float* nw = p.in[9];
    const h16* ao = (const h16*)(p.ws + WS_AO); const float* lse = (const float*)(p.ws + WS_LSE);
    h16* mix = (h16*)(p.ws + WS_MIX);
    const int tid_ = otid(); const int lane = tid_ & 63, wave = tid_ >> 6;
    const int gw = blockIdx.x * NWAVES + wave, NGW = gridDim.x * NWAVES;
    const f32x2 w2 = *(const f32x2*)(nw + 2 * lane);
    for (int row = gw; row < T; row += NGW) {
        const int ah = lane >> 3;
        const float l0 = lse[((size_t)0 * T + row) * 8 + ah], l1 = lse[((size_t)1 * T + row) * 8 + ah], l2 = lse[((size_t)2 * T + row) * 8 + ah];
        const h16x8 a0 = *(const h16x8*)(ao + ((size_t)0 * T + row) * AW + lane * 8), a1 = *(const h16x8*)(ao + ((size_t)1 * T + row) * AW + lane * 8),
                    a2 = *(const h16x8*)(ao + ((size_t)2 * T + row) * AW + lane * 8);
        const int bq = row / SEQ, tp = row % SEQ, nq = tp >> 6, cq = tp & 63, mtq = cq >> 5, cl = cq & 31, h2 = (cl >> 2) & 1, iq = (cl & 3) + 4 * (cl >> 3);
        f32x2 ov[4]; h16x2 zv[4];
#pragma unroll
        for (int hd = 0; hd < 4; ++hd) {
            { const h16x2* op = (const h16x2*)(p.ws + WS_O32) + ((size_t)(((bq * 4 + hd) * (SEQ / 64) + nq) * 2 + mtq) * 4 + (lane >> 4)) * 512 + (iq >> 1) * 64 + h2 * 32 + ((2 * lane) & 31);
              const h16x2 pa = op[0], pb = op[1]; ov[hd][0] = (float)pa[iq & 1]; ov[hd][1] = (float)pb[iq & 1]; }
            zv[hd] = *(const h16x2*)(z16 + (size_t)row * DW + hd * 128 + 2 * lane);
        }
        {
            const float m = fmaxf(l0, fmaxf(l1, l2));
            const float e0 = __expf(l0 - m), e1 = __expf(l1 - m), e2 = __expf(l2 - m), inv = 1.f / (e0 + e1 + e2);
            h16x8 o;
#pragma unroll
            for (int j = 0; j < 8; ++j) o[j] = (h16)((e0 * (float)a0[j] + e1 * (float)a1[j] + e2 * (float)a2[j]) * inv);
            *(h16x8*)(mix + (size_t)row * D + lane * 8) = o;
        }
#pragma unroll
        for (int hd = 0; hd < 4; ++hd) {
            const float rstd = rsqrtf(wave_sum(ov[hd][0] * ov[hd][0] + ov[hd][1] * ov[hd][1]) * (1.f / 128.f) + EPS);
            h16x2 r; r[0] = (h16)(ov[hd][0] * rstd * w2[0] * silu_f((float)zv[hd][0])); r[1] = (h16)(ov[hd][1] * rstd * w2[1] * silu_f((float)zv[hd][1]));
            *(h16x2*)(mix + (size_t)row * D + 512 + hd * 128 + 2 * lane) = r;
        }
    }
}

__device__ __forceinline__ void phase_final(const Params& p, float* lds) {
    int* li = (int*)lds;
    { const int* cnt = (const int*)(p.ws + WS_CTL);
      if (otid() == 0) { int t = 0; for (int e = 0; e < NE; ++e) { li[e] = t * 256; t += (cnt[e] + 255) / 256; } }
      __syncthreads(); }
    const h16* x1 = (const h16*)(p.ws + WS_X1); const float* mod = (const float*)(p.ws + WS_MOD); const float* fw = p.in[18];
    const h16* y = (const h16*)(p.ws + WS_Y16);
    const int* asg_e = (const int*)(p.ws + WS_ASG_E); const int* asg_p = (const int*)(p.ws + WS_ASG_P); const float* asg_g = (const float*)(p.ws + WS_ASG_G);
    const int tid_ = otid(); const int lane = tid_ & 63, wave = tid_ >> 6;
    const int gw = blockIdx.x * NWAVES + wave, NGW = gridDim.x * NWAVES;
    for (int row0 = gw; row0 < T; row0 += 2 * NGW) {
        size_t slot[2][4]; float gk[2][4]; int rows[2];
#pragma unroll
        for (int rr = 0; rr < 2; ++rr) {
            const int row = (row0 + rr * NGW < T) ? row0 + rr * NGW : row0; rows[rr] = row;
            const int4 ae = *(const int4*)(asg_e + row * 4), ap = *(const int4*)(asg_p + row * 4); const f32x4 ag = *(const f32x4*)(asg_g + row * 4);
            slot[rr][0] = (size_t)(li[ae.x] + ap.x); slot[rr][1] = (size_t)(li[ae.y] + ap.y); slot[rr][2] = (size_t)(li[ae.z] + ap.z); slot[rr][3] = (size_t)(li[ae.w] + ap.w);
            gk[rr][0] = ag[0] * (1.f / FP8_SY); gk[rr][1] = ag[1] * (1.f / FP8_SY); gk[rr][2] = ag[2] * (1.f / FP8_SY); gk[rr][3] = ag[3] * (1.f / FP8_SY);
        }
        f32x4 v[2][4]; float ss[2] = {0.f, 0.f};
#pragma unroll
        for (int rr = 0; rr < 2; ++rr) {
            const int row = rows[rr]; const float* gate2 = mod + (row / SEQ) * 6144 + 5120;
#pragma unroll
            for (int j = 0; j < 4; ++j) {
                const int col = 256 * j + 4 * lane;
                f32x4 yv[4];
#pragma unroll
                for (int k = 0; k < 4; ++k) { const int yw = *(const int*)((const unsigned char*)y + slot[rr][k] * D + col);
                    const f32x2 lo = __builtin_amdgcn_cvt_pk_f32_fp8(yw, false), hi = __builtin_amdgcn_cvt_pk_f32_fp8(yw, true); yv[k] = (f32x4){lo[0], lo[1], hi[0], hi[1]}; }
                const h16x4 xh = *(const h16x4*)(x1 + (size_t)row * D + col); const f32x4 xv = (f32x4){(float)xh[0], (float)xh[1], (float)xh[2], (float)xh[3]}, g2 = *(const f32x4*)(gate2 + col);
#pragma unroll
                for (int i = 0; i < 4; ++i) {
                    const float acc = gk[rr][0] * yv[0][i] + gk[rr][1] * yv[1][i] + gk[rr][2] * yv[2][i] + gk[rr][3] * yv[3][i];
                    v[rr][j][i] = xv[i] + g2[i] * acc; ss[rr] += v[rr][j][i] * v[rr][j][i];
                }
            }
        }
#pragma unroll
        for (int rr = 0; rr < 2; ++rr) {
            if (rr == 1 && row0 + NGW >= T) break;
            const float rstd = rsqrtf(wave_sum(ss[rr]) * (1.f / D) + EPS);
#pragma unroll
            for (int j = 0; j < 4; ++j) {
                const int col = 256 * j + 4 * lane; const f32x4 w4 = *(const f32x4*)(fw + col);
                f32x4 o; o[0] = v[rr][j][0] * rstd * w4[0]; o[1] = v[rr][j][1] * rstd * w4[1]; o[2] = v[rr][j][2] * rstd * w4[2]; o[3] = v[rr][j][3] * rstd * w4[3];
                *(f32x4*)(p.out + (size_t)rows[rr] * D + col) = o;
            }
        }
    }
}

constexpr float FP8_SA = 4.f, FP8_SW = 64.f;
__device__ __forceinline__ unsigned pack_fp8x4(float a, float b, float c, float d) {
    int w = 0;
    w = __builtin_amdgcn_cvt_pk_fp8_f32(fminf(fmaxf(a, -448.f), 448.f), fminf(fmaxf(b, -448.f), 448.f), w, false);
    w = __builtin_amdgcn_cvt_pk_fp8_f32(fminf(fmaxf(c, -448.f), 448.f), fminf(fmaxf(d, -448.f), 448.f), w, true);
    return (unsigned)w;
}
struct Cvt8Job { const float* src; unsigned char* dst; int N, K; };
__device__ __forceinline__ void cvt8_load(const Cvt8Job& j, int lane, f32x4 (&v)[16]) {
    const int kr = lane >> 4, n4 = (lane & 15) * 4;
#pragma unroll
    for (int i = 0; i < 16; ++i) v[i] = *(const f32x4*)(j.src + (size_t)(4 * i + kr) * j.N + n4);
}
__device__ __forceinline__ void cvt8_store(const Cvt8Job& jb, int lane, float* scr, const f32x4 (&v)[16]) {
    const int kr = lane >> 4, n4 = (lane & 15) * 4;
#pragma unroll
    for (int i = 0; i < 16; ++i) { float* d = scr + (4 * i + kr) * 65 + n4; d[0] = v[i][0]; d[1] = v[i][1]; d[2] = v[i][2]; d[3] = v[i][3]; }
    asm volatile("s_waitcnt lgkmcnt(0)" ::: "memory");
    const int c = lane & 3;
#pragma unroll
    for (int j = 0; j < 4; ++j) { const int n = (lane >> 2) + 16 * j; const float* sp = scr + (16 * c) * 65 + n;
        u32x4 o;
#pragma unroll
        for (int q = 0; q < 4; ++q) o[q] = pack_fp8x4(sp[(4 * q) * 65] * FP8_SW, sp[(4 * q + 1) * 65] * FP8_SW, sp[(4 * q + 2) * 65] * FP8_SW, sp[(4 * q + 3) * 65] * FP8_SW);
        *(u32x4*)(jb.dst + (size_t)n * jb.K + 16 * c) = o; }
    asm volatile("s_waitcnt lgkmcnt(0)" ::: "memory");
}
template <bool BF>
__device__ __forceinline__ void cvt_item(const float* W, int K, int N, h16* WT, int dst_row0, int k0, int n0, float* scr, int lane) {
    const int kr = lane >> 4, n4 = (lane & 15) * 4;
    f32x4 v[16];
#pragma unroll
    for (int i = 0; i < 16; ++i) v[i] = *(const f32x4*)(W + (size_t)(k0 + 4 * i + kr) * N + n0 + n4);
#pragma unroll
    for (int i = 0; i < 16; ++i) { float* d = scr + (4 * i + kr) * 65 + n4; d[0] = v[i][0]; d[1] = v[i][1]; d[2] = v[i][2]; d[3] = v[i][3]; }
    asm volatile("s_waitcnt lgkmcnt(0)" ::: "memory");
    const int c = lane & 7;
#pragma unroll
    for (int j = 0; j < 8; ++j) { const int n = (lane >> 3) + 8 * j; const float* sp = scr + (8 * c) * 65 + n;
        if constexpr (BF) { u32x4 ob; ob[0] = pk_bf16(sp[0], sp[65]); ob[1] = pk_bf16(sp[2 * 65], sp[3 * 65]); ob[2] = pk_bf16(sp[4 * 65], sp[5 * 65]); ob[3] = pk_bf16(sp[6 * 65], sp[7 * 65]);
            *(u32x4*)(WT + (size_t)(dst_row0 + n) * K + k0 + 8 * c) = ob; }
        else { h16x8 o;
#pragma unroll
            for (int q = 0; q < 8; ++q) o[q] = (h16)sp[q * 65];
            *(h16x8*)(WT + (size_t)(dst_row0 + n) * K + k0 + 8 * c) = o; } }
    asm volatile("s_waitcnt lgkmcnt(0)" ::: "memory");
}
__device__ __forceinline__ Cvt8Job cvt8_job(const Params& p, int r) {
    constexpr int I_W1 = 32 * 16 * 32;
    Cvt8Job j;
    if (r < I_W1) { const int e = r / 512, q = r % 512, kb = q / 32, nb = q % 32, n0 = nb * 64, hh = n0 / 1024, jj = n0 % 1024, row0 = (jj / 128) * 256 + hh * 128 + (jj % 128);
        j.N = 2 * FE; j.K = D; j.src = p.in[14] + (size_t)e * D * 2 * FE + (size_t)(kb * 64) * (2 * FE) + n0;
        j.dst = (unsigned char*)(p.ws + WS_W116) + (size_t)e * 2 * FE * D + (size_t)row0 * D + kb * 64; }
    else { r -= I_W1; const int e = r / 256, q = r % 256, kb = q / 16, nb = q % 16;
        j.N = D; j.K = FE; j.src = p.in[16] + (size_t)e * FE * D + (size_t)(kb * 64) * D + nb * 64;
        j.dst = (unsigned char*)(p.ws + WS_W216) + (size_t)e * D * FE + (size_t)(nb * 64) * FE + kb * 64; }
    return j;
}
__device__ __forceinline__ void phase_cvt(const Params& p, float* lds, int part, int vblock, int nvblocks) {
    const int tid_ = otid(); const int lane = tid_ & 63, wave = tid_ >> 6;
    float* scr = lds + wave * (64 * 65);
    const int gw = vblock * NWAVES + wave, NGW = nvblocks * NWAVES;
    constexpr int I_IN = 16 * 56, I_OUT = 16 * 16, I_W1 = 32 * 16 * 32, I_W2 = 32 * 16 * 16;
    const int it_lo = part == 0 ? 0 : I_IN, it_hi = part == 0 ? I_IN : I_IN + I_OUT;
    for (int it = it_lo + gw; it < it_hi; it += NGW) {
        int r = it;
        if (r < I_IN) { const int kb = r / 56, nb = r % 56; cvt_item<false>(p.in[5], D, INC, (h16*)(p.ws + WS_WIN16), nb * 64, kb * 64, nb * 64, scr, lane); continue; } r -= I_IN;
        { const int kb = r / 16, nb = r % 16; cvt_item<false>(p.in[10], D, D, (h16*)(p.ws + WS_WOUT16), nb * 64, kb * 64, nb * 64, scr, lane); }
    }
    if (part == 1) {
        constexpr int NI = I_W1 + I_W2;
        int it = gw;
        if (it < NI) {
            f32x4 v[16]; Cvt8Job jb = cvt8_job(p, it); cvt8_load(jb, lane, v);
            for (;;) {
                const int nx = it + NGW; const bool more = nx < NI;
                f32x4 vn[16]; const Cvt8Job jn = cvt8_job(p, more ? nx : it);
                cvt8_load(jn, lane, vn);
                cvt8_store(jb, lane, scr, v);
                if (!more) break;
#pragma unroll
                for (int i = 0; i < 16; ++i) v[i] = vn[i];
                jb = jn; it = nx;
            }
        }
    }
}

typedef pg8::Unit PUnit;
struct EpiInProjM {
    static constexpr bool PERM = true; unsigned char* ws;
    __device__ __forceinline__ void operator()(const f32x4 (&acc)[2][2][4][2], const PUnit& u, int wr, int wc, int fr, int fq) const {
        const int c0 = u.pn * 256; h16* dst; int ld, cc;
        if (c0 < 512) { dst = (h16*)(ws + WS_Q16); ld = 512; cc = c0; }
        else if (c0 < 1024) { dst = (h16*)(ws + WS_K16); ld = 512; cc = c0 - 512; }
        else if (c0 < 1536) { dst = (h16*)(ws + WS_V16); ld = 512; cc = c0 - 1024; }
        else if (c0 < 3072) { dst = (h16*)(ws + WS_DQKV); ld = 1536; cc = c0 - 1536; }
        else { dst = (h16*)(ws + WS_Z16); ld = 512; cc = c0 - 3072; }
        const int col0 = cc + wc * 32 + 8 * fq;
#pragma unroll
        for (int ai = 0; ai < 2; ++ai)
#pragma unroll
            for (int m = 0; m < 4; ++m) { const size_t row = (size_t)u.pm * 256 + ai * 128 + wr * 64 + m * 16 + fr;
#pragma unroll
                for (int bj = 0; bj < 2; ++bj) { h16x8 o;
#pragma unroll
                    for (int n = 0; n < 2; ++n)
#pragma unroll
                        for (int i = 0; i < 4; ++i) o[4 * n + i] = (h16)acc[ai][bj][m][n][i];
                    *(h16x8*)(dst + row * ld + col0 + bj * 128) = o; } }
    }
};
struct EpiOutProjM {
    static constexpr bool PERM = true; const float* x; const float* mod; h16* x1;
    __device__ __forceinline__ void operator()(const f32x4 (&acc)[2][2][4][2], const PUnit& u, int wr, int wc, int fr, int fq) const {
        const int col0 = u.pn * 256 + wc * 32 + 8 * fq;
#pragma unroll
        for (int ai = 0; ai < 2; ++ai)
#pragma unroll
            for (int m = 0; m < 4; ++m) { const size_t row = (size_t)u.pm * 256 + ai * 128 + wr * 64 + m * 16 + fr; const int b = (int)(row / SEQ);
#pragma unroll
                for (int bj = 0; bj < 2; ++bj) { const int c = col0 + bj * 128; h16x8 o;
#pragma unroll
                    for (int n = 0; n < 2; ++n) { const f32x4 gt = *(const f32x4*)(mod + b * 6144 + 2048 + c + 4 * n); const f32x4 xv = *(const f32x4*)(x + row * D + c + 4 * n);
#pragma unroll
                        for (int i = 0; i < 4; ++i) o[4 * n + i] = (h16)(xv[i] + gt[i] * acc[ai][bj][m][n][i]); }
                    *(h16x8*)(x1 + row * D + c) = o; } }
    }
};
struct EpiSwigluM {
    static constexpr bool PERM = true; h16* act; const float* b1;
    __device__ __forceinline__ void operator()(const f32x4 (&acc)[2][2][4][2], const PUnit& u, int wr, int wc, int fr, int fq) const {
        const float* bb = b1 + (size_t)u.e * 2 * FE; const int j0 = u.pn * 128 + wc * 32 + 8 * fq;
        f32x4 bg[2], bu[2];
#pragma unroll
        for (int n = 0; n < 2; ++n) { bg[n] = *(const f32x4*)(bb + j0 + 4 * n); bu[n] = *(const f32x4*)(bb + FE + j0 + 4 * n); }
        constexpr float RS = 1.f / (FP8_SA * FP8_SW);
        const f32x2 rs2 = {RS, RS}, ke2 = {-1.702f * 1.44269504089f, -1.702f * 1.44269504089f}, one2 = {1.f, 1.f}, sa2 = {FP8_SA, FP8_SA};
#pragma unroll
        for (int ai = 0; ai < 2; ++ai)
#pragma unroll
            for (int m = 0; m < 4; ++m) { const size_t row = (size_t)u.pm * 256 + ai * 128 + wr * 64 + m * 16 + fr; u32x2_t o;
#pragma unroll
                for (int n = 0; n < 2; ++n) { f32x2 ov[2];
#pragma unroll
                    for (int ip = 0; ip < 2; ++ip) { const int i = 2 * ip;
                        f32x2 gt = (f32x2){acc[ai][0][m][n][i], acc[ai][0][m][n][i + 1]} * rs2 + (f32x2){bg[n][i], bg[n][i + 1]};
                        f32x2 up = (f32x2){acc[ai][1][m][n][i], acc[ai][1][m][n][i + 1]} * rs2 + (f32x2){bu[n][i], bu[n][i + 1]};
                        gt[0] = fminf(gt[0], 7.f); gt[1] = fminf(gt[1], 7.f);
                        up[0] = __builtin_amdgcn_fmed3f(up[0], -7.f, 7.f); up[1] = __builtin_amdgcn_fmed3f(up[1], -7.f, 7.f);
                        f32x2 t = gt * ke2; t[0] = __builtin_amdgcn_exp2f(t[0]); t[1] = __builtin_amdgcn_exp2f(t[1]);
                        t = t + one2; t[0] = __builtin_amdgcn_rcpf(t[0]); t[1] = __builtin_amdgcn_rcpf(t[1]);
                        ov[ip] = (gt * t) * (up * sa2 + sa2); }
                    int w = __builtin_amdgcn_cvt_pk_fp8_f32(ov[0][0], ov[0][1], 0, false); w = __builtin_amdgcn_cvt_pk_fp8_f32(ov[1][0], ov[1][1], w, true);
                    o[n] = (unsigned)w; }
                *(u32x2_t*)((unsigned char*)act + row * FE + j0) = o; }
    }
};
struct EpiDownM {
    static constexpr bool PERM = true; h16* y; const float* b2;
    __device__ __forceinline__ void operator()(const f32x4 (&acc)[2][2][4][2], const PUnit& u, int wr, int wc, int fr, int fq) const {
        const float* bb = b2 + (size_t)u.e * D; const int col0 = u.pn * 256 + wc * 32 + 8 * fq;
#pragma unroll
        for (int bj = 0; bj < 2; ++bj) { f32x4 bv[2];
#pragma unroll
            for (int n = 0; n < 2; ++n) bv[n] = *(const f32x4*)(bb + col0 + bj * 128 + 4 * n);
#pragma unroll
            for (int ai = 0; ai < 2; ++ai)
#pragma unroll
                for (int m = 0; m < 4; ++m) { const size_t row = (size_t)u.pm * 256 + ai * 128 + wr * 64 + m * 16 + fr; u32x2_t o;
#pragma unroll
                    for (int n = 0; n < 2; ++n) { float t[4];
#pragma unroll
                        for (int i = 0; i < 4; ++i) t[i] = acc[ai][bj][m][n][i] * (FP8_SY / (FP8_SA * FP8_SW)) + bv[n][i] * FP8_SY;
                        o[n] = pack_fp8x4(t[0], t[1], t[2], t[3]); }
                    *(u32x2_t*)((unsigned char*)y + row * D + col0 + bj * 128) = o; } }
    }
};
#define LAS3 __attribute__((address_space(3)))
__device__ __forceinline__ void phase_inproj_m(const Params& p, LAS3 unsigned char* lds) {
    for (int i = 0; i < (int)((blockIdx.x >> 3) & 3); ++i) __builtin_amdgcn_s_sleep(64);
    pg8::Order S; S.init(T / 256, INC_MAIN / 256, gridDim.x, blockIdx.x, nullptr);
    pg8::gemm_phase<EpiInProjM, false>(lds, pg8::Gemm{(const h16*)(p.ws + WS_H16), (const h16*)(p.ws + WS_WIN16), INC_MAIN, D}, S, EpiInProjM{p.ws}, nullptr);
}
__device__ __forceinline__ void phase_outproj_m(const Params& p, LAS3 unsigned char* lds) {
    pg8::Order S; S.init(T / 256, D / 256, gridDim.x, blockIdx.x, nullptr);
    pg8::gemm_phase<EpiOutProjM, false>(lds, pg8::Gemm{(const h16*)(p.ws + WS_MIX), (const h16*)(p.ws + WS_WOUT16), D, D}, S,
                                         EpiOutProjM{p.in[0], (const float*)(p.ws + WS_MOD), (h16*)(p.ws + WS_X1)}, nullptr);
}
__device__ __forceinline__ void moe_prefix_m(const Params& p, LAS3 int* tab) {
    const int* cnt = (const int*)(p.ws + WS_CTL);
    const int t_ = otid();
    if (t_ < NE) tab[40 + t_] = cnt[t_];
    __syncthreads();
    if (t_ == 0) { int t = 0; for (int e = 0; e < NE; ++e) { tab[e] = t; t += (tab[40 + e] + 255) / 256; } tab[NE] = t; }
    __syncthreads();
}
__device__ __forceinline__ void phase_moe1_m(const Params& p, LAS3 unsigned char* lds) {
    LAS3 int* tab = (LAS3 int*)(lds + LDS_TAB); LAS3 int* gtab = (LAS3 int*)(lds + LDS_GTAB);
    moe_prefix_m(p, tab);
    const int* cnt = (const int*)(p.ws + WS_CTL); const int* tok = (const int*)(p.ws + WS_TOK);
    pg8::Order S; S.init(tab[NE], 2 * FE / 256, gridDim.x, blockIdx.x, tab);
    const int tid = otid();
    {
        int src[GTAB_UNITS / 2];
#pragma unroll
        for (int k = 0; k < GTAB_UNITS / 2; ++k) {
            const int ui = 2 * k + (tid >> 8); PUnit u; const bool ok = S.next(ui, u);
            const int e = ok ? u.e : 0, c = tab[40 + e]; int li = ok ? (u.pm - tab[e]) * 256 + (tid & 255) : 0; li = li < c ? li : (c > 0 ? c - 1 : 0);
            src[k] = tok[(size_t)e * T + li];
        }
#pragma unroll
        for (int k = 0; k < GTAB_UNITS / 2; ++k) gtab[(2 * k + (tid >> 8)) * 256 + (tid & 255)] = src[k];
    }
    __syncthreads();
    pg8::gemm_phase<EpiSwigluM, true, 3>(lds, pg8::Gemm{(const h16*)(p.ws + WS_H16), (const h16*)(p.ws + WS_W116), 2 * FE, D}, S,
                                       EpiSwigluM{(h16*)(p.ws + WS_ACT), p.in[15]}, gtab);
}
__device__ __forceinline__ void phase_moe2_m(const Params& p, LAS3 unsigned char* lds) {
    LAS3 int* tab = (LAS3 int*)(lds + LDS_TAB);
    moe_prefix_m(p, tab);
    pg8::Order S; S.init(tab[NE], D / 256, gridDim.x, blockIdx.x, tab);
    pg8::gemm_phase<EpiDownM, false, 3>(lds, pg8::Gemm{(const h16*)(p.ws + WS_ACT), (const h16*)(p.ws + WS_W216), D, FE}, S,
                                      EpiDownM{(h16*)(p.ws + WS_Y16), p.in[17]}, nullptr);
}


typedef float f32x4_t __attribute__((ext_vector_type(4)));
template <int MODE>
__device__ __forceinline__ void phase_rowproj(const Params& p, unsigned char* lds) {
    constexpr int NET = (MODE == 0) ? 1 : 2, RS = 1032;
    const float* xin = p.in[0]; const h16* x1h = (const h16*)(p.ws + WS_X1);
    const float* nw = (MODE == 0) ? p.in[4] : p.in[11];
    const float* mod = (const float*)(p.ws + WS_MOD);
    h16* hout = (h16*)(p.ws + WS_H16);
    h16* HI = (h16*)lds; h16* LO = (h16*)(lds + 33024); float* PART = (float*)(lds + 66048); float* LOGIT = (float*)(lds + 82432);
    int* LCNT = (int*)(lds + 84544); int* GB = (int*)(lds + 84672); int* LIST = (int*)(lds + 84800);
    const int tid = otid(), lane = tid & 63, w = tid >> 6, fr = lane & 15, fq = lane >> 4;
    int nit = 0;
    if (MODE == 1 && tid < 32) LCNT[tid] = 0;
    h16x8 Whi[NET][4], Wlo[NET][4];
#pragma unroll
    for (int et = 0; et < NET; ++et)
#pragma unroll
        for (int s4 = 0; s4 < 4; ++s4)
#pragma unroll
            for (int j = 0; j < 8; ++j) {
                const int k = 128 * w + 32 * s4 + 8 * fq + j, e = 16 * et + fr;
                float wv;
                if (MODE == 0) wv = (e < 8) ? p.in[5][(size_t)k * INC + INC_MAIN + e] : 0.f;
                else wv = p.in[12][(size_t)k * NE + e];
                wv *= 256.f;
                const h16 hi = (h16)wv; Whi[et][s4][j] = hi; Wlo[et][s4][j] = (h16)(wv - (float)hi);
            }
    f32x4 vn[2][4];
#define RP_LOAD(TILE) do { _Pragma("unroll") for (int rr_ = 0; rr_ < 2; ++rr_) { const size_t ro_ = (size_t)((TILE) * 16 + 2 * w + rr_) * D; \
        _Pragma("unroll") for (int j_ = 0; j_ < 4; ++j_) { if (MODE == 0) vn[rr_][j_] = *((const f32x4*)(xin + ro_) + lane + 64 * j_); \
            else { const h16x4 t_ = *((const h16x4*)(x1h + ro_) + lane + 64 * j_); vn[rr_][j_] = (f32x4){(float)t_[0], (float)t_[1], (float)t_[2], (float)t_[3]}; } } } } while (0)
    if ((int)blockIdx.x < T / 16) RP_LOAD(blockIdx.x);
    for (int tile = blockIdx.x; tile < T / 16; tile += gridDim.x) {
        f32x4 v[2][4]; float ss[2];
#pragma unroll
        for (int rr = 0; rr < 2; ++rr)
#pragma unroll
            for (int j = 0; j < 4; ++j) v[rr][j] = vn[rr][j];
        if (tile + (int)gridDim.x < T / 16) RP_LOAD(tile + gridDim.x);
#pragma unroll
        for (int rr = 0; rr < 2; ++rr) {
            float a = 0.f;
#pragma unroll
            for (int j = 0; j < 4; ++j) a += v[rr][j][0] * v[rr][j][0] + v[rr][j][1] * v[rr][j][1] + v[rr][j][2] * v[rr][j][2] + v[rr][j][3] * v[rr][j][3];
            ss[rr] = rsqrtf(wave_sum(a) * (1.f / D) + EPS);
        }
        {
            const int b = (tile * 16) / SEQ;
            const float* shift = mod + b * 6144 + (MODE == 0 ? 0 : 3072); const float* scale = shift + 1024;
#pragma unroll
            for (int j = 0; j < 4; ++j) {
                const int col = 256 * j + 4 * lane;
                const f32x4 w4 = *(const f32x4*)(nw + col), sc = *(const f32x4*)(scale + col), sh = *(const f32x4*)(shift + col);
#pragma unroll
                for (int rr = 0; rr < 2; ++rr) {
                    const int rl = 2 * w + rr;
                    h16x4 hi4, lo4;
                    float hvv[4];
#pragma unroll
                    for (int i = 0; i < 4; ++i) { const float hv = v[rr][j][i] * ss[rr] * w4[i] * (1.f + sc[i]) + sh[i]; hvv[i] = hv; const h16 hi = (h16)hv; hi4[i] = hi; lo4[i] = (h16)(hv - (float)hi); }
                    if (MODE == 0) *(h16x4*)(hout + (size_t)(tile * 16 + rl) * D + col) = hi4;
                    else ((unsigned*)(p.ws + WS_H16))[((size_t)(tile * 16 + rl) * D + col) >> 2] = pack_fp8x4(hvv[0] * FP8_SA, hvv[1] * FP8_SA, hvv[2] * FP8_SA, hvv[3] * FP8_SA);
                    *(h16x4*)(HI + rl * RS + col) = hi4;
                    *(h16x4*)(LO + rl * RS + col) = lo4;
                }
            }
        }
        __syncthreads();
        {
            f32x4 acc[NET];
#pragma unroll
            for (int et = 0; et < NET; ++et) acc[et] = (f32x4){0.f, 0.f, 0.f, 0.f};
#pragma unroll
            for (int s4 = 0; s4 < 4; ++s4) {
                const h16x8 bh = *(const h16x8*)(HI + fr * RS + 128 * w + 32 * s4 + 8 * fq);
                const h16x8 bl = *(const h16x8*)(LO + fr * RS + 128 * w + 32 * s4 + 8 * fq);
#pragma unroll
                for (int et = 0; et < NET; ++et) {
                    acc[et] = __builtin_amdgcn_mfma_f32_16x16x32_f16(Whi[et][s4], bh, acc[et], 0, 0, 0);
                    acc[et] = __builtin_amdgcn_mfma_f32_16x16x32_f16(Wlo[et][s4], bh, acc[et], 0, 0, 0);
                    acc[et] = __builtin_amdgcn_mfma_f32_16x16x32_f16(Whi[et][s4], bl, acc[et], 0, 0, 0);
                }
            }
#pragma unroll
            for (int et = 0; et < NET; ++et)
#pragma unroll
                for (int i = 0; i < 4; ++i) PART[(w * 32 + 16 * et + 4 * fq + i) * 16 + fr] = acc[et][i];
        }
        __syncthreads();
        if (tid < 16 * 16 * NET) {
            const int e = tid >> 4, rl = tid & 15; float a = 0.f;
#pragma unroll
            for (int q = 0; q < 8; ++q) a += PART[(q * 32 + e) * 16 + rl];
            a *= (1.f / 256.f);
            if (MODE == 0) { if (e < 8) ((float*)(p.ws + WS_BA))[(size_t)(tile * 16 + rl) * 8 + e] = a; }
            else LOGIT[rl * 33 + e] = a + p.in[13][e];
        }
        if (MODE == 1) {
            __syncthreads();
            {
                const int rl = 2 * w + (lane >> 5), e = lane & 31, row = tile * 16 + rl;
                float v = LOGIT[rl * 33 + e];
                float tv[4]; int te[4];
#pragma unroll
                for (int k = 0; k < 4; ++k) {
                    float bv = v; int bi = e;
#pragma unroll
                    for (int o = 1; o < 32; o <<= 1) { const float ov = __shfl_xor(bv, o); const int oi = __shfl_xor(bi, o); const bool take = (ov > bv) || (ov == bv && oi < bi); bv = take ? ov : bv; bi = take ? oi : bi; }
                    tv[k] = bv; te[k] = bi; if (e == bi) v = -INFINITY;
                }
                float ex[4]; float sum = 0.f;
#pragma unroll
                for (int k = 0; k < 4; ++k) { ex[k] = __expf(tv[k] - tv[0]); sum += ex[k]; }
                if (e < 4) {
                    const int ek = (e == 0) ? te[0] : (e == 1) ? te[1] : (e == 2) ? te[2] : te[3];
                    const float gk = ((e == 0) ? ex[0] : (e == 1) ? ex[1] : (e == 2) ? ex[2] : ex[3]) / sum;
                    const int lpos = atomicAdd(LCNT + ek, 1);
                    LIST[nit * 64 + rl * 4 + e] = (ek << 16) | lpos;
                    ((int*)(p.ws + WS_ASG_E))[row * 4 + e] = ek; ((float*)(p.ws + WS_ASG_G))[row * 4 + e] = gk;
                }
            }
        }
        ++nit;
    }
    if (MODE == 1) {
        __syncthreads();
        if (tid < 32) GB[tid] = atomicAdd((int*)(p.ws + WS_CTL) + tid, LCNT[tid]);
        __syncthreads();
        int* tok = (int*)(p.ws + WS_TOK); int* asg_p = (int*)(p.ws + WS_ASG_P);
        for (int idx = tid; idx < nit * 64; idx += NTHREADS) {
            const int pk = LIST[idx], e = pk >> 16, pos = GB[e] + (pk & 0xffff);
            const int row = (blockIdx.x + (idx >> 6) * gridDim.x) * 16 + ((idx & 63) >> 2);
            asg_p[row * 4 + (idx & 3)] = pos; tok[(size_t)e * T + pos] = row;
        }
    }
}

#define XB_TMO      128
#define XB_XCNT(j)  (256  + 64 * (j))
#define XB_XSUB(j)  (1280 + 64 * (j))
#define XB_XGEN(j)  (2304 + 64 * (j))
#define XB_TOP      3328
#define XB_TOPGEN   3392
#define XB_EXIT     3456
#define XCD_BAR_WORDS 3520
#define XB_SPIN_CAP (1u << 22)
__device__ __forceinline__ unsigned xb_ld(unsigned* p)              { return __hip_atomic_load(p, __ATOMIC_RELAXED, __HIP_MEMORY_SCOPE_AGENT); }
__device__ __forceinline__ unsigned xb_add(unsigned* p, unsigned v) { return __hip_atomic_fetch_add(p, v, __ATOMIC_RELAXED, __HIP_MEMORY_SCOPE_AGENT); }
__device__ __forceinline__ unsigned xb_xcc_id() { return (unsigned)__builtin_amdgcn_s_getreg((3 << 11) | 20) & 0xFu; }
#define XB_SPIN(cond, bar) do { unsigned _sp = 0; while (cond) { __builtin_amdgcn_s_sleep(1); \
    if ((++_sp & 255u) == 0u) { if (xb_ld(&(bar)[XB_TMO])) break; if (_sp > XB_SPIN_CAP) { atomicAdd(&(bar)[XB_TMO], 1u); break; } } } } while (0)
__device__ unsigned g_xbar[XCD_BAR_WORDS];
__device__ __forceinline__ void xcd_barrier_retire(unsigned* bar) {
    const unsigned old = xb_add(&bar[XB_EXIT], 1u);
    if (old + 1u == gridDim.x * gridDim.y * gridDim.z) {
        __hip_atomic_store(&bar[XB_TMO], 0u, __ATOMIC_RELAXED, __HIP_MEMORY_SCOPE_AGENT);
        for (unsigned j = 0; j < 16; ++j) { __hip_atomic_store(&bar[XB_XCNT(j)], 0u, __ATOMIC_RELAXED, __HIP_MEMORY_SCOPE_AGENT); __hip_atomic_store(&bar[XB_XSUB(j)], 0u, __ATOMIC_RELAXED, __HIP_MEMORY_SCOPE_AGENT);
            __hip_atomic_store(&bar[XB_XGEN(j)], 0u, __ATOMIC_RELAXED, __HIP_MEMORY_SCOPE_AGENT); }
        __hip_atomic_store(&bar[XB_TOP], 0u, __ATOMIC_RELAXED, __HIP_MEMORY_SCOPE_AGENT); __hip_atomic_store(&bar[XB_TOPGEN], 0u, __ATOMIC_RELAXED, __HIP_MEMORY_SCOPE_AGENT);
        __hip_atomic_store(&bar[XB_EXIT], 0u, __ATOMIC_RELAXED, __HIP_MEMORY_SCOPE_AGENT);
    }
}
struct XcdBarrier { unsigned* bar; unsigned x; volatile __attribute__((address_space(3))) unsigned* st; };
__device__ __forceinline__ XcdBarrier xcd_barrier_post(unsigned* bar, volatile __attribute__((address_space(3))) unsigned* st) {
    XcdBarrier b; b.bar = bar; b.x = xb_xcc_id(); b.st = st;
    if (threadIdx.x == 0) (void)xb_add(&bar[XB_XCNT(b.x)], 1u);
    return b;
}
__device__ __forceinline__ void xcd_barrier_complete(unsigned* bar, unsigned x, unsigned& nloc, unsigned& nx) {
    const unsigned G = gridDim.x * gridDim.y * gridDim.z;
    unsigned sum, cnt, mine, sp = 0u;
    for (;;) {
        sum = 0u; cnt = 0u; mine = 0u;
#pragma unroll
        for (unsigned j = 0; j < 16; ++j) { const unsigned c = xb_ld(&bar[XB_XCNT(j)]); sum += c; cnt += (c > 0u) ? 1u : 0u; mine = (j == x) ? c : mine; }
        if (sum == G) break;
        __builtin_amdgcn_s_sleep(1);
        if ((++sp & 255u) == 0u) { if (xb_ld(&bar[XB_TMO])) break; if (sp > XB_SPIN_CAP) { atomicAdd(&bar[XB_TMO], 1u); break; } }
    }
    nloc = mine > 0u ? mine : 1u; nx = cnt > 0u ? cnt : 1u;
}
__device__ __forceinline__ void xcd_barrier(const XcdBarrier& b) {
    asm volatile("s_waitcnt vmcnt(0)" ::: "memory");
    __syncthreads();
    if (threadIdx.x == 0) {
        unsigned* bar = b.bar;
        __builtin_amdgcn_s_waitcnt(0);
        unsigned nloc = b.st[0], nx = b.st[1];
        if (nloc == 0u) { xcd_barrier_complete(bar, b.x, nloc, nx); b.st[0] = nloc; b.st[1] = nx; }
        const unsigned old = xb_add(&bar[XB_XSUB(b.x)], 1u);
        const unsigned gen = old / nloc;
        if (old + 1u == (gen + 1u) * nloc) {
            __builtin_amdgcn_fence(__ATOMIC_RELEASE, "agent");
            asm volatile("s_waitcnt vmcnt(0)" ::: "memory");
            const unsigned og = xb_add(&bar[XB_TOP], 1u);
            const unsigned tg = og / nx;
            if (og + 1u == (tg + 1u) * nx) xb_add(&bar[XB_TOPGEN], 1u);
            else XB_SPIN(xb_ld(&bar[XB_TOPGEN]) == tg, bar);
            __builtin_amdgcn_fence(__ATOMIC_ACQUIRE, "agent");
            xb_add(&bar[XB_XGEN(b.x)], 1u);
            asm volatile("s_waitcnt vmcnt(0)" ::: "memory");
        } else {
            XB_SPIN(xb_ld(&bar[XB_XGEN(b.x)]) == gen, bar);
            __builtin_amdgcn_fence(__ATOMIC_ACQUIRE, "agent");
            asm volatile("s_waitcnt vmcnt(0)" ::: "memory");
        }
    }
    __syncthreads();
}

__global__ void __launch_bounds__(NTHREADS) fwd_megakernel(Params p) {
    extern __shared__ __attribute__((aligned(16))) unsigned char lds_raw[];
    float* lds = (float*)lds_raw;
    volatile LAS3 unsigned* misc = (volatile LAS3 unsigned*)((LAS3 unsigned char*)lds_raw + LDS_MISC);
    if (threadIdx.x < 2) misc[threadIdx.x] = 0u;
    __syncthreads();
    const XcdBarrier gbar = xcd_barrier_post(g_xbar, misc);
#define GSYNC() xcd_barrier(gbar)
    LAS3 unsigned char* l3 = (LAS3 unsigned char*)lds_raw;
#define REPS(k) for (int rep_ = 0; rep_ < ((PROBE == (k)) ? 2 : 1); ++rep_)
    REPS(1) { phase_mod(p, lds); phase_cvt(p, lds, 0, blockIdx.x, gridDim.x); GSYNC(); }
    REPS(2) { phase_rowproj<0>(p, lds_raw); GSYNC(); }
    REPS(3) { phase_inproj_m(p, l3); GSYNC(); }
    REPS(5) { phase_dnchunk2(p, lds_raw); GSYNC(); }
    for (int rep_ = 0; rep_ < ((PROBE == 6 || (PROBE >= 61 && PROBE <= 64)) ? 2 : 1); ++rep_) {
        const int nscan = 2 * NB * DH;
        if (gridDim.x >= 2 * nscan) {
            if (blockIdx.x < nscan) { if (!((PROBE == 62 || PROBE == 63 || PROBE == 64) && rep_)) phase_scan_mfma(p, lds_raw, ((blockIdx.x >> 4) << 3) + (blockIdx.x & 7), (blockIdx.x >> 3) & 1); }
            else if (!(PROBE == 61 && rep_)) {
                const bool cvt_first = ((blockIdx.x >> 3) & 1) != 0;
                if (cvt_first) { if (!(PROBE == 64 && rep_)) phase_cvt(p, lds, 1, blockIdx.x - nscan, gridDim.x - nscan); __syncthreads(); }
                if (!(PROBE == 63 && rep_)) phase_attn_mfma(p, lds_raw, blockIdx.x - nscan, gridDim.x - nscan);
                if (!cvt_first) { __syncthreads(); if (!(PROBE == 64 && rep_)) phase_cvt(p, lds, 1, blockIdx.x - nscan, gridDim.x - nscan); }
            }
        } else {
            for (int sb = blockIdx.x; sb < nscan; sb += gridDim.x) phase_scan_mfma(p, lds_raw, sb >> 1, sb & 1);
            phase_attn_mfma(p, lds_raw, blockIdx.x, gridDim.x); __syncthreads(); phase_cvt(p, lds, 1, blockIdx.x, gridDim.x);
        }
        GSYNC();
    }
    REPS(7) { phase_dnout(p); GSYNC(); }
    REPS(8) { phase_outproj_m(p, l3); GSYNC(); }
    REPS(9) {
        if (rep_) { if (blockIdx.x == 0 && threadIdx.x < 64) ((int*)(p.ws + WS_CTL))[threadIdx.x] = 0; GSYNC(); }
        phase_rowproj<1>(p, lds_raw); GSYNC();
    }
    REPS(10) { phase_moe1_m(p, l3); GSYNC(); }
    REPS(11) { phase_moe2_m(p, l3); GSYNC(); }
    REPS(12) { phase_final(p, lds); if (PROBE == 12) GSYNC(); }
    if (threadIdx.x == 0) xcd_barrier_retire(g_xbar);
}

extern "C" void kernel_launch(void* const* d_in, const int* in_sizes, int n_in, void* d_out, int out_size, void* d_ws, size_t ws_size, hipStream_t stream) {
    static int grid_blocks = 0;
    if (grid_blocks == 0) {
        if (n_in != 19 || out_size != T * D || ws_size < WS_END) { fprintf(stderr, "kernel_launch: unexpected shapes (n_in %d out %d ws %zu)\n", n_in, out_size, ws_size); grid_blocks = -1; return; }
        int dev = 0, cus = 0, per_cu = 0;
        hipGetDevice(&dev);
        hipDeviceGetAttribute(&cus, hipDeviceAttributeMultiprocessorCount, dev);
        hipFuncSetAttribute((const void*)fwd_megakernel, hipFuncAttributeMaxDynamicSharedMemorySize, LDS_BYTES);
        hipOccupancyMaxActiveBlocksPerMultiprocessor(&per_cu, (const void*)fwd_megakernel, NTHREADS, LDS_BYTES);
        if (per_cu < 1) { fprintf(stderr, "kernel_launch: occupancy query says %d blocks/CU\n", per_cu); grid_blocks = -1; return; }
        grid_blocks = cus;
    }
    if (grid_blocks < 0) return;
    Params p{};
    for (int i = 0; i < 19; ++i) p.in[i] = (const float*)d_in[i];
    p.out = (float*)d_out; p.ws = (unsigned char*)d_ws;
    hipLaunchKernelGGL(fwd_megakernel, dim3(grid_blocks), dim3(NTHREADS), LDS_BYTES, stream, p);
    const hipError_t e = hipPeekAtLastError();
    if (e != hipSuccess) fprintf(stderr, "launch failed: %s (grid %d)\n", hipGetErrorString(e), grid_blocks);
}
```

```cpp
#define PROBE 0
#include <hip/hip_runtime.h>
#include <hip/hip_cooperative_groups.h>
#include <cstdio>
#include <cstdint>
namespace cg = cooperative_groups;

typedef _Float16 h16;
typedef _Float16 h16x2 __attribute__((ext_vector_type(2)));
typedef _Float16 h16x4 __attribute__((ext_vector_type(4)));
typedef _Float16 h16x8 __attribute__((ext_vector_type(8)));
typedef float f32x4 __attribute__((ext_vector_type(4)));
typedef float f32x2 __attribute__((ext_vector_type(2)));
typedef float f32x16 __attribute__((ext_vector_type(16)));
typedef unsigned u32x4 __attribute__((ext_vector_type(4)));
typedef unsigned u32x2_t __attribute__((ext_vector_type(2)));

constexpr int D = 1024, NB = 4, SEQ = 8192, T = NB * SEQ;
constexpr int AH = 8, AHD = 64, AW = 512;
constexpr int DH = 4, DKD = 128, DW = 512, DCONV = 1536;
constexpr int INC = 3592, INC_MAIN = 3584;
constexpr int NE = 32, TOPK = 4, FE = 1024;
constexpr int NASG = T * TOPK;
constexpr float EPS = 1e-6f;
constexpr int NTHREADS = 512, NWAVES = 8;

constexpr size_t MiB = (size_t)1 << 20;
constexpr size_t WS_CTL = 0;
constexpr int CW_BAR = 4096; constexpr size_t CTL_ZERO_BYTES = 65536;
constexpr size_t WS_MOD = 1 * MiB;
constexpr size_t WS_BA = 2 * MiB;
constexpr size_t WS_G = 3 * MiB;
constexpr size_t WS_ASG_E = 4 * MiB;
constexpr size_t WS_ASG_P = 4 * MiB + 512 * 1024;
constexpr size_t WS_ASG_G = 5 * MiB;
constexpr size_t WS_TOK = 6 * MiB;
constexpr size_t WS_WIN16 = 16 * MiB;
constexpr size_t WS_WOUT16 = 24 * MiB;
constexpr size_t WS_W116 = 32 * MiB;
constexpr size_t WS_W216 = 160 * MiB;
constexpr size_t WS_H16 = 224 * MiB;
constexpr size_t WS_X1 = 288 * MiB;
constexpr size_t WS_R = 416 * MiB;
constexpr size_t WS_Q16 = WS_R;
constexpr size_t WS_K16 = WS_R + 32 * MiB;
constexpr size_t WS_V16 = WS_R + 64 * MiB;
constexpr size_t WS_DQKV = WS_R + 96 * MiB;
constexpr size_t WS_Z16 = WS_R + 192 * MiB;
constexpr size_t WS_QN = WS_R + 224 * MiB;
constexpr size_t WS_KN = WS_R + 256 * MiB;
constexpr size_t WS_VV = WS_R + 288 * MiB;
constexpr size_t WS_O32 = WS_R + 320 * MiB;
constexpr size_t WS_MIX = WS_R + 384 * MiB;
constexpr size_t WS_ACT = WS_R;
constexpr float FP8_SY = 32.f;
constexpr size_t WS_Y16 = WS_R + 272 * MiB;
constexpr size_t WS_AO = WS_DQKV;
constexpr size_t WS_LSE = WS_QN;
constexpr size_t WS_DNREC = WS_R + 448 * MiB;
constexpr size_t WS_END = WS_R + 592 * MiB;

constexpr int LDS_STAGE = 131072, LDS_TAB = LDS_STAGE, LDS_GTAB = LDS_STAGE + 1024, GTAB_UNITS = 18;
constexpr int LDS_MISC = LDS_GTAB + GTAB_UNITS * 256 * 4;
constexpr int LDS_BYTES = LDS_MISC + 256;
struct Params { const float* in[19]; float* out; unsigned char* ws; };

__device__ __forceinline__ float wave_sum(float v) {
#pragma unroll
    for (int o = 1; o < 64; o <<= 1) v += __shfl_xor(v, o);
    return v;
}
__device__ __forceinline__ float wave_max(float v) {
#pragma unroll
    for (int o = 1; o < 64; o <<= 1) v = fmaxf(v, __shfl_xor(v, o));
    return v;
}
__device__ __forceinline__ int otid() { int t = threadIdx.x; asm volatile("" : "+v"(t)); return t; }
__device__ __forceinline__ unsigned pk_bf16(float lo, float hi) { unsigned r; asm("v_cvt_pk_bf16_f32 %0, %1, %2" : "=v"(r) : "v"(lo), "v"(hi)); return r; }
__device__ __forceinline__ float silu_f(float v) { return v * __builtin_amdgcn_rcpf(1.f + __expf(-v)); }
__device__ __forceinline__ float sigmoid_f(float v) { return __builtin_amdgcn_rcpf(1.f + __expf(-v)); }


namespace pg8 {
#define PG8_LAS __attribute__((address_space(3)))
constexpr int BM = 256, BK = 64, HALF = 128, HTB = HALF * BK * 2, STAGE_BYTES = 8 * HTB, NXCD = 8, WGM = 4;
__device__ __forceinline__ int lds_byte(int r, int c) { const int st = (r >> 4) * 2 + (c >> 5), rr = r & 15, cc = c & 31, ob = rr * 64 + cc * 2; return st * 1024 + (ob ^ (((ob >> 9) & 1) << 5)); }
__device__ __forceinline__ void stage_rc(int b, int& R, int& C) { const int st = b / 1024, sb = b % 1024, swz = sb ^ (((sb >> 9) & 1) << 5); R = (st >> 1) * 16 + swz / 64; C = (st & 1) * 32 + (swz % 64) / 2; }
__device__ __forceinline__ int perm32(int rho) { const int n = rho >> 4, i = rho & 15; return 8 * (i >> 2) + 4 * n + (i & 3); }

struct Unit { int pm, pn, e; };
struct Gemm { const h16* A; const h16* Bt; int N, K; };

struct Order {
    int nM, nN, nwg, G, c; PG8_LAS const int* tstart;
    __device__ __forceinline__ void init(int nM_, int nN_, int G_, int c_, PG8_LAS const int* ts) { nM = nM_; nN = nN_; nwg = nM * nN; G = G_; c = c_; tstart = ts; }
    __device__ __forceinline__ bool next(int i, Unit& u) const {
        const long L = (long)i * G + c; if (L >= nwg) return false;
        int wgid = (int)L; { const int q = nwg / NXCD, r = nwg % NXCD, xcd = wgid % NXCD, off = wgid / NXCD; wgid = (xcd < r ? xcd * (q + 1) : r * (q + 1) + (xcd - r) * q) + off; }
        const int nig = WGM * nN, gid = wgid / nig, fm = gid * WGM, gsz = (nM - fm) < WGM ? (nM - fm) : WGM;
        u.pm = fm + ((wgid % nig) % gsz); u.pn = (wgid % nig) / gsz;
        int e = 0;
        if (tstart) { for (int q = 1; q < 32; ++q) if (tstart[q] <= u.pm) e = q; }
        u.e = e; return true;
    }
};

typedef __bf16 bf16x8_t __attribute__((ext_vector_type(8)));
typedef long l64x2_t __attribute__((ext_vector_type(2)));
typedef int v8i32 __attribute__((ext_vector_type(8)));
typedef int v4i32 __attribute__((ext_vector_type(4)));
#define PG8_CAT8(a, b) __builtin_shufflevector(__builtin_bit_cast(v4i32, a), __builtin_bit_cast(v4i32, b), 0, 1, 2, 3, 4, 5, 6, 7)
template <class Epi, bool GATHER, int EM = 0>
__device__ __forceinline__ void gemm_phase(PG8_LAS unsigned char* lds, const Gemm g, const Order& S, const Epi& E, PG8_LAS const int* gtab) {
    const int tid = otid(), wid = __builtin_amdgcn_readfirstlane(tid >> 6), lane = tid & 63, wr = wid >> 2, wc = wid & 3, fr = lane & 15, fq = lane >> 4;
    constexpr bool BF16 = (EM == 1); constexpr int ES = (EM >= 2) ? 1 : 2;
    const int K = g.K, nt = (K * ES) / (BK * 2);
    unsigned voffB[2]; int RA[2]; unsigned CA2[2];
#pragma unroll
    for (int i = 0; i < 2; ++i) { int R, C; stage_rc(tid * 16 + i * 8192, R, C);
        const int Rb = Epi::NADJ ? ((R >> 5) * 64 + 16 * ((R & 15) >> 2) + 4 * ((R >> 4) & 1) + (R & 3)) : (Epi::PERM ? ((R & ~31) + perm32(R & 31)) : R);
        RA[i] = R; CA2[i] = (unsigned)C * 2u; voffB[i] = (unsigned)(Rb * K) * (unsigned)ES + (unsigned)C * 2u; }
    const size_t kstep = (size_t)(BK * 2);
    const size_t hstep = (size_t)(Epi::NADJ ? 8 : HALF) * K * ES;
    const size_t tstep = 2 * hstep;
    const unsigned ldsw = (unsigned)wid * 1024u;
    const int aoff = lds_byte(wr * 64 + fr, fq * 8), boff = lds_byte(wc * 32 + fr, fq * 8);
#define PG8_SA(b, h) (((b) * 2 + (h)) * HTB)
#define PG8_SB(b, h) ((4 + (b) * 2 + (h)) * HTB)
#define PG8_STAGE(bufoff, gbase, voff) do { _Pragma("unroll") for (int _i = 0; _i < 2; ++_i) \
        __builtin_amdgcn_global_load_lds((const unsigned*)((const char*)(gbase) + (voff)[_i]), (PG8_LAS unsigned*)(lds + (bufoff) + ldsw + _i * 8192), 16, 0, 0); } while (0)
#define PG8_LDA(dst, b, h) do { _Pragma("unroll") for (int m = 0; m < 4; ++m) _Pragma("unroll") for (int k = 0; k < 2; ++k) dst[m][k] = *(const PG8_LAS h16x8*)(lds + PG8_SA(b, h) + aoff + m * 2048 + k * 1024); } while (0)
#define PG8_LDB(dst, b, h) do { _Pragma("unroll") for (int n = 0; n < 2; ++n) _Pragma("unroll") for (int k = 0; k < 2; ++k) dst[n][k] = *(const PG8_LAS h16x8*)(lds + PG8_SB(b, h) + boff + n * 2048 + k * 1024); } while (0)
#define PG8_MMA(ai, bj, At, Bt) do { __builtin_amdgcn_s_setprio(1); _Pragma("unroll") for (int m = 0; m < 4; ++m) _Pragma("unroll") for (int n = 0; n < 2; ++n) { if constexpr (EM == 3) { \
        { const v8i32 a8_ = PG8_CAT8(Bt[n][0], Bt[n][1]), b8_ = PG8_CAT8(At[m][0], At[m][1]); asm volatile("v_mfma_scale_f32_16x16x128_f8f6f4 %0, %1, %2, %0, %3, %3 op_sel_hi:[0,0,0]" : "+v"(acc[ai][bj][m][n]) : "v"(a8_), "v"(b8_), "v"(sc1)); } } else \
        _Pragma("unroll") for (int k = 0; k < 2; ++k) \
        { if constexpr (EM == 2) { const l64x2_t a_ = __builtin_bit_cast(l64x2_t, Bt[n][k]), b_ = __builtin_bit_cast(l64x2_t, At[m][k]); \
              acc[ai][bj][m][n] = __builtin_amdgcn_mfma_f32_16x16x32_fp8_fp8(a_[0], b_[0], acc[ai][bj][m][n], 0, 0, 0); acc[ai][bj][m][n] = __builtin_amdgcn_mfma_f32_16x16x32_fp8_fp8(a_[1], b_[1], acc[ai][bj][m][n], 0, 0, 0); } \
          else if constexpr (BF16) acc[ai][bj][m][n] = __builtin_amdgcn_mfma_f32_16x16x32_bf16(__builtin_bit_cast(bf16x8_t, Bt[n][k]), __builtin_bit_cast(bf16x8_t, At[m][k]), acc[ai][bj][m][n], 0, 0, 0); \
          else acc[ai][bj][m][n] = __builtin_amdgcn_mfma_f32_16x16x32_f16(Bt[n][k], At[m][k], acc[ai][bj][m][n], 0, 0, 0); } } __builtin_amdgcn_s_setprio(0); } while (0)
#define PG8_WAIT_V(n) asm volatile("s_waitcnt vmcnt(" #n ")" ::: "memory")
#define PG8_WAIT_L(n) asm volatile("s_waitcnt lgkmcnt(" #n ")" ::: "memory")
#define PG8_BAR __builtin_amdgcn_s_barrier()
#define PG8_SCHED __builtin_amdgcn_sched_barrier(0)
#define PG8_AOFF(o, u, uix) do { _Pragma("unroll") for (int _h = 0; _h < 2; ++_h) _Pragma("unroll") for (int _i = 0; _i < 2; ++_i) { \
        const int _r = _h * HALF + RA[_i]; const unsigned _src = GATHER ? (unsigned)gtab[(uix) * BM + _r] : (unsigned)((u).pm * BM + _r); \
        o[_h][_i] = _src * (unsigned)(K * ES) + CA2[_i]; } } while (0)
    Unit cur, nxt; int ui = 0;
    if (!S.next(0, cur)) return;
    int sc1 = 0x7F7F7F7F; asm volatile("" : "+v"(sc1));
    f32x4 acc[2][2][4][2];
#pragma unroll
    for (int a = 0; a < 2; ++a)
#pragma unroll
        for (int b = 0; b < 2; ++b)
#pragma unroll
            for (int m = 0; m < 4; ++m)
#pragma unroll
                for (int n = 0; n < 2; ++n) acc[a][b][m][n] = (f32x4){0.f, 0.f, 0.f, 0.f};
    h16x8 At[4][2], B0[2][2], B1[2][2];
    unsigned oc[2][2], on[2][2];
    PG8_AOFF(oc, cur, 0);
    const char* const A0 = (const char*)g.A;
    const char* cB = (const char*)g.Bt + ((size_t)cur.e * g.N + (size_t)cur.pn * BM) * K * ES;
    PG8_STAGE(PG8_SB(0, 0), cB, voffB); PG8_STAGE(PG8_SB(0, 1), cB + hstep, voffB); PG8_STAGE(PG8_SA(0, 0), A0, oc[0]); PG8_STAGE(PG8_SA(0, 1), A0, oc[1]);
    if (wr == 1) PG8_BAR;
    PG8_WAIT_V(2); PG8_BAR;
    PG8_STAGE(PG8_SB(1, 0), cB + kstep, voffB); PG8_STAGE(PG8_SA(1, 0), A0 + kstep, oc[0]); PG8_STAGE(PG8_SB(1, 1), cB + hstep + kstep, voffB);
    PG8_WAIT_V(6); PG8_BAR;
    for (;;) {
        const bool has_next = S.next(ui + 1, nxt);
        const char* nB = cB;
        if (has_next) { nB = (const char*)g.Bt + ((size_t)nxt.e * g.N + (size_t)nxt.pn * BM) * K * ES; PG8_AOFF(on, nxt, ui + 1); }
        else {
#pragma unroll
            for (int h = 0; h < 2; ++h)
#pragma unroll
                for (int i = 0; i < 2; ++i) on[h][i] = oc[h][i];
        }
#pragma unroll 1
        for (int t = 0; t < nt; t += 2) {
            const bool last = (t == nt - 2);
            const char* a1 = A0 + (size_t)(t + 1) * kstep;
            const char* a2 = last ? A0 : A0 + (size_t)(t + 2) * kstep; const char* b2 = last ? nB : cB + (size_t)(t + 2) * kstep;
            const char* a3 = a2 + kstep; const char* b3 = b2 + kstep;
            unsigned o2[2][2];
#pragma unroll
            for (int h = 0; h < 2; ++h)
#pragma unroll
                for (int i = 0; i < 2; ++i) o2[h][i] = last ? on[h][i] : oc[h][i];
            PG8_LDB(B0, 0, 0); PG8_LDB(B1, 0, 1); PG8_SCHED; PG8_LDA(At, 0, 0); PG8_STAGE(PG8_SA(1, 1), a1, oc[1]);
            PG8_WAIT_V(8); PG8_WAIT_L(0); PG8_BAR; PG8_MMA(0, 0, At, B0); PG8_MMA(0, 1, At, B1); PG8_BAR; PG8_SCHED;
            PG8_LDA(At, 0, 1); PG8_STAGE(PG8_SB(0, 0), b2, voffB); PG8_STAGE(PG8_SB(0, 1), b2 + hstep, voffB); PG8_STAGE(PG8_SA(0, 0), a2, o2[0]);
            PG8_WAIT_V(8); PG8_WAIT_L(0); PG8_BAR; PG8_MMA(1, 0, At, B0); PG8_MMA(1, 1, At, B1); PG8_BAR; PG8_SCHED;
            PG8_LDB(B0, 1, 0); PG8_LDB(B1, 1, 1); PG8_SCHED; PG8_LDA(At, 1, 0); PG8_STAGE(PG8_SA(0, 1), a2, o2[1]);
            PG8_WAIT_V(8); PG8_WAIT_L(0); PG8_BAR; PG8_MMA(0, 0, At, B0); PG8_MMA(0, 1, At, B1); PG8_BAR; PG8_SCHED;
            PG8_LDA(At, 1, 1); PG8_STAGE(PG8_SB(1, 0), b3, voffB); PG8_STAGE(PG8_SB(1, 1), b3 + hstep, voffB); PG8_STAGE(PG8_SA(1, 0), a3, o2[0]);
            PG8_WAIT_V(8); PG8_WAIT_L(0); PG8_BAR; PG8_MMA(1, 0, At, B0); PG8_MMA(1, 1, At, B1); PG8_BAR; PG8_SCHED;
        }
        if (wr == 0) PG8_BAR;
        if constexpr (EM == 3) asm volatile("s_nop 15\n\ts_nop 15" ::: "memory");
        E(acc, cur, wr, wc, fr, fq);
        if (!has_next) break;
#pragma unroll
        for (int a = 0; a < 2; ++a)
#pragma unroll
            for (int b = 0; b < 2; ++b)
#pragma unroll
                for (int m = 0; m < 4; ++m)
#pragma unroll
                    for (int n = 0; n < 2; ++n) acc[a][b][m][n] = (f32x4){0.f, 0.f, 0.f, 0.f};
        cur = nxt; cB = nB; ++ui;
#pragma unroll
        for (int h = 0; h < 2; ++h)
#pragma unroll
            for (int i = 0; i < 2; ++i) oc[h][i] = on[h][i];
        if (wr == 1) PG8_BAR;
    }
    PG8_WAIT_V(0);
    PG8_BAR;
#undef PG8_SA
#undef PG8_SB
#undef PG8_STAGE
#undef PG8_LDA
#undef PG8_LDB
#undef PG8_MMA
#undef PG8_WAIT_V
#undef PG8_WAIT_L
#undef PG8_BAR
#undef PG8_SCHED
#undef PG8_AOFF
}
}

__device__ __forceinline__ void phase_mod(const Params& p, float* lds) {
    const float* c = p.in[1]; const float* w = p.in[2]; const float* bias = p.in[3];
    float* mod = (float*)(p.ws + WS_MOD);
    const int tid = otid();
    for (int i = tid; i < 4096; i += NTHREADS) lds[i] = silu_f(c[i]);
    __syncthreads();
    float* red = lds + 4096;
    for (int cb = blockIdx.x; cb < 192; cb += gridDim.x) {
        const int cc = tid & 31, col = cb * 32 + cc, ks = tid >> 5;
        float a0 = 0.f, a1 = 0.f, a2 = 0.f, a3 = 0.f;
#pragma unroll 16
        for (int k = ks * 64; k < ks * 64 + 64; ++k) {
            const float wv = w[(size_t)k * 6144 + col];
            a0 += lds[k] * wv; a1 += lds[1024 + k] * wv; a2 += lds[2048 + k] * wv; a3 += lds[3072 + k] * wv;
        }
        red[(ks * 4 + 0) * 32 + cc] = a0; red[(ks * 4 + 1) * 32 + cc] = a1; red[(ks * 4 + 2) * 32 + cc] = a2; red[(ks * 4 + 3) * 32 + cc] = a3;
        __syncthreads();
        if (tid < 128) {
            const int b = tid >> 5; float s = 0.f;
            for (int q = 0; q < 16; ++q) s += red[(q * 4 + b) * 32 + cc];
            mod[b * 6144 + col] = s + bias[col];
        }
        __syncthreads();
    }
    if (blockIdx.x == 0 && tid < 64) ((int*)(p.ws + WS_CTL))[tid] = 0;
}

constexpr float FP8_SA = 4.f, FP8_SW = 64.f;
__device__ __forceinline__ unsigned pack_fp8x4(float a, float b, float c, float d) {
    int w = 0;
    w = __builtin_amdgcn_cvt_pk_fp8_f32(fminf(fmaxf(a, -448.f), 448.f), fminf(fmaxf(b, -448.f), 448.f), w, false);
    w = __builtin_amdgcn_cvt_pk_fp8_f32(fminf(fmaxf(c, -448.f), 448.f), fminf(fmaxf(d, -448.f), 448.f), w, true);
    return (unsigned)w;
}
constexpr int CW2_TILES = 32 * 16 * 16;
constexpr int CW1_EARLY = 16 * 16 * 32;
struct CvtTile { const float* src; unsigned char* dst; int N, K; };
__device__ __forceinline__ CvtTile cvt_tile_w2(const Params& p, int r) {
    const int e = r / 256, q = r % 256, kb = q / 16, nb = q % 16;
    return CvtTile{p.in[16] + (size_t)e * FE * D + (size_t)(kb * 64) * D + nb * 64, (unsigned char*)(p.ws + WS_W216) + (size_t)e * D * FE + (size_t)(nb * 64) * FE + kb * 64, D, FE};
}
__device__ __forceinline__ CvtTile cvt_tile_w1(const Params& p, int r) {
    const int e = r / 512, q = r % 512, kb = q / 32, nb = q % 32, n0 = nb * 64, hh = n0 / 1024, jj = n0 % 1024, row0 = (jj / 128) * 256 + hh * 128 + (jj % 128);
    return CvtTile{p.in[14] + (size_t)e * D * 2 * FE + (size_t)(kb * 64) * (2 * FE) + n0, (unsigned char*)(p.ws + WS_W116) + (size_t)e * 2 * FE * D + (size_t)row0 * D + kb * 64, 2 * FE, D};
}
__device__ __forceinline__ void cvt_tile_load(const CvtTile& t, int lane, float (&v)[64]) {
#pragma unroll
    for (int k = 0; k < 64; ++k) v[k] = t.src[(size_t)k * t.N + lane];
}
__device__ __forceinline__ void cvt_tile_store(const CvtTile& t, int lane, const float (&v)[64]) {
    unsigned char* dst = t.dst + (size_t)lane * t.K;
#pragma unroll
    for (int q4 = 0; q4 < 4; ++q4) { u32x4 o;
#pragma unroll
        for (int d = 0; d < 4; ++d) o[d] = pack_fp8x4(v[16 * q4 + 4 * d] * FP8_SW, v[16 * q4 + 4 * d + 1] * FP8_SW, v[16 * q4 + 4 * d + 2] * FP8_SW, v[16 * q4 + 4 * d + 3] * FP8_SW);
        *(u32x4*)(dst + 16 * q4) = o; }
}
__device__ __forceinline__ void cvt_tile_pair(const CvtTile& ta, const CvtTile& tb, int lane) {
    float va[64], vb[64];
    cvt_tile_load(ta, lane, va); cvt_tile_load(tb, lane, vb);
    cvt_tile_store(ta, lane, va); cvt_tile_store(tb, lane, vb);
}

constexpr int DN_REC = 73728, DN_NW = 0, DN_QD = 16384, DN_KD = 32768, DN_IN = 49152, DN_U = 57344, DN_GL = 51200;
template <int NS>
__device__ __forceinline__ void dn_conv_load(const h16* dqkv, size_t t0, int n, int hd, int r, int c8, int part, h16x8 (&xr)[NS][4][2]) {
#pragma unroll
    for (int q = 0; q < NS; ++q)
#pragma unroll
        for (int j = 0; j < 4; ++j) {
            const int rr = r + 32 * q; const bool ok = (n * 64 + rr - 3 + j >= 0);
            const h16* rowp = dqkv + (t0 + rr - (ok ? 3 - j : 0)) * DCONV + part * 512 + hd * 128 + c8 * 8;
            const h16x8 x0 = *(const h16x8*)rowp, x1 = *(const h16x8*)(rowp + 64);
#pragma unroll
            for (int i = 0; i < 8; ++i) { xr[q][j][0][i] = ok ? x0[i] : (h16)0.f; xr[q][j][1][i] = ok ? x1[i] : (h16)0.f; }
        }
}
template <int NS>
__device__ __forceinline__ void dn_conv_math(const float* cw, int hd, int r, int c8, int part, const h16x8 (&xr)[NS][4][2], h16* QS, h16* KS, h16* VS) {
#pragma unroll
    for (int q = 0; q < NS; ++q) {
        float acc[16];
#pragma unroll
        for (int i = 0; i < 16; ++i) acc[i] = 0.f;
#pragma unroll
        for (int j = 0; j < 4; ++j) {
            const float* wp = cw + hd * 1536 + j * 384 + part * 128 + c8 * 8;
#pragma unroll
            for (int i4 = 0; i4 < 2; ++i4) { const f32x4 wa = *(const f32x4*)(wp + 4 * i4), wb = *(const f32x4*)(wp + 64 + 4 * i4);
#pragma unroll
                for (int i = 0; i < 4; ++i) { acc[4 * i4 + i] += (float)xr[q][j][0][4 * i4 + i] * wa[i]; acc[8 + 4 * i4 + i] += (float)xr[q][j][1][4 * i4 + i] * wb[i]; } }
        }
        float ssq = 0.f;
#pragma unroll
        for (int i = 0; i < 16; ++i) { acc[i] = silu_f(acc[i]); ssq += acc[i] * acc[i]; }
        float sc = 1.f;
        if (part < 2) { ssq += __shfl_xor(ssq, 1); ssq += __shfl_xor(ssq, 2); ssq += __shfl_xor(ssq, 4); sc = rsqrtf(ssq + EPS) * (part == 0 ? 0.08838834764831845f : 1.f); }
        h16x8 o0, o1;
#pragma unroll
        for (int i = 0; i < 8; ++i) { o0[i] = (h16)(acc[i] * sc); o1[i] = (h16)(acc[8 + i] * sc); }
        h16* dst = (part == 0 ? QS : (part == 1 ? KS : VS)) + (r + 32 * q) * 136 + c8 * 8;
        *(h16x8*)dst = o0; *(h16x8*)(dst + 64) = o1;
    }
}
template <int NS, int PLO, int PHI>
__device__ __forceinline__ void dn_conv_rows(const h16* dqkv, const float* cw, size_t t0, int n, int hd, int r, int c8, h16* QS, h16* KS, h16* VS) {
    static_assert(PLO == 0 && PHI == 3, "q, k, v");
    h16x8 xa[NS][4][2], xb[NS][4][2];
    dn_conv_load<NS>(dqkv, t0, n, hd, r, c8, 0, xa);
    dn_conv_load<NS>(dqkv, t0, n, hd, r, c8, 1, xb);
    dn_conv_math<NS>(cw, hd, r, c8, 0, xa, QS, KS, VS);
    dn_conv_load<NS>(dqkv, t0, n, hd, r, c8, 2, xa);
    dn_conv_math<NS>(cw, hd, r, c8, 1, xb, QS, KS, VS);
    dn_conv_math<NS>(cw, hd, r, c8, 2, xa, QS, KS, VS);
}
__device__ __forceinline__ void dn_gates(const float* ba, const float* A_log, const float* dt_bias, size_t t0, int hd, int lane, float* GC, float* EG, float* BT) {
    const float dbv = ba[(t0 + lane) * 8 + hd], dav = ba[(t0 + lane) * 8 + 4 + hd];
    const float xsp = dav + dt_bias[hd];
    const float sp = (xsp > 20.f) ? xsp : log1pf(__expf(xsp));
    float x = -__expf(A_log[hd]) * sp;
#pragma unroll
    for (int o = 1; o < 64; o <<= 1) { const float y = __shfl_up(x, o); if (lane >= o) x += y; }
    GC[lane] = x; EG[lane] = __expf(x); BT[lane] = sigmoid_f(dbv);
    GC[192 + lane] = __expf(__shfl(x, 63) - x);
}
__device__ __forceinline__ void phase_dnchunk2(const Params& p, unsigned char* lds) {
    const h16* dqkv = (const h16*)(p.ws + WS_DQKV); const float* ba = (const float*)(p.ws + WS_BA);
    const float* A_log = p.in[7]; const float* dt_bias = p.in[8];
    h16* QS = (h16*)lds; h16* KS = (h16*)(lds + 17408); h16* VS = (h16*)(lds + 34816);
    float* KKA = (float*)(lds + 52224); float* QKA = (float*)(lds + 69632);
    h16* UL = (h16*)(lds + 87040); h16* WL = (h16*)(lds + 104448);
    float* GC = (float*)(lds + 121856); float* BT = GC + 64; float* EG = GC + 128;
    const int tid0 = otid(), wave = __builtin_amdgcn_readfirstlane(tid0 >> 6);
    constexpr int NITEM = NB * DH * (SEQ / 64);
    static_assert(NITEM * 4 == CW2_TILES && NITEM * 4 == CW1_EARLY, "each chunk item's solve step converts four w2 tiles and four w1 tiles (two of each per idle wave)");
    float* CWS = (float*)(lds + 122880);
    { const float* cwg = p.in[6];
      for (int i = tid0; i < 4 * 1536; i += NTHREADS) { const int hq = i / 1536, q = i % 1536, j = q / 384, c = q % 384; CWS[i] = cwg[j * DCONV + (c >> 7) * 512 + hq * 128 + (c & 127)]; }
      __syncthreads(); }
    const float* cw = CWS;
    if ((int)blockIdx.x < NITEM) {
        const int item = blockIdx.x, bh = item >> 7, n = item & 127; const size_t t0 = (size_t)(bh >> 2) * SEQ + n * 64;
        dn_conv_rows<1, 0, 3>(dqkv, cw, t0, n, bh & 3, tid0 >> 3, tid0 & 7, QS, KS, VS);
        if (wave == 0) dn_gates(ba, A_log, dt_bias, t0, bh & 3, tid0 & 63, GC, EG, BT);
    }
    __syncthreads();
    for (int item = blockIdx.x; item < NITEM; item += gridDim.x) {
        int tid = tid0; asm volatile("" : "+v"(tid));
        const int lane = tid & 63;
        unsigned char* rec = p.ws + WS_DNREC + (size_t)item * DN_REC;
        if (wave < 6) {
            const int kind = wave / 3, tl = wave - 3 * kind, I = (tl >= 1) ? 1 : 0, J = (tl == 2) ? 1 : 0, r32 = lane & 31, hh = lane >> 5;
            const h16* Ar = (kind == 0 ? KS : QS) + (32 * I + r32) * 136 + 8 * hh; const h16* Br = KS + (32 * J + r32) * 136 + 8 * hh;
            f32x16 acc;
#pragma unroll
            for (int i = 0; i < 16; ++i) acc[i] = 0.f;
#pragma unroll
            for (int s8 = 0; s8 < 8; ++s8) acc = __builtin_amdgcn_mfma_f32_32x32x16_f16(*(const h16x8*)(Ar + 16 * s8), *(const h16x8*)(Br + 16 * s8), acc, 0, 0, 0);
            const int j = 32 * J + r32; const float gj = GC[j];
            if (kind == 0) {
#pragma unroll
                for (int g4 = 0; g4 < 4; ++g4) {
                    f32x4 o;
#pragma unroll
                    for (int q = 0; q < 4; ++q) { const int i = 32 * I + 8 * g4 + 4 * hh + q; o[q] = (j < i) ? acc[4 * g4 + q] * __expf(GC[i] - gj) * BT[i] : 0.f; }
                    *(f32x4*)(KKA + j * 68 + 32 * I + 8 * g4 + 4 * hh) = o;
                }
            } else {
#pragma unroll
                for (int reg = 0; reg < 16; ++reg) {
                    const int i = 32 * I + (reg & 3) + 8 * (reg >> 2) + 4 * hh;
                    QKA[i * 68 + j] = (j <= i) ? acc[reg] * __expf(GC[i] - gj) : 0.f;
                }
            }
        } else if (wave == 6) {
            for (int idx = lane; idx < 1024; idx += 64) KKA[(32 + (idx >> 5)) * 68 + (idx & 31)] = 0.f;
        } else {
            for (int idx = lane; idx < 1024; idx += 64) QKA[(idx >> 5) * 68 + 32 + (idx & 31)] = 0.f;
        }
        __syncthreads();
        const float gclast = GC[63];
        for (int pc = tid; pc < 2560; pc += NTHREADS) {
            h16x8 o; int off;
            if (pc < 1024) {
                const int fs = pc >> 6, l = pc & 63, mt = fs >> 3, s8 = fs & 7, r = l & 31, hh = l >> 5, c = 32 * mt + r;
                const h16* sp = QS + c * 136 + 16 * s8 + 4 * hh;
                const h16x4 lo = *(const h16x4*)sp, hi = *(const h16x4*)(sp + 8);
                const float sc = EG[c];
#pragma unroll
                for (int j = 0; j < 4; ++j) { o[j] = (h16)((float)lo[j] * sc); o[4 + j] = (h16)((float)hi[j] * sc); }
                off = DN_QD + pc * 16;
            } else if (pc < 2048) {
                const int q = pc - 1024, fs = q >> 6, l = q & 63, kt = fs >> 2, s4 = fs & 3, r = l & 31, hh = l >> 5, dk = 32 * kt + r;
#pragma unroll
                for (int j = 0; j < 8; ++j) { const int c = 16 * s4 + 8 * (j >> 2) + 4 * hh + (j & 3); o[j] = (h16)((float)KS[c * 136 + dk] * GC[192 + c]); }
                off = DN_KD + q * 16;
            } else {
                const int q = pc - 2048, fs = q >> 6, l = q & 63, mt = fs >> 2, s4 = fs & 3, r = l & 31, hh = l >> 5, c = 32 * mt + r;
#pragma unroll
                for (int j = 0; j < 8; ++j) { const int c2 = 16 * s4 + 8 * (j >> 2) + 4 * hh + (j & 3); o[j] = (h16)QKA[c * 68 + c2]; }
                off = DN_IN + q * 16;
                if (fs == 2 && l == 0) { const unsigned gb = __float_as_uint(__expf(gclast)); const unsigned short lo16 = (unsigned short)(gb & 0xffffu), hi16 = (unsigned short)(gb >> 16);
                    o[0] = __builtin_bit_cast(h16, lo16); o[1] = __builtin_bit_cast(h16, hi16); }
            }
            *(h16x8*)(rec + off) = o;
        }
        for (int idx = tid; idx < 4096; idx += NTHREADS) {
            const int i = idx >> 6, c4 = (idx & 63) * 4; const bool wpart = c4 >= 128; const int dd = c4 & 127;
            const h16x4 sv = *(const h16x4*)((wpart ? KS : VS) + i * 136 + dd);
            const float sc = wpart ? BT[i] * EG[i] : BT[i];
            h16x4 o; o[0] = (h16)((float)sv[0] * sc); o[1] = (h16)((float)sv[1] * sc); o[2] = (h16)((float)sv[2] * sc); o[3] = (h16)((float)sv[3] * sc);
            *(h16x4*)((wpart ? WL : UL) + i * 136 + dd) = o;
        }
        __syncthreads();
        if (wave < 2) {
            const int d = tid & 127;
            h16* dU = UL + d; h16* dW = WL + d;
            int zl = 0; asm volatile("" : "+v"(zl));
            const float* Ab = KKA + zl;
            f32x2 XU[32], XW[32];
#pragma unroll
            for (int m = 0; m < 32; ++m) { XU[m][0] = (float)dU[(2 * m) * 136]; XU[m][1] = (float)dU[(2 * m + 1) * 136]; XW[m][0] = (float)dW[(2 * m) * 136]; XW[m][1] = (float)dW[(2 * m + 1) * 136]; }
#pragma unroll
            for (int j = 0; j < 64; ++j) {
                const float xu = XU[j / 2][j & 1], xw = XW[j / 2][j & 1];
                dU[j * 136] = (h16)xu; dW[j * 136] = (h16)(-xw);
                const f32x2 xu2 = (f32x2){xu, xu}, xw2 = (f32x2){xw, xw};
#pragma unroll
                for (int i4 = ((j + 1) & ~3); i4 < 64; i4 += 4) {
                    const f32x4 av = *(const f32x4*)(Ab + j * 68 + i4);
                    const f32x2 a01 = (f32x2){av[0], av[1]}, a23 = (f32x2){av[2], av[3]};
                    XU[i4 / 2] -= a01 * xu2; XU[i4 / 2 + 1] -= a23 * xu2;
                    XW[i4 / 2] -= a01 * xw2; XW[i4 / 2 + 1] -= a23 * xw2;
                }
                if ((j & 7) == 7) asm volatile("" ::: "memory");
            }
        } else if (wave == 4 || wave == 5) {
            if (wave == 4 && item + (int)gridDim.x < NITEM) { const int nitem = item + gridDim.x, bh = nitem >> 7, n = nitem & 127; const size_t t0 = (size_t)(bh >> 2) * SEQ + n * 64;
                dn_gates(ba, A_log, dt_bias, t0, bh & 3, lane, GC, EG, BT); }
            { const int ws = item * 2 + (wave - 4);
              cvt_tile_pair(cvt_tile_w2(p, 2 * ws), cvt_tile_w2(p, 2 * ws + 1), lane);
              cvt_tile_pair(cvt_tile_w1(p, 2 * ws), cvt_tile_w1(p, 2 * ws + 1), lane); }
        } else if (wave >= 2 && item + (int)gridDim.x < NITEM) {
            const int nitem = item + gridDim.x, bh = nitem >> 7, n = nitem & 127; const size_t t0 = (size_t)(bh >> 2) * SEQ + n * 64;
            const int lt = (wave < 4) ? tid - 128 : tid - 256;
            dn_conv_rows<2, 0, 3>(dqkv, cw, t0, n, bh & 3, lt >> 3, lt & 7, QS, KS, VS);
        }
        __syncthreads();
        for (int pc = tid; pc < 2048; pc += NTHREADS) {
            h16x8 o; int off;
            if (pc < 1024) {
                const int fs = pc >> 6, l = pc & 63, mt = fs >> 3, s8 = fs & 7, r = l & 31, hh = l >> 5, c = 32 * mt + r;
                const h16* sp = WL + c * 136 + 16 * s8 + 4 * hh;
                const h16x4 lo = *(const h16x4*)sp, hi = *(const h16x4*)(sp + 8);
#pragma unroll
                for (int j = 0; j < 4; ++j) { o[j] = lo[j]; o[4 + j] = hi[j]; }
                off = DN_NW + pc * 16;
            } else {
                const int q = pc - 1024, half8 = q & 1, l = (q >> 1) & 63, ms = q >> 7, mt = ms >> 2, sl = ms & 3, col = l & 31, hh = l >> 5;
#pragma unroll
                for (int j = 0; j < 8; ++j) { const int i = 8 * half8 + j; const int c = 32 * mt + (i & 3) + 8 * (i >> 2) + 4 * hh; o[j] = UL[c * 136 + 32 * sl + col]; }
                off = DN_U + q * 16;
            }
            *(h16x8*)(rec + off) = o;
        }
    }
}

__device__ __forceinline__ void cvt_frags(const f32x16& a, h16x8& f0, h16x8& f1) {
#pragma unroll
    for (int j = 0; j < 8; ++j) { f0[j] = (h16)a[j]; f1[j] = (h16)a[8 + j]; }
}
__device__ __forceinline__ void phase_scan_mfma(const Params& p, unsigned char* lds, int bh, int half) {
    const int tid = otid(), lane = tid & 63, wave = __builtin_amdgcn_readfirstlane(tid >> 6);
    const unsigned char* recs = p.ws + WS_DNREC + (size_t)bh * 128 * DN_REC;
    constexpr int NCH = SEQ / 64;
    if (wave >= 2) {
        const int lt = tid - 128;
        u32x4 R0[12], R1[12], R2[12];
#define DN_LOAD(R, n) do { const u32x4* s_ = (const u32x4*)(recs + (size_t)(n) * DN_REC) + lt; _Pragma("unroll") for (int k = 0; k < 12; ++k) R[k] = s_[k * 384]; } while (0)
#define DN_WRITE(R, n) do { u32x4* d_ = (u32x4*)(lds + ((n) & 1) * DN_REC) + lt; _Pragma("unroll") for (int k = 0; k < 12; ++k) d_[k * 384] = R[k]; } while (0)
        DN_LOAD(R0, 0); DN_WRITE(R0, 0); DN_LOAD(R1, 1); DN_LOAD(R2, 2);
        __syncthreads();
        for (int n = 0; n < NCH - 2; n += 3) {
            DN_LOAD(R0, min(n + 3, NCH - 1)); DN_WRITE(R1, n + 1); __syncthreads();
            DN_LOAD(R1, min(n + 4, NCH - 1)); DN_WRITE(R2, n + 2); __syncthreads();
            DN_LOAD(R2, min(n + 5, NCH - 1)); DN_WRITE(R0, n + 3); __syncthreads();
        }
        DN_WRITE(R1, NCH - 1); __syncthreads();
        __syncthreads();
        static_assert((NCH - 2) % 3 == 0 && (NCH - 1) % 3 == 1, "loader schedule assumes NCH = 3k + 2");
#undef DN_LOAD
#undef DN_WRITE
    } else {
        const int sl = 2 * half + wave, hh = lane >> 5;
        h16x2* o16 = (h16x2*)(p.ws + WS_O32);
        f32x16 S[4];
        h16x8 S16[4][2];
#pragma unroll
        for (int kt = 0; kt < 4; ++kt) {
#pragma unroll
            for (int i = 0; i < 16; ++i) S[kt][i] = 0.f;
#pragma unroll
            for (int j = 0; j < 8; ++j) { S16[kt][0][j] = (h16)0.f; S16[kt][1][j] = (h16)0.f; }
        }
        (void)hh;
        __syncthreads();
#define SB() __builtin_amdgcn_sched_barrier(0)
#define LD4(F, o0, o1, o2, o3) do { F[0] = *(const h16x8*)(fb + (o0)); F[1] = *(const h16x8*)(fb + (o1)); F[2] = *(const h16x8*)(fb + (o2)); F[3] = *(const h16x8*)(fb + (o3)); } while (0)
#define LDSEQ(F, base) LD4(F, (base), (base) + 1024, (base) + 2048, (base) + 3072)
#define MM(ACC, A, B) ACC = __builtin_amdgcn_mfma_f32_32x32x16_f16(A, B, ACC, 0, 0, 0)
        unsigned long long tacc_ = 0ull;
        for (int n = 0; n < NCH; ++n) {
            unsigned long long ts0_ = 0ull; if (PROBE == 70) ts0_ = __builtin_amdgcn_s_memtime();
            const unsigned char* buf = lds + (n & 1) * DN_REC;
            const unsigned char* fb = buf + lane * 16;
            h16x8 F0[4], F1[4], F2[4];
            f32x16 VN[2], O[2];
            h16x8 VN16[2][2];
            LDSEQ(F0, DN_NW + 0 * 1024); LDSEQ(F1, DN_NW + 4 * 1024);
            const float gl = *(const float*)(buf + DN_GL);
            h16x8 ur[2][2];
#pragma unroll
            for (int mt = 0; mt < 2; ++mt) { const h16x8* up = (const h16x8*)(buf + DN_U + ((mt * 4 + sl) * 64 + lane) * 32); ur[mt][0] = up[0]; ur[mt][1] = up[1]; }
            const f32x16 Z16 = {0.f, 0.f, 0.f, 0.f, 0.f, 0.f, 0.f, 0.f, 0.f, 0.f, 0.f, 0.f, 0.f, 0.f, 0.f, 0.f};
            SB();
            LDSEQ(F2, DN_NW + 8 * 1024);
            VN[0] = __builtin_amdgcn_mfma_f32_32x32x16_f16(F0[0], S16[0][0], Z16, 0, 0, 0); MM(VN[0], F0[1], S16[0][1]); MM(VN[0], F0[2], S16[1][0]); MM(VN[0], F0[3], S16[1][1]);
            SB();
            LDSEQ(F0, DN_NW + 12 * 1024);
            MM(VN[0], F1[0], S16[2][0]); MM(VN[0], F1[1], S16[2][1]); MM(VN[0], F1[2], S16[3][0]); MM(VN[0], F1[3], S16[3][1]);
            SB();
            LDSEQ(F1, DN_QD + 0 * 1024);
            VN[1] = __builtin_amdgcn_mfma_f32_32x32x16_f16(F2[0], S16[0][0], Z16, 0, 0, 0); MM(VN[1], F2[1], S16[0][1]); MM(VN[1], F2[2], S16[1][0]); MM(VN[1], F2[3], S16[1][1]);
            SB();
            LDSEQ(F2, DN_QD + 4 * 1024);
            MM(VN[1], F0[0], S16[2][0]); MM(VN[1], F0[1], S16[2][1]); MM(VN[1], F0[2], S16[3][0]); MM(VN[1], F0[3], S16[3][1]);
            SB();
            LDSEQ(F0, DN_QD + 8 * 1024);
            O[0] = __builtin_amdgcn_mfma_f32_32x32x16_f16(F1[0], S16[0][0], Z16, 0, 0, 0); MM(O[0], F1[1], S16[0][1]); MM(O[0], F1[2], S16[1][0]); MM(O[0], F1[3], S16[1][1]);
#pragma unroll
            for (int i = 0; i < 16; ++i) { S[0][i] *= gl; S[1][i] *= gl; }
#pragma unroll
            for (int j = 0; j < 8; ++j) { VN[0][j] += (float)ur[0][0][j]; VN[0][8 + j] += (float)ur[0][1][j]; }
            SB();
            LDSEQ(F1, DN_QD + 12 * 1024);
            MM(O[0], F2[0], S16[2][0]); MM(O[0], F2[1], S16[2][1]); MM(O[0], F2[2], S16[3][0]); MM(O[0], F2[3], S16[3][1]);
#pragma unroll
            for (int i = 0; i < 16; ++i) { S[2][i] *= gl; S[3][i] *= gl; }
#pragma unroll
            for (int j = 0; j < 8; ++j) { VN[1][j] += (float)ur[1][0][j]; VN[1][8 + j] += (float)ur[1][1][j]; }
            SB();
            LD4(F2, DN_IN + 0 * 1024, DN_IN + 1 * 1024, DN_IN + 4 * 1024, DN_IN + 5 * 1024);
            O[1] = __builtin_amdgcn_mfma_f32_32x32x16_f16(F0[0], S16[0][0], Z16, 0, 0, 0); MM(O[1], F0[1], S16[0][1]); MM(O[1], F0[2], S16[1][0]); MM(O[1], F0[3], S16[1][1]);
            cvt_frags(VN[0], VN16[0][0], VN16[0][1]);
            SB();
            F0[0] = *(const h16x8*)(fb + DN_IN + 6 * 1024); F0[1] = *(const h16x8*)(fb + DN_IN + 7 * 1024);
            MM(O[1], F1[0], S16[2][0]); MM(O[1], F1[1], S16[2][1]); MM(O[1], F1[2], S16[3][0]); MM(O[1], F1[3], S16[3][1]);
            cvt_frags(VN[1], VN16[1][0], VN16[1][1]);
            SB();
            LDSEQ(F1, DN_KD + 0 * 1024);
            MM(O[0], F2[0], VN16[0][0]); MM(O[0], F2[1], VN16[0][1]); MM(O[1], F2[2], VN16[0][0]); MM(O[1], F2[3], VN16[0][1]);
            SB();
            LDSEQ(F2, DN_KD + 4 * 1024);
            MM(O[1], F0[0], VN16[1][0]); MM(O[1], F0[1], VN16[1][1]);
            SB();
            h16x2* ob = o16 + ((size_t)((bh * NCH + n) * 2) * 4 + sl) * 512 + lane;
            LDSEQ(F0, DN_KD + 8 * 1024);
            MM(S[0], F1[0], VN16[0][0]); MM(S[0], F1[1], VN16[0][1]); MM(S[0], F1[2], VN16[1][0]); MM(S[0], F1[3], VN16[1][1]);
#pragma unroll
            for (int i = 0; i < 8; ++i) { h16x2 t2; t2[0] = (h16)O[0][2 * i]; t2[1] = (h16)O[0][2 * i + 1]; ob[i * 64] = t2; }
            SB();
            LDSEQ(F1, DN_KD + 12 * 1024);
            MM(S[1], F2[0], VN16[0][0]); MM(S[1], F2[1], VN16[0][1]); MM(S[1], F2[2], VN16[1][0]); MM(S[1], F2[3], VN16[1][1]);
#pragma unroll
            for (int i = 0; i < 8; ++i) { h16x2 t2; t2[0] = (h16)O[1][2 * i]; t2[1] = (h16)O[1][2 * i + 1]; ob[2048 + i * 64] = t2; }
            SB();
            MM(S[2], F0[0], VN16[0][0]); MM(S[2], F0[1], VN16[0][1]); MM(S[2], F0[2], VN16[1][0]); MM(S[2], F0[3], VN16[1][1]);
            cvt_frags(S[0], S16[0][0], S16[0][1]);
            SB();
            MM(S[3], F1[0], VN16[0][0]); MM(S[3], F1[1], VN16[0][1]); MM(S[3], F1[2], VN16[1][0]); MM(S[3], F1[3], VN16[1][1]);
            cvt_frags(S[1], S16[1][0], S16[1][1]);
            SB();
            cvt_frags(S[2], S16[2][0], S16[2][1]); cvt_frags(S[3], S16[3][0], S16[3][1]);
            if (PROBE == 70) { asm volatile("s_nop 0" :: "v"(S16[3][1])); tacc_ += __builtin_amdgcn_s_memtime() - ts0_; }
            if (PROBE == 71) ts0_ = __builtin_amdgcn_s_memtime();
            __syncthreads();
            if (PROBE == 71) tacc_ += __builtin_amdgcn_s_memtime() - ts0_;
        }
        if ((PROBE == 70 || PROBE == 71) && bh == 0 && tid == 0) *(float*)(p.ws + WS_CTL + 32768) = 0.02f * floorf((float)tacc_ / (float)NCH / 250.f);
#undef SB
#undef LD4
#undef LDSEQ
#undef MM
    }
}

constexpr int AT_KS_STRIDE = 72, AT_VT_STRIDE = 388, AT_VT_OFF = 384 * AT_KS_STRIDE * 2;
struct AttnUnit { int g, b, hd, dil, r, m0; size_t rowbase; };
__device__ __forceinline__ AttnUnit attn_unit(int u) {
    AttnUnit a; a.g = u >> 10; const int rem = u & 1023, x = (rem >> 3) & 31; a.b = rem >> 8; a.hd = rem & 7;
    a.dil = (a.g == 0) ? 1 : ((a.g == 1) ? 4 : 16); a.r = x & (a.dil - 1); a.m0 = (x / a.dil) * 256; a.rowbase = (size_t)a.b * SEQ + a.r; return a;
}
__device__ __forceinline__ void phase_attn_mfma(const Params& p, unsigned char* lds, int vblock, int nvblocks) {
    const h16* q16 = (const h16*)(p.ws + WS_Q16); const h16* k16 = (const h16*)(p.ws + WS_K16); const h16* v16 = (const h16*)(p.ws + WS_V16);
    h16* ao = (h16*)(p.ws + WS_AO); float* lse = (float*)(p.ws + WS_LSE);
    h16* Ks = (h16*)lds; h16* Vt = (h16*)(lds + AT_VT_OFF);
    const int tid = otid(), lane = tid & 63, w = tid >> 6, ql = lane & 31, hh = lane >> 5;
    h16x8 kr[6], vr[6], qf[4];
#define AT_PREFETCH(U) do { const AttnUnit a_ = attn_unit(U); \
        _Pragma("unroll") for (int k_ = 0; k_ < 6; ++k_) { const int idx_ = tid + 512 * k_, pc_ = idx_ & 7, kk_ = idx_ >> 3, m_ = a_.m0 - 128 + kk_; \
            const size_t go_ = (a_.rowbase + (size_t)(m_ < 0 ? 0 : m_) * a_.dil) * AW + a_.hd * 64 + pc_ * 8; \
            kr[k_] = *(const h16x8*)(k16 + go_); vr[k_] = *(const h16x8*)(v16 + go_); } \
        const size_t qrow_ = a_.rowbase + (size_t)(a_.m0 + 32 * w + ql) * a_.dil; \
        _Pragma("unroll") for (int s_ = 0; s_ < 4; ++s_) qf[s_] = *(const h16x8*)(q16 + qrow_ * AW + a_.hd * 64 + 16 * s_ + 8 * hh); } while (0)
    float bnd0[16], bnd4[16];
#pragma unroll
    for (int i = 0; i < 16; ++i) { const int row = (i & 3) + 8 * (i >> 2) + 4 * hh; bnd0[i] = (row >= ql) ? INFINITY : -INFINITY; bnd4[i] = (row <= ql) ? INFINITY : -INFINITY; }
    int u = vblock;
    if (u < 3 * 1024) AT_PREFETCH(u);
    for (; u < 3 * 1024; u += nvblocks) {
        const AttnUnit au = attn_unit(u);
        const int m0 = au.m0;
        const size_t qrow = au.rowbase + (size_t)(m0 + 32 * w + ql) * au.dil;
        __syncthreads();
#pragma unroll
        for (int k = 0; k < 6; ++k) {
            const int idx = tid + 512 * k, pc = idx & 7, kk = idx >> 3;
            const h16x8 kv = kr[k], vv = vr[k];
            *(h16x8*)(Ks + kk * AT_KS_STRIDE + pc * 8) = kv;
#pragma unroll
            for (int j = 0; j < 8; ++j) Vt[(pc * 8 + j) * AT_VT_STRIDE + kk] = vv[j];
        }
        h16x8 qc[4];
#pragma unroll
        for (int s4 = 0; s4 < 4; ++s4) qc[s4] = qf[s4];
        __syncthreads();
        if (u + nvblocks < 3 * 1024) AT_PREFETCH(u + nvblocks);
        f32x16 St[5];
#pragma unroll
        for (int kt = 0; kt < 5; ++kt) {
#pragma unroll
            for (int i = 0; i < 16; ++i) St[kt][i] = 0.f;
#pragma unroll
            for (int s4 = 0; s4 < 4; ++s4) {
                const h16x8 a = *(const h16x8*)(Ks + (32 * (w + kt) + ql) * AT_KS_STRIDE + 16 * s4 + 8 * hh);
                St[kt] = __builtin_amdgcn_mfma_f32_32x32x16_f16(a, qc[s4], St[kt], 0, 0, 0);
            }
        }
#pragma unroll
        for (int i = 0; i < 16; ++i) { St[0][i] = fminf(St[0][i], bnd0[i]); St[4][i] = fminf(St[4][i], bnd4[i]); }
        if (m0 == 0) {
#pragma unroll
            for (int kt = 0; kt < 4; ++kt)
                if (w + kt < 4) {
#pragma unroll
                    for (int i = 0; i < 16; ++i) St[kt][i] = -INFINITY;
                }
        }
        float mx = -INFINITY;
#pragma unroll
        for (int kt = 0; kt < 5; ++kt)
#pragma unroll
            for (int i = 0; i < 16; ++i) mx = fmaxf(mx, St[kt][i]);
        mx = fmaxf(mx, __shfl_xor(mx, 32));
        float l = 0.f;
        {
            const float c2 = 0.125f * 1.4426950408889634f, mb = -mx * c2;
#pragma unroll
            for (int kt = 0; kt < 5; ++kt)
#pragma unroll
                for (int i = 0; i < 16; ++i) { St[kt][i] = __builtin_amdgcn_exp2f(__builtin_fmaf(St[kt][i], c2, mb)); l += St[kt][i]; }
        }
        l += __shfl_xor(l, 32);
        f32x16 Ot[2];
#pragma unroll
        for (int dt = 0; dt < 2; ++dt)
#pragma unroll
            for (int i = 0; i < 16; ++i) Ot[dt][i] = 0.f;
#pragma unroll
        for (int kt = 0; kt < 5; ++kt) {
            h16x8 pf[2];
            cvt_frags(St[kt], pf[0], pf[1]);
#pragma unroll
            for (int s2 = 0; s2 < 2; ++s2)
#pragma unroll
                for (int dt = 0; dt < 2; ++dt) {
                    const h16* vp = Vt + (32 * dt + ql) * AT_VT_STRIDE + 32 * (w + kt) + 16 * s2 + 4 * hh;
                    const h16x4 lo = *(const h16x4*)vp, hi = *(const h16x4*)(vp + 8);
                    h16x8 a;
#pragma unroll
                    for (int j = 0; j < 4; ++j) { a[j] = lo[j]; a[4 + j] = hi[j]; }
                    Ot[dt] = __builtin_amdgcn_mfma_f32_32x32x16_f16(a, pf[s2], Ot[dt], 0, 0, 0);
                }
        }
        const float inv = __builtin_amdgcn_rcpf(l);
        h16* orow = ao + ((size_t)au.g * T + qrow) * AW + au.hd * 64;
#pragma unroll
        for (int dt = 0; dt < 2; ++dt)
#pragma unroll
            for (int i4 = 0; i4 < 4; ++i4) {
                h16x4 o;
#pragma unroll
                for (int j = 0; j < 4; ++j) o[j] = (h16)(Ot[dt][4 * i4 + j] * inv);
                *(h16x4*)(orow + 32 * dt + 8 * i4 + 4 * hh) = o;
            }
        if (hh == 0) lse[((size_t)au.g * T + qrow) * 8 + au.hd] = 0.125f * mx + __logf(l);
    }
#undef AT_PREFETCH
}

__device__ __forceinline__ void phase_dnout(const Params& p) {
    const float* o32 = (const float*)(p.ws + WS_O32); const h16* z16 = (const h16*)(p.ws + WS_Z16); const float* nw = p.in[9];
    const h16* ao = (const h16*)(p.ws + WS_AO); const float* lse = (const float*)(p.ws + WS_LSE);
    h16* mix = (h16*)(p.ws + WS_MIX);
    const int tid_ = otid(); const int lane = tid_ & 63, wave = tid_ >> 6;
    const int gw = blockIdx.x * NWAVES + wave, NGW = gridDim.x * NWAVES;
    const f32x2 w2 = *(const f32x2*)(nw + 2 * lane);
    for (int row = gw; row < T; row += NGW) {
        const int ah = lane >> 3;
        const float l0 = lse[((size_t)0 * T + row) * 8 + ah], l1 = lse[((size_t)1 * T + row) * 8 + ah], l2 = lse[((size_t)2 * T + row) * 8 + ah];
        const h16x8 a0 = *(const h16x8*)(ao + ((size_t)0 * T + row) * AW + lane * 8), a1 = *(const h16x8*)(ao + ((size_t)1 * T + row) * AW + lane * 8),
                    a2 = *(const h16x8*)(ao + ((size_t)2 * T + row) * AW + lane * 8);
        const int bq = row / SEQ, tp = row % SEQ, nq = tp >> 6, cq = tp & 63, mtq = cq >> 5, cl = cq & 31, h2 = (cl >> 2) & 1, iq = (cl & 3) + 4 * (cl >> 3);
        f32x2 ov[4]; h16x2 zv[4];
#pragma unroll
        for (int hd = 0; hd < 4; ++hd) {
            { const h16x2* op = (const h16x2*)(p.ws + WS_O32) + ((size_t)(((bq * 4 + hd) * (SEQ / 64) + nq) * 2 + mtq) * 4 + (lane >> 4)) * 512 + (iq >> 1) * 64 + h2 * 32 + ((2 * lane) & 31);
              const h16x2 pa = op[0], pb = op[1]; ov[hd][0] = (float)pa[iq & 1]; ov[hd][1] = (float)pb[iq & 1]; }
            zv[hd] = *(const h16x2*)(z16 + (size_t)row * DW + hd * 128 + 2 * lane);
        }
        {
            const float m = fmaxf(l0, fmaxf(l1, l2));
            const float e0 = __expf(l0 - m), e1 = __expf(l1 - m), e2 = __expf(l2 - m), inv = 1.f / (e0 + e1 + e2);
            h16x8 o;
#pragma unroll
            for (int j = 0; j < 8; ++j) o[j] = (h16)((e0 * (float)a0[j] + e1 * (float)a1[j] + e2 * (float)a2[j]) * inv);
            *(h16x8*)(mix + (size_t)row * D + lane * 8) = o;
        }
#pragma unroll
        for (int hd = 0; hd < 4; ++hd) {
            const float rstd = rsqrtf(wave_sum(ov[hd][0] * ov[hd][0] + ov[hd][1] * ov[hd][1]) * (1.f / 128.f) + EPS);
            h16x2 r; r[0] = (h16)(ov[hd][0] * rstd * w2[0] * silu_f((float)zv[hd][0])); r[1] = (h16)(ov[hd][1] * rstd * w2[1] * silu_f((float)zv[hd][1]));
            *(h16x2*)(mix + (size_t)row * D + 512 + hd * 128 + 2 * lane) = r;
        }
    }
}

__device__ __forceinline__ void phase_final(const Params& p, float* lds) {
    int* li = (int*)lds;
    { const int* cnt = (const int*)(p.ws + WS_CTL);
      if (otid() == 0) { int t = 0; for (int e = 0; e < NE; ++e) { li[e] = t * 256; t += (cnt[e] + 255) / 256; } }
      __syncthreads(); }
    const h16* x1 = (const h16*)(p.ws + WS_X1); const float* mod = (const float*)(p.ws + WS_MOD); const float* fw = p.in[18];
    const h16* y = (const h16*)(p.ws + WS_Y16);
    const int* asg_e = (const int*)(p.ws + WS_ASG_E); const int* asg_p = (const int*)(p.ws + WS_ASG_P); const float* asg_g = (const float*)(p.ws + WS_ASG_G);
    const int tid_ = otid(); const int lane = tid_ & 63, wave = tid_ >> 6;
    const int gw = blockIdx.x * NWAVES + wave, NGW = gridDim.x * NWAVES;
    for (int row0 = gw; row0 < T; row0 += 2 * NGW) {
        size_t slot[2][4]; float gk[2][4]; int rows[2];
#pragma unroll
        for (int rr = 0; rr < 2; ++rr) {
            const int row = (row0 + rr * NGW < T) ? row0 + rr * NGW : row0; rows[rr] = row;
            const int4 ae = *(const int4*)(asg_e + row * 4), ap = *(const int4*)(asg_p + row * 4); const f32x4 ag = *(const f32x4*)(asg_g + row * 4);
            slot[rr][0] = (size_t)(li[ae.x] + ap.x); slot[rr][1] = (size_t)(li[ae.y] + ap.y); slot[rr][2] = (size_t)(li[ae.z] + ap.z); slot[rr][3] = (size_t)(li[ae.w] + ap.w);
            gk[rr][0] = ag[0] * (1.f / FP8_SY); gk[rr][1] = ag[1] * (1.f / FP8_SY); gk[rr][2] = ag[2] * (1.f / FP8_SY); gk[rr][3] = ag[3] * (1.f / FP8_SY);
        }
        f32x4 v[2][4]; float ss[2] = {0.f, 0.f};
#pragma unroll
        for (int rr = 0; rr < 2; ++rr) {
            const int row = rows[rr]; const float* gate2 = mod + (row / SEQ) * 6144 + 5120;
#pragma unroll
            for (int j = 0; j < 4; ++j) {
                const int col = 256 * j + 4 * lane;
                f32x4 yv[4];
#pragma unroll
                for (int k = 0; k < 4; ++k) { const int yw = *(const int*)((const unsigned char*)y + slot[rr][k] * D + col);
                    const f32x2 lo = __builtin_amdgcn_cvt_pk_f32_fp8(yw, false), hi = __builtin_amdgcn_cvt_pk_f32_fp8(yw, true); yv[k] = (f32x4){lo[0], lo[1], hi[0], hi[1]}; }
                const h16x4 xh = *(const h16x4*)(x1 + (size_t)row * D + col); const f32x4 xv = (f32x4){(float)xh[0], (float)xh[1], (float)xh[2], (float)xh[3]}, g2 = *(const f32x4*)(gate2 + col);
#pragma unroll
                for (int i = 0; i < 4; ++i) {
                    const float acc = gk[rr][0] * yv[0][i] + gk[rr][1] * yv[1][i] + gk[rr][2] * yv[2][i] + gk[rr][3] * yv[3][i];
                    v[rr][j][i] = xv[i] + g2[i] * acc; ss[rr] += v[rr][j][i] * v[rr][j][i];
                }
            }
        }
#pragma unroll
        for (int rr = 0; rr < 2; ++rr) {
            if (rr == 1 && row0 + NGW >= T) break;
            const float rstd = rsqrtf(wave_sum(ss[rr]) * (1.f / D) + EPS);
#pragma unroll
            for (int j = 0; j < 4; ++j) {
                const int col = 256 * j + 4 * lane; const f32x4 w4 = *(const f32x4*)(fw + col);
                f32x4 o; o[0] = v[rr][j][0] * rstd * w4[0]; o[1] = v[rr][j][1] * rstd * w4[1]; o[2] = v[rr][j][2] * rstd * w4[2]; o[3] = v[rr][j][3] * rstd * w4[3];
                *(f32x4*)(p.out + (size_t)rows[rr] * D + col) = o;
            }
        }
    }
}

struct Cvt8Job { const float* src; unsigned char* dst; int N, K; };
__device__ __forceinline__ void cvt8_load(const Cvt8Job& j, int lane, f32x4 (&v)[16]) {
    const int kr = lane >> 4, n4 = (lane & 15) * 4;
#pragma unroll
    for (int i = 0; i < 16; ++i) v[i] = *(const f32x4*)(j.src + (size_t)(4 * i + kr) * j.N + n4);
}
__device__ __forceinline__ void cvt8_store(const Cvt8Job& jb, int lane, float* scr, const f32x4 (&v)[16]) {
    const int kr = lane >> 4, n4 = (lane & 15) * 4;
#pragma unroll
    for (int i = 0; i < 16; ++i) { float* d = scr + (4 * i + kr) * 65 + n4; d[0] = v[i][0]; d[1] = v[i][1]; d[2] = v[i][2]; d[3] = v[i][3]; }
    asm volatile("s_waitcnt lgkmcnt(0)" ::: "memory");
    const int c = lane & 3;
#pragma unroll
    for (int j = 0; j < 4; ++j) { const int n = (lane >> 2) + 16 * j; const float* sp = scr + (16 * c) * 65 + n;
        u32x4 o;
#pragma unroll
        for (int q = 0; q < 4; ++q) o[q] = pack_fp8x4(sp[(4 * q) * 65] * FP8_SW, sp[(4 * q + 1) * 65] * FP8_SW, sp[(4 * q + 2) * 65] * FP8_SW, sp[(4 * q + 3) * 65] * FP8_SW);
        *(u32x4*)(jb.dst + (size_t)n * jb.K + 16 * c) = o; }
    asm volatile("s_waitcnt lgkmcnt(0)" ::: "memory");
}
template <bool BF>
__device__ __forceinline__ void cvt_item(const float* W, int K, int N, h16* WT, int dst_row0, int k0, int n0, float* scr, int lane) {
    const int kr = lane >> 4, n4 = (lane & 15) * 4;
    f32x4 v[16];
#pragma unroll
    for (int i = 0; i < 16; ++i) v[i] = *(const f32x4*)(W + (size_t)(k0 + 4 * i + kr) * N + n0 + n4);
#pragma unroll
    for (int i = 0; i < 16; ++i) { float* d = scr + (4 * i + kr) * 65 + n4; d[0] = v[i][0]; d[1] = v[i][1]; d[2] = v[i][2]; d[3] = v[i][3]; }
    asm volatile("s_waitcnt lgkmcnt(0)" ::: "memory");
    const int c = lane & 7;
#pragma unroll
    for (int j = 0; j < 8; ++j) { const int n = (lane >> 3) + 8 * j; const float* sp = scr + (8 * c) * 65 + n;
        if constexpr (BF) { u32x4 ob; ob[0] = pk_bf16(sp[0], sp[65]); ob[1] = pk_bf16(sp[2 * 65], sp[3 * 65]); ob[2] = pk_bf16(sp[4 * 65], sp[5 * 65]); ob[3] = pk_bf16(sp[6 * 65], sp[7 * 65]);
            *(u32x4*)(WT + (size_t)(dst_row0 + n) * K + k0 + 8 * c) = ob; }
        else { h16x8 o;
#pragma unroll
            for (int q = 0; q < 8; ++q) o[q] = (h16)sp[q * 65];
            *(h16x8*)(WT + (size_t)(dst_row0 + n) * K + k0 + 8 * c) = o; } }
    asm volatile("s_waitcnt lgkmcnt(0)" ::: "memory");
}
__device__ __forceinline__ Cvt8Job cvt8_job(const Params& p, int r) {
    constexpr int I_W1 = 32 * 16 * 32;
    Cvt8Job j;
    if (r < I_W1) { const int e = r / 512, q = r % 512, kb = q / 32, nb = q % 32, n0 = nb * 64, hh = n0 / 1024, jj = n0 % 1024, row0 = (jj / 128) * 256 + hh * 128 + (jj % 128);
        j.N = 2 * FE; j.K = D; j.src = p.in[14] + (size_t)e * D * 2 * FE + (size_t)(kb * 64) * (2 * FE) + n0;
        j.dst = (unsigned char*)(p.ws + WS_W116) + (size_t)e * 2 * FE * D + (size_t)row0 * D + kb * 64; }
    else { r -= I_W1; const int e = r / 256, q = r % 256, kb = q / 16, nb = q % 16;
        j.N = D; j.K = FE; j.src = p.in[16] + (size_t)e * FE * D + (size_t)(kb * 64) * D + nb * 64;
        j.dst = (unsigned char*)(p.ws + WS_W216) + (size_t)e * D * FE + (size_t)(nb * 64) * FE + kb * 64; }
    return j;
}
__device__ __forceinline__ void phase_cvt(const Params& p, float* lds, int part, int vblock, int nvblocks) {
    const int tid_ = otid(); const int lane = tid_ & 63, wave = tid_ >> 6;
    float* scr = lds + wave * (64 * 65);
    const int gw = vblock * NWAVES + wave, NGW = nvblocks * NWAVES;
    constexpr int I_IN = 16 * 56, I_OUT = 16 * 16, I_W1 = 32 * 16 * 32, I_W2 = 32 * 16 * 16;
    const int it_lo = part == 0 ? 0 : I_IN, it_hi = part == 0 ? I_IN : I_IN + I_OUT;
    for (int it = it_lo + gw; it < it_hi; it += NGW) {
        int r = it;
        if (r < I_IN) { const int kb = r / 56, nb = r % 56; cvt_item<false>(p.in[5], D, INC, (h16*)(p.ws + WS_WIN16), nb * 64, kb * 64, nb * 64, scr, lane); continue; } r -= I_IN;
        { const int kb = r / 16, nb = r % 16; cvt_item<false>(p.in[10], D, D, (h16*)(p.ws + WS_WOUT16), nb * 64, kb * 64, nb * 64, scr, lane); }
    }
    if (part == 1) {
        constexpr int NI = I_W1;
        int it = CW1_EARLY + gw;
        if (it < NI) {
            f32x4 v[16]; Cvt8Job jb = cvt8_job(p, it); cvt8_load(jb, lane, v);
            for (;;) {
                const int nx = it + NGW; const bool more = nx < NI;
                f32x4 vn[16]; const Cvt8Job jn = cvt8_job(p, more ? nx : it);
                cvt8_load(jn, lane, vn);
                cvt8_store(jb, lane, scr, v);
                if (!more) break;
#pragma unroll
                for (int i = 0; i < 16; ++i) v[i] = vn[i];
                jb = jn; it = nx;
            }
        }
    }
}

typedef pg8::Unit PUnit;
struct EpiInProjM {
    static constexpr bool PERM = true, NADJ = false; unsigned char* ws;
    __device__ __forceinline__ void operator()(const f32x4 (&acc)[2][2][4][2], const PUnit& u, int wr, int wc, int fr, int fq) const {
        const int c0 = u.pn * 256; h16* dst; int ld, cc;
        if (c0 < 512) { dst = (h16*)(ws + WS_Q16); ld = 512; cc = c0; }
        else if (c0 < 1024) { dst = (h16*)(ws + WS_K16); ld = 512; cc = c0 - 512; }
        else if (c0 < 1536) { dst = (h16*)(ws + WS_V16); ld = 512; cc = c0 - 1024; }
        else if (c0 < 3072) { dst = (h16*)(ws + WS_DQKV); ld = 1536; cc = c0 - 1536; }
        else { dst = (h16*)(ws + WS_Z16); ld = 512; cc = c0 - 3072; }
        const int col0 = cc + wc * 32 + 8 * fq;
#pragma unroll
        for (int ai = 0; ai < 2; ++ai)
#pragma unroll
            for (int m = 0; m < 4; ++m) { const size_t row = (size_t)u.pm * 256 + ai * 128 + wr * 64 + m * 16 + fr;
#pragma unroll
                for (int bj = 0; bj < 2; ++bj) { h16x8 o;
#pragma unroll
                    for (int n = 0; n < 2; ++n)
#pragma unroll
                        for (int i = 0; i < 4; ++i) o[4 * n + i] = (h16)acc[ai][bj][m][n][i];
                    *(h16x8*)(dst + row * ld + col0 + bj * 128) = o; } }
    }
};
struct EpiOutProjM {
    static constexpr bool PERM = true, NADJ = false; const float* x; const float* mod; h16* x1;
    __device__ __forceinline__ void operator()(const f32x4 (&acc)[2][2][4][2], const PUnit& u, int wr, int wc, int fr, int fq) const {
        const int col0 = u.pn * 256 + wc * 32 + 8 * fq;
#pragma unroll
        for (int ai = 0; ai < 2; ++ai)
#pragma unroll
            for (int m = 0; m < 4; ++m) { const size_t row = (size_t)u.pm * 256 + ai * 128 + wr * 64 + m * 16 + fr; const int b = (int)(row / SEQ);
#pragma unroll
                for (int bj = 0; bj < 2; ++bj) { const int c = col0 + bj * 128; h16x8 o;
#pragma unroll
                    for (int n = 0; n < 2; ++n) { const f32x4 gt = *(const f32x4*)(mod + b * 6144 + 2048 + c + 4 * n); const f32x4 xv = *(const f32x4*)(x + row * D + c + 4 * n);
#pragma unroll
                        for (int i = 0; i < 4; ++i) o[4 * n + i] = (h16)(xv[i] + gt[i] * acc[ai][bj][m][n][i]); }
                    *(h16x8*)(x1 + row * D + c) = o; } }
    }
};
struct EpiSwigluM {
    static constexpr bool PERM = true, NADJ = false; h16* act; const float* b1;
    __device__ __forceinline__ void operator()(const f32x4 (&acc)[2][2][4][2], const PUnit& u, int wr, int wc, int fr, int fq) const {
        const float* bb = b1 + (size_t)u.e * 2 * FE; const int j0 = u.pn * 128 + wc * 32 + 8 * fq;
        f32x4 bg[2], bu[2];
#pragma unroll
        for (int n = 0; n < 2; ++n) { bg[n] = *(const f32x4*)(bb + j0 + 4 * n); bu[n] = *(const f32x4*)(bb + FE + j0 + 4 * n); }
        constexpr float RS = 1.f / (FP8_SA * FP8_SW);
        const f32x2 rs2 = {RS, RS}, ke2 = {-1.702f * 1.44269504089f, -1.702f * 1.44269504089f}, one2 = {1.f, 1.f}, sa2 = {FP8_SA, FP8_SA};
#pragma unroll
        for (int ai = 0; ai < 2; ++ai)
#pragma unroll
            for (int m = 0; m < 4; ++m) { const size_t row = (size_t)u.pm * 256 + ai * 128 + wr * 64 + m * 16 + fr; u32x2_t o;
#pragma unroll
                for (int n = 0; n < 2; ++n) { f32x2 ov[2];
#pragma unroll
                    for (int ip = 0; ip < 2; ++ip) { const int i = 2 * ip;
                        f32x2 gt = (f32x2){acc[ai][0][m][n][i], acc[ai][0][m][n][i + 1]} * rs2 + (f32x2){bg[n][i], bg[n][i + 1]};
                        f32x2 up = (f32x2){acc[ai][1][m][n][i], acc[ai][1][m][n][i + 1]} * rs2 + (f32x2){bu[n][i], bu[n][i + 1]};
                        gt[0] = fminf(gt[0], 7.f); gt[1] = fminf(gt[1], 7.f);
                        up[0] = __builtin_amdgcn_fmed3f(up[0], -7.f, 7.f); up[1] = __builtin_amdgcn_fmed3f(up[1], -7.f, 7.f);
                        f32x2 t = gt * ke2; t[0] = __builtin_amdgcn_exp2f(t[0]); t[1] = __builtin_amdgcn_exp2f(t[1]);
                        t = t + one2; t[0] = __builtin_amdgcn_rcpf(t[0]); t[1] = __builtin_amdgcn_rcpf(t[1]);
                        ov[ip] = (gt * t) * (up * sa2 + sa2); }
                    int w = __builtin_amdgcn_cvt_pk_fp8_f32(ov[0][0], ov[0][1], 0, false); w = __builtin_amdgcn_cvt_pk_fp8_f32(ov[1][0], ov[1][1], w, true);
                    o[n] = (unsigned)w; }
                *(u32x2_t*)((unsigned char*)act + row * FE + j0) = o; }
    }
};
struct EpiDownM {
    static constexpr bool PERM = true, NADJ = true; h16* y; const float* b2;
    __device__ __forceinline__ void operator()(const f32x4 (&acc)[2][2][4][2], const PUnit& u, int wr, int wc, int fr, int fq) const {
        const float* bb = b2 + (size_t)u.e * D; const int col0 = u.pn * 256 + wc * 64 + 16 * fq;
        f32x4 bv[2][2];
#pragma unroll
        for (int bj = 0; bj < 2; ++bj)
#pragma unroll
            for (int n = 0; n < 2; ++n) bv[bj][n] = *(const f32x4*)(bb + col0 + 8 * bj + 4 * n);
#pragma unroll
        for (int ai = 0; ai < 2; ++ai)
#pragma unroll
            for (int m = 0; m < 4; ++m) { const size_t row = (size_t)u.pm * 256 + ai * 128 + wr * 64 + m * 16 + fr; u32x4 o;
#pragma unroll
                for (int bj = 0; bj < 2; ++bj)
#pragma unroll
                    for (int n = 0; n < 2; ++n) { float t[4];
#pragma unroll
                        for (int i = 0; i < 4; ++i) t[i] = acc[ai][bj][m][n][i] * (FP8_SY / (FP8_SA * FP8_SW)) + bv[bj][n][i] * FP8_SY;
                        o[2 * bj + n] = pack_fp8x4(t[0], t[1], t[2], t[3]); }
                *(u32x4*)((unsigned char*)y + row * D + col0) = o; }
    }
};
#define LAS3 __attribute__((address_space(3)))
__device__ __forceinline__ void phase_inproj_m(const Params& p, LAS3 unsigned char* lds) {
    for (int i = 0; i < (int)((blockIdx.x >> 3) & 3); ++i) __builtin_amdgcn_s_sleep(64);
    pg8::Order S; S.init(T / 256, INC_MAIN / 256, gridDim.x, blockIdx.x, nullptr);
    pg8::gemm_phase<EpiInProjM, false>(lds, pg8::Gemm{(const h16*)(p.ws + WS_H16), (const h16*)(p.ws + WS_WIN16), INC_MAIN, D}, S, EpiInProjM{p.ws}, nullptr);
}
__device__ __forceinline__ void phase_outproj_m(const Params& p, LAS3 unsigned char* lds) {
    pg8::Order S; S.init(T / 256, D / 256, gridDim.x, blockIdx.x, nullptr);
    pg8::gemm_phase<EpiOutProjM, false>(lds, pg8::Gemm{(const h16*)(p.ws + WS_MIX), (const h16*)(p.ws + WS_WOUT16), D, D}, S,
                                         EpiOutProjM{p.in[0], (const float*)(p.ws + WS_MOD), (h16*)(p.ws + WS_X1)}, nullptr);
}
__device__ __forceinline__ void moe_prefix_m(const Params& p, LAS3 int* tab) {
    const int* cnt = (const int*)(p.ws + WS_CTL);
    const int t_ = otid();
    if (t_ < NE) tab[40 + t_] = cnt[t_];
    __syncthreads();
    if (t_ == 0) { int t = 0; for (int e = 0; e < NE; ++e) { tab[e] = t; t += (tab[40 + e] + 255) / 256; } tab[NE] = t; }
    __syncthreads();
}
__device__ __forceinline__ void phase_moe1_m(const Params& p, LAS3 unsigned char* lds) {
    LAS3 int* tab = (LAS3 int*)(lds + LDS_TAB); LAS3 int* gtab = (LAS3 int*)(lds + LDS_GTAB);
    moe_prefix_m(p, tab);
    const int* cnt = (const int*)(p.ws + WS_CTL); const int* tok = (const int*)(p.ws + WS_TOK);
    pg8::Order S; S.init(tab[NE], 2 * FE / 256, gridDim.x, blockIdx.x, tab);
    const int tid = otid();
    {
        int src[GTAB_UNITS / 2];
#pragma unroll
        for (int k = 0; k < GTAB_UNITS / 2; ++k) {
            const int ui = 2 * k + (tid >> 8); PUnit u; const bool ok = S.next(ui, u);
            const int e = ok ? u.e : 0, c = tab[40 + e]; int li = ok ? (u.pm - tab[e]) * 256 + (tid & 255) : 0; li = li < c ? li : (c > 0 ? c - 1 : 0);
            src[k] = tok[(size_t)e * T + li];
        }
#pragma unroll
        for (int k = 0; k < GTAB_UNITS / 2; ++k) gtab[(2 * k + (tid >> 8)) * 256 + (tid & 255)] = src[k];
    }
    __syncthreads();
    pg8::gemm_phase<EpiSwigluM, true, 3>(lds, pg8::Gemm{(const h16*)(p.ws + WS_H16), (const h16*)(p.ws + WS_W116), 2 * FE, D}, S,
                                       EpiSwigluM{(h16*)(p.ws + WS_ACT), p.in[15]}, gtab);
}
__device__ __forceinline__ void phase_moe2_m(const Params& p, LAS3 unsigned char* lds) {
    LAS3 int* tab = (LAS3 int*)(lds + LDS_TAB);
    moe_prefix_m(p, tab);
    pg8::Order S; S.init(tab[NE], D / 256, gridDim.x, blockIdx.x, tab);
    pg8::gemm_phase<EpiDownM, false, 3>(lds, pg8::Gemm{(const h16*)(p.ws + WS_ACT), (const h16*)(p.ws + WS_W216), D, FE}, S,
                                      EpiDownM{(h16*)(p.ws + WS_Y16), p.in[17]}, nullptr);
}


typedef float f32x4_t __attribute__((ext_vector_type(4)));
template <int MODE>
__device__ __forceinline__ void phase_rowproj(const Params& p, unsigned char* lds) {
    constexpr int NET = (MODE == 0) ? 1 : 2, RS = 1032;
    const float* xin = p.in[0]; const h16* x1h = (const h16*)(p.ws + WS_X1);
    const float* nw = (MODE == 0) ? p.in[4] : p.in[11];
    const float* mod = (const float*)(p.ws + WS_MOD);
    h16* hout = (h16*)(p.ws + WS_H16);
    h16* HI = (h16*)lds; h16* LO = (h16*)(lds + 33024); float* PART = (float*)(lds + 66048); float* LOGIT = (float*)(lds + 82432);
    int* LCNT = (int*)(lds + 84544); int* GB = (int*)(lds + 84672); int* LIST = (int*)(lds + 84800);
    const int tid = otid(), lane = tid & 63, w = tid >> 6, fr = lane & 15, fq = lane >> 4;
    int nit = 0;
    if (MODE == 1 && tid < 32) LCNT[tid] = 0;
    h16x8 Whi[NET][4], Wlo[NET][4];
#pragma unroll
    for (int et = 0; et < NET; ++et)
#pragma unroll
        for (int s4 = 0; s4 < 4; ++s4)
#pragma unroll
            for (int j = 0; j < 8; ++j) {
                const int k = 128 * w + 32 * s4 + 8 * fq + j, e = 16 * et + fr;
                float wv;
                if (MODE == 0) wv = (e < 8) ? p.in[5][(size_t)k * INC + INC_MAIN + e] : 0.f;
                else wv = p.in[12][(size_t)k * NE + e];
                wv *= 256.f;
                const h16 hi = (h16)wv; Whi[et][s4][j] = hi; Wlo[et][s4][j] = (h16)(wv - (float)hi);
            }
    f32x4 vn[2][4];
#define RP_LOAD(TILE) do { _Pragma("unroll") for (int rr_ = 0; rr_ < 2; ++rr_) { const size_t ro_ = (size_t)((TILE) * 16 + 2 * w + rr_) * D; \
        _Pragma("unroll") for (int j_ = 0; j_ < 4; ++j_) { if (MODE == 0) vn[rr_][j_] = *((const f32x4*)(xin + ro_) + lane + 64 * j_); \
            else { const h16x4 t_ = *((const h16x4*)(x1h + ro_) + lane + 64 * j_); vn[rr_][j_] = (f32x4){(float)t_[0], (float)t_[1], (float)t_[2], (float)t_[3]}; } } } } while (0)
    if ((int)blockIdx.x < T / 16) RP_LOAD(blockIdx.x);
    for (int tile = blockIdx.x; tile < T / 16; tile += gridDim.x) {
        f32x4 v[2][4]; float ss[2];
#pragma unroll
        for (int rr = 0; rr < 2; ++rr)
#pragma unroll
            for (int j = 0; j < 4; ++j) v[rr][j] = vn[rr][j];
        if (tile + (int)gridDim.x < T / 16) RP_LOAD(tile + gridDim.x);
#pragma unroll
        for (int rr = 0; rr < 2; ++rr) {
            float a = 0.f;
#pragma unroll
            for (int j = 0; j < 4; ++j) a += v[rr][j][0] * v[rr][j][0] + v[rr][j][1] * v[rr][j][1] + v[rr][j][2] * v[rr][j][2] + v[rr][j][3] * v[rr][j][3];
            ss[rr] = rsqrtf(wave_sum(a) * (1.f / D) + EPS);
        }
        {
            const int b = (tile * 16) / SEQ;
            const float* shift = mod + b * 6144 + (MODE == 0 ? 0 : 3072); const float* scale = shift + 1024;
#pragma unroll
            for (int j = 0; j < 4; ++j) {
                const int col = 256 * j + 4 * lane;
                const f32x4 w4 = *(const f32x4*)(nw + col), sc = *(const f32x4*)(scale + col), sh = *(const f32x4*)(shift + col);
#pragma unroll
                for (int rr = 0; rr < 2; ++rr) {
                    const int rl = 2 * w + rr;
                    h16x4 hi4, lo4;
                    float hvv[4];
#pragma unroll
                    for (int i = 0; i < 4; ++i) { const float hv = v[rr][j][i] * ss[rr] * w4[i] * (1.f + sc[i]) + sh[i]; hvv[i] = hv; const h16 hi = (h16)hv; hi4[i] = hi; lo4[i] = (h16)(hv - (float)hi); }
                    if (MODE == 0) *(h16x4*)(hout + (size_t)(tile * 16 + rl) * D + col) = hi4;
                    else ((unsigned*)(p.ws + WS_H16))[((size_t)(tile * 16 + rl) * D + col) >> 2] = pack_fp8x4(hvv[0] * FP8_SA, hvv[1] * FP8_SA, hvv[2] * FP8_SA, hvv[3] * FP8_SA);
                    *(h16x4*)(HI + rl * RS + col) = hi4;
                    *(h16x4*)(LO + rl * RS + col) = lo4;
                }
            }
        }
        __syncthreads();
        {
            f32x4 acc[NET];
#pragma unroll
            for (int et = 0; et < NET; ++et) acc[et] = (f32x4){0.f, 0.f, 0.f, 0.f};
#pragma unroll
            for (int s4 = 0; s4 < 4; ++s4) {
                const h16x8 bh = *(const h16x8*)(HI + fr * RS + 128 * w + 32 * s4 + 8 * fq);
                const h16x8 bl = *(const h16x8*)(LO + fr * RS + 128 * w + 32 * s4 + 8 * fq);
#pragma unroll
                for (int et = 0; et < NET; ++et) {
                    acc[et] = __builtin_amdgcn_mfma_f32_16x16x32_f16(Whi[et][s4], bh, acc[et], 0, 0, 0);
                    acc[et] = __builtin_amdgcn_mfma_f32_16x16x32_f16(Wlo[et][s4], bh, acc[et], 0, 0, 0);
                    acc[et] = __builtin_amdgcn_mfma_f32_16x16x32_f16(Whi[et][s4], bl, acc[et], 0, 0, 0);
                }
            }
#pragma unroll
            for (int et = 0; et < NET; ++et)
#pragma unroll
                for (int i = 0; i < 4; ++i) PART[(w * 32 + 16 * et + 4 * fq + i) * 16 + fr] = acc[et][i];
        }
        __syncthreads();
        if (tid < 16 * 16 * NET) {
            const int e = tid >> 4, rl = tid & 15; float a = 0.f;
#pragma unroll
            for (int q = 0; q < 8; ++q) a += PART[(q * 32 + e) * 16 + rl];
            a *= (1.f / 256.f);
            if (MODE == 0) { if (e < 8) ((float*)(p.ws + WS_BA))[(size_t)(tile * 16 + rl) * 8 + e] = a; }
            else LOGIT[rl * 33 + e] = a + p.in[13][e];
        }
        if (MODE == 1) {
            __syncthreads();
            {
                const int rl = 2 * w + (lane >> 5), e = lane & 31, row = tile * 16 + rl;
                float v = LOGIT[rl * 33 + e];
                float tv[4]; int te[4];
#pragma unroll
                for (int k = 0; k < 4; ++k) {
                    float bv = v; int bi = e;
#pragma unroll
                    for (int o = 1; o < 32; o <<= 1) { const float ov = __shfl_xor(bv, o); const int oi = __shfl_xor(bi, o); const bool take = (ov > bv) || (ov == bv && oi < bi); bv = take ? ov : bv; bi = take ? oi : bi; }
                    tv[k] = bv; te[k] = bi; if (e == bi) v = -INFINITY;
                }
                float ex[4]; float sum = 0.f;
#pragma unroll
                for (int k = 0; k < 4; ++k) { ex[k] = __expf(tv[k] - tv[0]); sum += ex[k]; }
                if (e < 4) {
                    const int ek = (e == 0) ? te[0] : (e == 1) ? te[1] : (e == 2) ? te[2] : te[3];
                    const float gk = ((e == 0) ? ex[0] : (e == 1) ? ex[1] : (e == 2) ? ex[2] : ex[3]) / sum;
                    const int lpos = atomicAdd(LCNT + ek, 1);
                    LIST[nit * 64 + rl * 4 + e] = (ek << 16) | lpos;
                    ((int*)(p.ws + WS_ASG_E))[row * 4 + e] = ek; ((float*)(p.ws + WS_ASG_G))[row * 4 + e] = gk;
                }
            }
        }
        ++nit;
    }
    if (MODE == 1) {
        __syncthreads();
        if (tid < 32) GB[tid] = atomicAdd((int*)(p.ws + WS_CTL) + tid, LCNT[tid]);
        __syncthreads();
        int* tok = (int*)(p.ws + WS_TOK); int* asg_p = (int*)(p.ws + WS_ASG_P);
        for (int idx = tid; idx < nit * 64; idx += NTHREADS) {
            const int pk = LIST[idx], e = pk >> 16, pos = GB[e] + (pk & 0xffff);
            const int row = (blockIdx.x + (idx >> 6) * gridDim.x) * 16 + ((idx & 63) >> 2);
            asg_p[row * 4 + (idx & 3)] = pos; tok[(size_t)e * T + pos] = row;
        }
    }
}

#define XB_TMO      128
#define XB_XCNT(j)  (256  + 64 * (j))
#define XB_XSUB(j)  (1280 + 64 * (j))
#define XB_XGEN(j)  (2304 + 64 * (j))
#define XB_TOP      3328
#define XB_TOPGEN   3392
#define XB_EXIT     3456
#define XCD_BAR_WORDS 3520
#define XB_SPIN_CAP (1u << 22)
__device__ __forceinline__ unsigned xb_ld(unsigned* p)              { return __hip_atomic_load(p, __ATOMIC_RELAXED, __HIP_MEMORY_SCOPE_AGENT); }
__device__ __forceinline__ unsigned xb_add(unsigned* p, unsigned v) { return __hip_atomic_fetch_add(p, v, __ATOMIC_RELAXED, __HIP_MEMORY_SCOPE_AGENT); }
__device__ __forceinline__ unsigned xb_xcc_id() { return (unsigned)__builtin_amdgcn_s_getreg((3 << 11) | 20) & 0xFu; }
#define XB_SPIN(cond, bar) do { unsigned _sp = 0; while (cond) { __builtin_amdgcn_s_sleep(1); \
    if ((++_sp & 255u) == 0u) { if (xb_ld(&(bar)[XB_TMO])) break; if (_sp > XB_SPIN_CAP) { atomicAdd(&(bar)[XB_TMO], 1u); break; } } } } while (0)
__device__ unsigned g_xbar[XCD_BAR_WORDS];
__device__ __forceinline__ void xcd_barrier_retire(unsigned* bar) {
    const unsigned old = xb_add(&bar[XB_EXIT], 1u);
    if (old + 1u == gridDim.x * gridDim.y * gridDim.z) {
        __hip_atomic_store(&bar[XB_TMO], 0u, __ATOMIC_RELAXED, __HIP_MEMORY_SCOPE_AGENT);
        for (unsigned j = 0; j < 16; ++j) { __hip_atomic_store(&bar[XB_XCNT(j)], 0u, __ATOMIC_RELAXED, __HIP_MEMORY_SCOPE_AGENT); __hip_atomic_store(&bar[XB_XSUB(j)], 0u, __ATOMIC_RELAXED, __HIP_MEMORY_SCOPE_AGENT);
            __hip_atomic_store(&bar[XB_XGEN(j)], 0u, __ATOMIC_RELAXED, __HIP_MEMORY_SCOPE_AGENT); }
        __hip_atomic_store(&bar[XB_TOP], 0u, __ATOMIC_RELAXED, __HIP_MEMORY_SCOPE_AGENT); __hip_atomic_store(&bar[XB_TOPGEN], 0u, __ATOMIC_RELAXED, __HIP_MEMORY_SCOPE_AGENT);
        __hip_atomic_store(&bar[XB_EXIT], 0u, __ATOMIC_RELAXED, __HIP_MEMORY_SCOPE_AGENT);
    }
}
struct XcdBarrier { unsigned* bar; unsigned x; volatile __attribute__((address_space(3))) unsigned* st; };
__device__ __forceinline__ XcdBarrier xcd_barrier_post(unsigned* bar, volatile __attribute__((address_space(3))) unsigned* st) {
    XcdBarrier b; b.bar = bar; b.x = xb_xcc_id(); b.st = st;
    if (threadIdx.x == 0) (void)xb_add(&bar[XB_XCNT(b.x)], 1u);
    return b;
}
__device__ __forceinline__ void xcd_barrier_complete(unsigned* bar, unsigned x, unsigned& nloc, unsigned& nx) {
    const unsigned G = gridDim.x * gridDim.y * gridDim.z;
    unsigned sum, cnt, mine, sp = 0u;
    for (;;) {
        sum = 0u; cnt = 0u; mine = 0u;
#pragma unroll
        for (unsigned j = 0; j < 16; ++j) { const unsigned c = xb_ld(&bar[XB_XCNT(j)]); sum += c; cnt += (c > 0u) ? 1u : 0u; mine = (j == x) ? c : mine; }
        if (sum == G) break;
        __builtin_amdgcn_s_sleep(1);
        if ((++sp & 255u) == 0u) { if (xb_ld(&bar[XB_TMO])) break; if (sp > XB_SPIN_CAP) { atomicAdd(&bar[XB_TMO], 1u); break; } }
    }
    nloc = mine > 0u ? mine : 1u; nx = cnt > 0u ? cnt : 1u;
}
__device__ __forceinline__ void xcd_barrier(const XcdBarrier& b) {
    asm volatile("s_waitcnt vmcnt(0)" ::: "memory");
    __syncthreads();
    if (threadIdx.x == 0) {
        unsigned* bar = b.bar;
        __builtin_amdgcn_s_waitcnt(0);
        unsigned nloc = b.st[0], nx = b.st[1];
        if (nloc == 0u) { xcd_barrier_complete(bar, b.x, nloc, nx); b.st[0] = nloc; b.st[1] = nx; }
        const unsigned old = xb_add(&bar[XB_XSUB(b.x)], 1u);
        const unsigned gen = old / nloc;
        if (old + 1u == (gen + 1u) * nloc) {
            __builtin_amdgcn_fence(__ATOMIC_RELEASE, "agent");
            asm volatile("s_waitcnt vmcnt(0)" ::: "memory");
            const unsigned og = xb_add(&bar[XB_TOP], 1u);
            const unsigned tg = og / nx;
            if (og + 1u == (tg + 1u) * nx) xb_add(&bar[XB_TOPGEN], 1u);
            else XB_SPIN(xb_ld(&bar[XB_TOPGEN]) == tg, bar);
            __builtin_amdgcn_fence(__ATOMIC_ACQUIRE, "agent");
            xb_add(&bar[XB_XGEN(b.x)], 1u);
            asm volatile("s_waitcnt vmcnt(0)" ::: "memory");
        } else {
            XB_SPIN(xb_ld(&bar[XB_XGEN(b.x)]) == gen, bar);
            __builtin_amdgcn_fence(__ATOMIC_ACQUIRE, "agent");
            asm volatile("s_waitcnt vmcnt(0)" ::: "memory");
        }
    }
    __syncthreads();
}

__global__ void __launch_bounds__(NTHREADS) fwd_megakernel(Params p) {
    extern __shared__ __attribute__((aligned(16))) unsigned char lds_raw[];
    float* lds = (float*)lds_raw;
    volatile LAS3 unsigned* misc = (volatile LAS3 unsigned*)((LAS3 unsigned char*)lds_raw + LDS_MISC);
    if (threadIdx.x < 2) misc[threadIdx.x] = 0u;
    __syncthreads();
    const XcdBarrier gbar = xcd_barrier_post(g_xbar, misc);
#define GSYNC() xcd_barrier(gbar)
    LAS3 unsigned char* l3 = (LAS3 unsigned char*)lds_raw;
#define REPS(k) for (int rep_ = 0; rep_ < ((PROBE == (k)) ? 2 : 1); ++rep_)
    REPS(1) { phase_mod(p, lds); phase_cvt(p, lds, 0, blockIdx.x, gridDim.x); GSYNC(); }
    REPS(2) { phase_rowproj<0>(p, lds_raw); GSYNC(); }
    REPS(3) { phase_inproj_m(p, l3); GSYNC(); }
    REPS(5) { phase_dnchunk2(p, lds_raw); GSYNC(); }
    for (int rep_ = 0; rep_ < ((PROBE == 6 || (PROBE >= 61 && PROBE <= 64)) ? 2 : 1); ++rep_) {
        const int nscan = 2 * NB * DH;
        if (gridDim.x >= 2 * nscan) {
            if (blockIdx.x < nscan) { if (!((PROBE == 62 || PROBE == 63 || PROBE == 64) && rep_)) phase_scan_mfma(p, lds_raw, ((blockIdx.x >> 4) << 3) + (blockIdx.x & 7), (blockIdx.x >> 3) & 1); }
            else if (!(PROBE == 61 && rep_)) {
                const bool cvt_first = ((blockIdx.x >> 3) & 1) != 0;
                if (cvt_first) { if (!(PROBE == 64 && rep_)) phase_cvt(p, lds, 1, blockIdx.x - nscan, gridDim.x - nscan); __syncthreads(); }
                if (!(PROBE == 63 && rep_)) phase_attn_mfma(p, lds_raw, blockIdx.x - nscan, gridDim.x - nscan);
                if (!cvt_first) { __syncthreads(); if (!(PROBE == 64 && rep_)) phase_cvt(p, lds, 1, blockIdx.x - nscan, gridDim.x - nscan); }
            }
        } else {
            for (int sb = blockIdx.x; sb < nscan; sb += gridDim.x) phase_scan_mfma(p, lds_raw, sb >> 1, sb & 1);
            phase_attn_mfma(p, lds_raw, blockIdx.x, gridDim.x); __syncthreads(); phase_cvt(p, lds, 1, blockIdx.x, gridDim.x);
        }
        GSYNC();
    }
    REPS(7) { phase_dnout(p); GSYNC(); }
    REPS(8) { phase_outproj_m(p, l3); GSYNC(); }
    REPS(9) {
        if (rep_) { if (blockIdx.x == 0 && threadIdx.x < 64) ((int*)(p.ws + WS_CTL))[threadIdx.x] = 0; GSYNC(); }
        phase_rowproj<1>(p, lds_raw); GSYNC();
    }
    REPS(10) { phase_moe1_m(p, l3); GSYNC(); }
    REPS(11) { phase_moe2_m(p, l3); GSYNC(); }
    REPS(12) { phase_final(p, lds); if (PROBE == 12) GSYNC(); }
    if (threadIdx.x == 0) xcd_barrier_retire(g_xbar);
}

extern "C" void kernel_launch(void* const* d_in, const int* in_sizes, int n_in, void* d_out, int out_size, void* d_ws, size_t ws_size, hipStream_t stream) {
    static int grid_blocks = 0;
    if (grid_blocks == 0) {
        if (n_in != 19 || out_size != T * D || ws_size < WS_END) { fprintf(stderr, "kernel_launch: unexpected shapes (n_in %d out %d ws %zu)\n", n_in, out_size, ws_size); grid_blocks = -1; return; }
        int dev = 0, cus = 0, per_cu = 0;
        hipGetDevice(&dev);
        hipDeviceGetAttribute(&cus, hipDeviceAttributeMultiprocessorCount, dev);
        hipFuncSetAttribute((const void*)fwd_megakernel, hipFuncAttributeMaxDynamicSharedMemorySize, LDS_BYTES);
        hipOccupancyMaxActiveBlocksPerMultiprocessor(&per_cu, (const void*)fwd_megakernel, NTHREADS, LDS_BYTES);
        if (per_cu < 1) { fprintf(stderr, "kernel_launch: occupancy query says %d blocks/CU\n", per_cu); grid_blocks = -1; return; }
        grid_blocks = cus;
    }
    if (grid_blocks < 0) return;
    Params p{};
    for (int i = 0; i < 19; ++i) p.in[i] = (const float*)d_in[i];
    p.out = (float*)d_out; p.ws = (unsigned char*)d_ws;
    hipLaunchKernelGGL(fwd_megakernel, dim3(grid_blocks), dim3(NTHREADS), LDS_BYTES, stream, p);
    const hipError_t e = hipPeekAtLastError();
    if (e != hipSuccess) fprintf(stderr, "launch failed: %s (grid %d)\n", hipGetErrorString(e), grid_blocks);
}
```
